# Optimizing an MI355X kernel written in HIP

```python
import math
import jax, jax.numpy as jnp
from jax import lax
import numpy as np

D_MODEL = 1024
BATCH = 8
SEQ = 2048
DEPTH = 2
DEC_BATCH = 32
DEC_SEQ = 64
PAST_LEN = 4096

CHUNK = 64
EPS = 1e-6
GLA_HEADS = 4
GLA_KEY_DIM = D_MODEL // 2
GLA_VALUE_DIM = D_MODEL
GLA_DK = GLA_KEY_DIM // GLA_HEADS
GLA_DV = GLA_VALUE_DIM // GLA_HEADS
GLA_GATE_RANK = 16
GLA_GATE_NORM = 16.0
SSD_INNER = 2 * D_MODEL
SSD_HEADDIM = 64
SSD_HEADS = SSD_INNER // SSD_HEADDIM
SSD_GROUPS = 4
SSD_DSTATE = 128
CONV_WIDTH = 4
SSD_CONV_DIM = SSD_INNER + 2 * SSD_GROUPS * SSD_DSTATE
N_BRANCH = 2
IN_SPLITS = (GLA_KEY_DIM, GLA_KEY_DIM, GLA_VALUE_DIM, GLA_VALUE_DIM, GLA_GATE_RANK,
             SSD_INNER, SSD_CONV_DIM, SSD_HEADS, N_BRANCH * D_MODEL)
D_IN_PROJ = sum(IN_SPLITS)
PEER_HEADS = 8
PEER_NKEYS = 128
PEER_EXPERTS = PEER_NKEYS * PEER_NKEYS
PEER_DQ = 256
PEER_TOPK = 16
PEER_TOKEN_BLOCK = 128

kernel_name = "hybrid_gla_ssd_peer_streaming_step"


def rmsnorm(x, w):
    xf = x.astype(jnp.float32)
    y = xf * lax.rsqrt(jnp.mean(xf * xf, axis=-1, keepdims=True) + EPS)
    return (y * w.astype(jnp.float32)).astype(x.dtype)


def chunk_len(T):
    return CHUNK if T >= CHUNK else T


def gla_chunked(q, k, v, gk, s0):
    Bsz, T, H, DK = q.shape
    DV = v.shape[-1]
    L = chunk_len(T)
    NC = T // L
    q = q.reshape(Bsz, NC, L, H, DK)
    k = k.reshape(Bsz, NC, L, H, DK)
    v = v.reshape(Bsz, NC, L, H, DV)
    b = jnp.cumsum(gk.reshape(Bsz, NC, L, H, DK), axis=2)
    b_last = b[:, :, -1]
    q_t = q * jnp.exp(b)
    k_t = k * jnp.exp(-b)
    causal = jnp.tril(jnp.ones((L, L), dtype=bool))
    att = jnp.where(causal, jnp.einsum('bnihd,bnjhd->bnhij', q_t, k_t), 0.0)
    o_intra = jnp.einsum('bnhij,bnjhe->bnihe', att, v)
    k_end = k * jnp.exp(b_last[:, :, None] - b)
    d_s = jnp.einsum('bnjhd,bnjhe->bnhde', k_end, v)

    def step(s, inp):
        dec, ds = inp
        return s * dec[..., None] + ds, s

    s_final, s_starts = lax.scan(step, s0, (jnp.moveaxis(jnp.exp(b_last), 1, 0), jnp.moveaxis(d_s, 1, 0)))
    s_starts = jnp.moveaxis(s_starts, 0, 1)
    o_inter = jnp.einsum('bnihd,bnhde->bnihe', q_t, s_starts)
    return (o_intra + o_inter).reshape(Bsz, T, H, DV), s_final


def ssd_chunked(x, dt, A, bm, cm, s0):
    Bsz, T, H, P = x.shape
    G, N = bm.shape[-2], bm.shape[-1]
    HG = H // G
    L = chunk_len(T)
    NC = T // L
    x = x.reshape(Bsz, NC, L, G, HG, P)
    dt = dt.reshape(Bsz, NC, L, G, HG)
    bm = bm.reshape(Bsz, NC, L, G, N)
    cm = cm.reshape(Bsz, NC, L, G, N)
    a = jnp.cumsum(dt * A.reshape(G, HG), axis=2)
    a_last = a[:, :, -1]
    a_t = jnp.moveaxis(a, 2, -1)
    causal = jnp.tril(jnp.ones((L, L), dtype=bool))
    decay = jnp.exp(jnp.where(causal, a_t[..., :, None] - a_t[..., None, :], -jnp.inf))
    cb = jnp.einsum('bnigs,bnjgs->bngij', cm, bm)
    w_intra = cb[:, :, :, None] * decay * jnp.moveaxis(dt, 2, -1)[..., None, :]
    y_intra = jnp.einsum('bnghij,bnjghp->bnighp', w_intra, x)
    xw = x * (dt * jnp.exp(a_last[:, :, None] - a))[..., None]
    d_s = jnp.einsum('bnjghp,bnjgs->bnghps', xw, bm)

    def step(s, inp):
        dec, ds = inp
        return s * dec[..., None, None] + ds, s

    s_final, s_starts = lax.scan(step, s0.reshape(Bsz, G, HG, P, N),
                                 (jnp.moveaxis(jnp.exp(a_last), 1, 0), jnp.moveaxis(d_s, 1, 0)))
    s_starts = jnp.moveaxis(s_starts, 0, 1)
    y_inter = jnp.einsum('bnigs,bnghps->bnighp', cm, s_starts) * jnp.exp(a)[..., None]
    y = (y_intra + y_inter).reshape(Bsz, T, H, P)
    return y, s_final.reshape(Bsz, H, P, N)


def token_mixer(h, conv_prev, gla_s0, ssd_s0, w_in, gla_gk_w2, gla_gk_b, gla_norm_w, gla_proj,
                ssd_conv_w, ssd_conv_b, ssd_dt_bias, ssd_A_log, ssd_D, ssd_norm_w, ssd_proj, w_out):
    f32 = jnp.float32
    Bsz, T, _ = h.shape
    offs = np.cumsum(IN_SPLITS)[:-1].tolist()
    q, k, v, g_out, gk_low, z, xbc, dt_raw, gate_logits = jnp.split(h @ w_in, offs, axis=-1)

    qh = q.reshape(Bsz, T, GLA_HEADS, GLA_DK).astype(f32) * (GLA_DK ** -0.5)
    kh = k.reshape(Bsz, T, GLA_HEADS, GLA_DK).astype(f32)
    vh = v.reshape(Bsz, T, GLA_HEADS, GLA_DV).astype(f32)
    gk = jax.nn.log_sigmoid((gk_low @ gla_gk_w2 + gla_gk_b).astype(f32)) / GLA_GATE_NORM
    o_a, gla_s = gla_chunked(qh, kh, vh, gk.reshape(Bsz, T, GLA_HEADS, GLA_DK), gla_s0.astype(f32))
    o_a = rmsnorm(o_a, gla_norm_w) * jax.nn.silu(g_out.reshape(Bsz, T, GLA_HEADS, GLA_DV).astype(f32))
    br_a = o_a.reshape(Bsz, T, GLA_VALUE_DIM).astype(h.dtype) @ gla_proj

    xbc_ext = jnp.concatenate([conv_prev.astype(xbc.dtype), xbc], axis=1)
    conv = ssd_conv_b + xbc_ext[:, 0:T] * ssd_conv_w[0]
    for i in range(1, CONV_WIDTH):
        conv = conv + xbc_ext[:, i:i + T] * ssd_conv_w[i]
    conv_new = xbc_ext[:, T:]
    xbc_act = jax.nn.silu(conv.astype(f32))
    xs, b_ssm, c_ssm = jnp.split(xbc_act, [SSD_INNER, SSD_INNER + SSD_GROUPS * SSD_DSTATE], axis=-1)
    xs = xs.reshape(Bsz, T, SSD_HEADS, SSD_HEADDIM)
    dt = jax.nn.softplus(dt_raw.astype(f32) + ssd_dt_bias.astype(f32))
    A = -jnp.exp(ssd_A_log.astype(f32))
    y, ssd_s = ssd_chunked(xs, dt, A,
                           b_ssm.reshape(Bsz, T, SSD_GROUPS, SSD_DSTATE),
                           c_ssm.reshape(Bsz, T, SSD_GROUPS, SSD_DSTATE),
                           ssd_s0.astype(f32))
    y = (y + ssd_D.astype(f32)[:, None] * xs).reshape(Bsz, T, SSD_INNER) * jax.nn.silu(z.astype(f32))
    y = rmsnorm(y.reshape(Bsz, T, SSD_GROUPS, SSD_INNER // SSD_GROUPS),
                ssd_norm_w.reshape(SSD_GROUPS, SSD_INNER // SSD_GROUPS)).reshape(Bsz, T, SSD_INNER)
    br_b = y.astype(h.dtype) @ ssd_proj

    g_a, g_b = jnp.split(jax.nn.sigmoid(gate_logits), N_BRANCH, axis=-1)
    return (g_a * br_a + g_b * br_b) @ w_out, conv_new, gla_s, ssd_s


def peer_ffn(h, wq, keys1, keys2, u_tab, v_tab):
    Bsz, T, D = h.shape
    xt = h.reshape(Bsz * T, D)
    n = Bsz * T
    npad = (-n) % PEER_TOKEN_BLOCK
    blocks = jnp.pad(xt, ((0, npad), (0, 0))).reshape(-1, PEER_TOKEN_BLOCK, D)
    half = PEER_DQ // 2

    def one_block(xb):
        q = (xb @ wq).reshape(PEER_TOKEN_BLOCK, PEER_HEADS, PEER_DQ).astype(jnp.float32)
        s1 = jnp.einsum('thd,hkd->thk', q[..., :half], keys1.astype(jnp.float32))
        s2 = jnp.einsum('thd,hkd->thk', q[..., half:], keys2.astype(jnp.float32))
        v1, i1 = lax.top_k(s1, PEER_TOPK)
        v2, i2 = lax.top_k(s2, PEER_TOPK)
        cand = (v1[..., :, None] + v2[..., None, :]).reshape(PEER_TOKEN_BLOCK, PEER_HEADS, PEER_TOPK * PEER_TOPK)
        cidx = (i1[..., :, None] * PEER_NKEYS + i2[..., None, :]).reshape(PEER_TOKEN_BLOCK, PEER_HEADS, PEER_TOPK * PEER_TOPK)
        sc, pos = lax.top_k(cand, PEER_TOPK)
        eidx = jnp.take_along_axis(cidx, pos, axis=-1)
        gsm = jax.nn.softmax(sc, axis=-1)
        u_sel = u_tab[eidx]
        v_sel = v_tab[eidx]
        act = jnp.einsum('td,thkd->thk', xb, u_sel).astype(jnp.float32)
        w = gsm * jax.nn.gelu(act, approximate=False)
        return jnp.einsum('thk,thkd->td', w.astype(xb.dtype), v_sel)

    out = lax.map(one_block, blocks).reshape(-1, D)[:n]
    return out.reshape(Bsz, T, D)


def run_trunk(x, c, conv_state, gla_state, ssd_state, w_ada, b_ada, norm1_w, w_in, gla_gk_w2, gla_gk_b,
              gla_norm_w, gla_proj, ssd_conv_w, ssd_conv_b, ssd_dt_bias, ssd_A_log, ssd_D, ssd_norm_w,
              ssd_proj, w_out, norm2_w, peer_wq, peer_keys1, peer_keys2, peer_u, peer_v, final_norm_w):
    new_gla, new_ssd, new_conv = [], [], []
    for l in range(DEPTH):
        mod = jax.nn.silu(c) @ w_ada[l] + b_ada[l]
        sh1, sc1, ga1, sh2, sc2, ga2 = jnp.split(mod[:, None, :], 6, axis=-1)
        h = rmsnorm(x, norm1_w[l]) * (1 + sc1) + sh1
        y, cv, sg, ss = token_mixer(h, conv_state[l], gla_state[l], ssd_state[l], w_in[l], gla_gk_w2[l],
                                    gla_gk_b[l], gla_norm_w[l], gla_proj[l], ssd_conv_w[l], ssd_conv_b[l],
                                    ssd_dt_bias[l], ssd_A_log[l], ssd_D[l], ssd_norm_w[l], ssd_proj[l], w_out[l])
        x = x + ga1 * y
        h = rmsnorm(x, norm2_w[l]) * (1 + sc2) + sh2
        x = x + ga2 * peer_ffn(h, peer_wq[l], peer_keys1[l], peer_keys2[l], peer_u[l], peer_v[l])
        new_gla.append(sg)
        new_ssd.append(ss)
        new_conv.append(cv)
    return rmsnorm(x, final_norm_w), jnp.stack(new_gla), jnp.stack(new_ssd), jnp.stack(new_conv)


def setup_inputs(seed: int = 0) -> dict:
    key = jax.random.key(seed)
    ks = iter(jax.random.split(key, 40))
    f32 = jnp.float32

    def nrm(shape, scale):
        return jax.random.normal(next(ks), shape, f32) * scale

    u_dt = jax.random.uniform(next(ks), (DEPTH, SSD_HEADS), f32)
    dt0 = jnp.exp(u_dt * (math.log(0.1) - math.log(1e-3)) + math.log(1e-3))
    return {
        "x_prompt": nrm((BATCH, SEQ, D_MODEL), 1.0),
        "x_sample": nrm((DEC_BATCH, DEC_SEQ, D_MODEL), 1.0),
        "state_gla": nrm((DEPTH, DEC_BATCH, GLA_HEADS, GLA_DK, GLA_DV), 1.0),
        "state_ssd": nrm((DEPTH, DEC_BATCH, SSD_HEADS, SSD_HEADDIM, SSD_DSTATE), 0.3),
        "state_conv": nrm((DEPTH, DEC_BATCH, CONV_WIDTH - 1, SSD_CONV_DIM), 1.0),
        "c_prompt": nrm((BATCH, D_MODEL), 1.0),
        "c_sample": nrm((DEC_BATCH, D_MODEL), 1.0),
        "w_ada": nrm((DEPTH, D_MODEL, 6 * D_MODEL), 0.5 * D_MODEL ** -0.5),
        "b_ada": nrm((DEPTH, 6 * D_MODEL), 0.02),
        "norm1_w": 1.0 + nrm((DEPTH, D_MODEL), 0.02),
        "w_in": nrm((DEPTH, D_MODEL, D_IN_PROJ), D_MODEL ** -0.5),
        "gla_gk_w2": nrm((DEPTH, GLA_GATE_RANK, GLA_KEY_DIM), GLA_GATE_RANK ** -0.5),
        "gla_gk_b": nrm((DEPTH, GLA_KEY_DIM), 0.1),
        "gla_norm_w": 1.0 + nrm((DEPTH, GLA_DV), 0.02),
        "gla_proj": nrm((DEPTH, GLA_VALUE_DIM, D_MODEL), GLA_VALUE_DIM ** -0.5),
        "ssd_conv_w": nrm((DEPTH, CONV_WIDTH, SSD_CONV_DIM), CONV_WIDTH ** -0.5),
        "ssd_conv_b": nrm((DEPTH, SSD_CONV_DIM), 0.02),
        "ssd_dt_bias": dt0 + jnp.log(-jnp.expm1(-dt0)),
        "ssd_A_log": jnp.log(jax.random.uniform(next(ks), (DEPTH, SSD_HEADS), f32, minval=1.0, maxval=16.0)),
        "ssd_D": 1.0 + nrm((DEPTH, SSD_HEADS), 0.1),
        "ssd_norm_w": 1.0 + nrm((DEPTH, SSD_INNER), 0.02),
        "ssd_proj": nrm((DEPTH, SSD_INNER, D_MODEL), SSD_INNER ** -0.5),
        "w_out": nrm((DEPTH, D_MODEL, D_MODEL), D_MODEL ** -0.5),
        "norm2_w": 1.0 + nrm((DEPTH, D_MODEL), 0.02),
        "peer_wq": nrm((DEPTH, D_MODEL, PEER_HEADS * PEER_DQ), D_MODEL ** -0.5),
        "peer_keys1": nrm((DEPTH, PEER_HEADS, PEER_NKEYS, PEER_DQ // 2), (PEER_DQ // 2) ** -0.5),
        "peer_keys2": nrm((DEPTH, PEER_HEADS, PEER_NKEYS, PEER_DQ // 2), (PEER_DQ // 2) ** -0.5),
        "peer_u": nrm((DEPTH, PEER_EXPERTS, D_MODEL), D_MODEL ** -0.5),
        "peer_v": nrm((DEPTH, PEER_EXPERTS, D_MODEL), (PEER_HEADS * PEER_TOPK) ** -0.5),
        "final_norm_w": 1.0 + nrm((D_MODEL,), 0.02),
    }


def reference(x_prompt, x_sample, state_gla, state_ssd, state_conv, c_prompt, c_sample, w_ada, b_ada,
              norm1_w, w_in, gla_gk_w2, gla_gk_b, gla_norm_w, gla_proj, ssd_conv_w, ssd_conv_b, ssd_dt_bias,
              ssd_A_log, ssd_D, ssd_norm_w, ssd_proj, w_out, norm2_w, peer_wq, peer_keys1, peer_keys2,
              peer_u, peer_v, final_norm_w):
    weights = (w_ada, b_ada, norm1_w, w_in, gla_gk_w2, gla_gk_b, gla_norm_w, gla_proj, ssd_conv_w,
               ssd_conv_b, ssd_dt_bias, ssd_A_log, ssd_D, ssd_norm_w, ssd_proj, w_out, norm2_w, peer_wq,
               peer_keys1, peer_keys2, peer_u, peer_v, final_norm_w)
    nb = x_prompt.shape[0]
    zero_conv = jnp.zeros((DEPTH, nb, CONV_WIDTH - 1, SSD_CONV_DIM), x_prompt.dtype)
    zero_gla = jnp.zeros((DEPTH, nb, GLA_HEADS, GLA_DK, GLA_DV), jnp.float32)
    zero_ssd = jnp.zeros((DEPTH, nb, SSD_HEADS, SSD_HEADDIM, SSD_DSTATE), jnp.float32)
    y_prompt, gla_p, ssd_p, conv_p = run_trunk(x_prompt, c_prompt, zero_conv, zero_gla, zero_ssd, *weights)
    y_sample, gla_s, ssd_s, conv_s = run_trunk(x_sample, c_sample, state_conv, state_gla, state_ssd, *weights)
    return (y_prompt, y_sample, gla_p, ssd_p, conv_p, gla_s, ssd_s, conv_s)
```

```cpp
#define SANITIZE 1
#define DBG2 1
#include <hip/hip_runtime.h>
#include <cstdio>
#define LAS __attribute__((address_space(3)))
namespace pg8 {
#define PG8_LAS __attribute__((address_space(3)))
typedef unsigned short bf16_t;
typedef short bf16x8 __attribute__((ext_vector_type(8)));
typedef float f32x4 __attribute__((ext_vector_type(4)));
typedef unsigned u32x4 __attribute__((ext_vector_type(4)));
constexpr int BM = 256, BK = 64, HALF = 128, HTB = HALF * BK * 2  , STAGE_BYTES = 8 * HTB, NXCD = 8, WGM = 8;

__host__ __device__ __forceinline__ int lds_byte(int r, int c) { const int st = (r >> 4) * 2 + (c >> 5), rr = r & 15, cc = c & 31, ob = rr * 64 + cc * 2; return st * 1024 + (ob ^ (((ob >> 9) & 1) << 5)); }
__host__ __device__ __forceinline__ void stage_rc(int b, int& R, int& C) { const int st = b / 1024, sb = b % 1024, swz = sb ^ (((sb >> 9) & 1) << 5); R = (st >> 1) * 16 + swz / 64; C = (st & 1) * 32 + (swz % 64) / 2; }
__host__ __device__ __forceinline__ int perm32(int rho) { const int n = rho >> 4, i = rho & 15; return 8 * (i >> 2) + 4 * n + (i & 3); }

struct Unit { int pm, pn; };
struct Gemm { const bf16_t* A; const bf16_t* Bt; int M, N, K, lda; };

struct StaticOrder {
    int nM, nN, nwg, G, c;
    __host__ __device__ void init(int M, int N, int G_, int c_) { nM = M / BM; nN = N / BM; nwg = nM * nN; G = G_; c = c_; }
    __host__ __device__ bool next(int i, Unit& u) const {
        const long L = (long)i * G + c; if (L >= nwg) return false;
        int wgid = (int)L; { const int q = nwg / NXCD, r = nwg % NXCD, xcd = wgid % NXCD, off = wgid / NXCD; wgid = (xcd < r ? xcd * (q + 1) : r * (q + 1) + (xcd - r) * q) + off; }
        const int nig = WGM * nN, gid = wgid / nig, fm = gid * WGM, gsz = (nM - fm) < WGM ? (nM - fm) : WGM;
        u.pm = fm + ((wgid % nig) % gsz); u.pn = (wgid % nig) / gsz; return true;
    }
    __device__ __forceinline__ void a_ready(const Unit&) const {}
    __device__ __forceinline__ void done(const Unit&) const {}
};
__device__ __forceinline__ unsigned cvt_pk_bf16(float lo, float hi) { unsigned r; asm volatile("v_cvt_pk_bf16_f32 %0, %1, %2" : "=v"(r) : "v"(lo), "v"(hi)); return r; }
typedef float f32x2 __attribute__((ext_vector_type(2)));
template <class Epi, class Sched, bool STAMP = false>
__device__ __forceinline__ void gemm_phase(PG8_LAS unsigned char* lds, const Gemm g, const Sched& S, const Epi& E, unsigned long long* stamps) {
    int tid_ = threadIdx.x; asm volatile("" : "+v"(tid_)); const int tid = tid_, wid = __builtin_amdgcn_readfirstlane(tid >> 6), lane = tid & 63, wr = wid >> 2, wc = wid & 3, fr = lane & 15, fq = lane >> 4;
    const int K = g.K, nt = K / BK;
    int ts_lo = 0, ts_hi = 0, nts = 0; const unsigned long long rt_entry = STAMP ? (unsigned long long)wall_clock64() : 0ull;
#define PG8_STAMP() do { if (STAMP && wid == 0 && nts < 64) { const unsigned long long _c = (unsigned long long)clock64(); \
        ts_lo = (lane == nts) ? (int)(unsigned)_c : ts_lo; ts_hi = (lane == nts) ? (int)(unsigned)(_c >> 32) : ts_hi; ++nts; } } while (0)
    PG8_STAMP();
    unsigned voffA[2], voffB[2];
#pragma unroll
    for (int i = 0; i < 2; ++i) { int R, C; stage_rc(tid * 16 + i * 8192, R, C); const int Rb = Epi::PERM ? ((R & ~31) + perm32(R & 31)) : R;
        voffA[i] = (unsigned)(R * g.lda + C) * 2u; voffB[i] = (unsigned)(Rb * K + C) * 2u; }
    const size_t kstep = (size_t)(BK * 2);
    const size_t hstepB = (size_t)HALF * K * 2, hstepA = (size_t)HALF * g.lda * 2;
    const size_t tstepA = 2 * hstepA, tstepB = 2 * hstepB;
    const unsigned ldsw = (unsigned)wid * 1024u;
    const int aoff = lds_byte(wr * 64 + fr, fq * 8), boff = lds_byte(wc * 32 + fr, fq * 8);
#define PG8_SA(b, h) (((b) * 2 + (h)) * HTB)
#define PG8_SB(b, h) ((4 + (b) * 2 + (h)) * HTB)
#define PG8_STAGE(bufoff, gbase, voff) do { _Pragma("unroll") for (int _i = 0; _i < 2; ++_i) \
        __builtin_amdgcn_global_load_lds((const unsigned*)((const char*)(gbase) + (voff)[_i]), (PG8_LAS unsigned*)(lds + (bufoff) + ldsw + _i * 8192), 16, 0, 0); } while (0)
#define PG8_LDA(dst, b, h) do { _Pragma("unroll") for (int m = 0; m < 4; ++m) _Pragma("unroll") for (int k = 0; k < 2; ++k) dst[m][k] = *(const PG8_LAS bf16x8*)(lds + PG8_SA(b, h) + aoff + m * 2048 + k * 1024); } while (0)
#define PG8_LDB(dst, b, h) do { _Pragma("unroll") for (int n = 0; n < 2; ++n) _Pragma("unroll") for (int k = 0; k < 2; ++k) dst[n][k] = *(const PG8_LAS bf16x8*)(lds + PG8_SB(b, h) + boff + n * 2048 + k * 1024); } while (0)
#define PG8_MMA(ai, bj, At, Bt) do { __builtin_amdgcn_s_setprio(1); _Pragma("unroll") for (int m = 0; m < 4; ++m) _Pragma("unroll") for (int n = 0; n < 2; ++n) _Pragma("unroll") for (int k = 0; k < 2; ++k) \
        acc[ai][bj][m][n] = __builtin_amdgcn_mfma_f32_16x16x32_bf16(Bt[n][k], At[m][k], acc[ai][bj][m][n], 0, 0, 0); __builtin_amdgcn_s_setprio(0); } while (0)
#define PG8_WAIT_V(n) asm volatile("s_waitcnt vmcnt(" #n ")" ::: "memory")
#define PG8_WAIT_L(n) asm volatile("s_waitcnt lgkmcnt(" #n ")" ::: "memory")
#define PG8_BAR __builtin_amdgcn_s_barrier()
#define PG8_SCHED __builtin_amdgcn_sched_barrier(0)
    Unit cur, nxt; int ui = 0;
    if (!S.next(0, cur)) return;
    f32x4 acc[2][2][4][2];
#pragma unroll
    for (int a = 0; a < 2; ++a)
#pragma unroll
        for (int b = 0; b < 2; ++b)
#pragma unroll
            for (int m = 0; m < 4; ++m)
#pragma unroll
                for (int n = 0; n < 2; ++n) acc[a][b][m][n] = (f32x4){0.f, 0.f, 0.f, 0.f};
    bf16x8 At[4][2], B0[2][2], B1[2][2];
    const char* cA = (const char*)g.A + (size_t)cur.pm * tstepA; const char* cB = (const char*)g.Bt + (size_t)cur.pn * tstepB;
    S.a_ready(cur);
    PG8_STAGE(PG8_SB(0, 0), cB, voffB); PG8_STAGE(PG8_SA(0, 0), cA, voffA); PG8_STAGE(PG8_SB(0, 1), cB + hstepB, voffB); PG8_STAGE(PG8_SA(0, 1), cA + hstepA, voffA);
    if (wr == 1) PG8_BAR;
    PG8_WAIT_V(4); PG8_BAR;
    PG8_STAGE(PG8_SB(1, 0), cB + kstep, voffB); PG8_STAGE(PG8_SA(1, 0), cA + kstep, voffA); PG8_STAGE(PG8_SB(1, 1), cB + hstepB + kstep, voffB);
    PG8_WAIT_V(6); PG8_BAR;
    PG8_STAMP();
    for (;;) {
        const bool has_next = S.next(ui + 1, nxt);
        const char* nA = has_next ? (const char*)g.A + (size_t)nxt.pm * tstepA : cA; const char* nB = has_next ? (const char*)g.Bt + (size_t)nxt.pn * tstepB : cB;
        for (int t = 0; t < nt; t += 2) {
            const bool last = (t == nt - 2);
            const char* a1 = cA + (size_t)(t + 1) * kstep;
            const char* a2 = last ? nA : cA + (size_t)(t + 2) * kstep; const char* b2 = last ? nB : cB + (size_t)(t + 2) * kstep;
            const char* a3 = a2 + kstep; const char* b3 = b2 + kstep;
            if (last && has_next) S.a_ready(nxt);
            PG8_LDB(B0, 0, 0); PG8_SCHED; PG8_LDA(At, 0, 0); PG8_STAGE(PG8_SA(1, 1), a1 + hstepA, voffA);
            PG8_WAIT_L(8); PG8_BAR; PG8_WAIT_L(0); PG8_MMA(0, 0, At, B0); PG8_BAR; PG8_SCHED;
            PG8_LDB(B1, 0, 1); PG8_STAGE(PG8_SB(0, 0), b2, voffB);
            PG8_BAR; PG8_WAIT_L(0); PG8_MMA(0, 1, At, B1); PG8_BAR;
            PG8_LDA(At, 0, 1); PG8_STAGE(PG8_SA(0, 0), a2, voffA);
            PG8_BAR; PG8_WAIT_L(0); PG8_MMA(1, 0, At, B0); PG8_BAR; PG8_SCHED;
            PG8_STAGE(PG8_SB(0, 1), b2 + hstepB, voffB);
            PG8_WAIT_V(6); PG8_BAR; PG8_MMA(1, 1, At, B1); PG8_BAR;
            PG8_LDB(B0, 1, 0); PG8_SCHED; PG8_LDA(At, 1, 0); PG8_STAGE(PG8_SA(0, 1), a2 + hstepA, voffA);
            PG8_WAIT_L(8); PG8_BAR; PG8_WAIT_L(0); PG8_MMA(0, 0, At, B0); PG8_BAR; PG8_SCHED;
            PG8_LDB(B1, 1, 1); PG8_STAGE(PG8_SB(1, 0), b3, voffB);
            PG8_BAR; PG8_WAIT_L(0); PG8_MMA(0, 1, At, B1); PG8_BAR;
            PG8_LDA(At, 1, 1); PG8_STAGE(PG8_SA(1, 0), a3, voffA);
            PG8_BAR; PG8_WAIT_L(0); PG8_MMA(1, 0, At, B0); PG8_BAR; PG8_SCHED;
            PG8_STAGE(PG8_SB(1, 1), b3 + hstepB, voffB);
            PG8_WAIT_V(6); PG8_BAR; PG8_MMA(1, 1, At, B1); PG8_BAR;
        }
        PG8_STAMP();
        if constexpr (!Epi::AFTER_DRAIN) { E(acc, cur, wr, wc, fr, fq); S.done(cur); }
        PG8_STAMP();
        if (!has_next) break;
#pragma unroll
        for (int a = 0; a < 2; ++a)
#pragma unroll
            for (int b = 0; b < 2; ++b)
#pragma unroll
                for (int m = 0; m < 4; ++m)
#pragma unroll
                    for (int n = 0; n < 2; ++n) acc[a][b][m][n] = (f32x4){0.f, 0.f, 0.f, 0.f};
        cur = nxt; cA = nA; cB = nB; ++ui;
    }
    PG8_WAIT_V(0);
    if (wr == 0) PG8_BAR;
    PG8_BAR;
    if constexpr (Epi::AFTER_DRAIN) { E.fused(acc, cur, wr, wc, fr, fq, lds, wid, lane); S.done(cur); }
    PG8_STAMP();
    if (STAMP && wid == 0) { stamps[lane] = lane < nts ? (((unsigned long long)(unsigned)ts_hi << 32) | (unsigned)ts_lo) : 0ull;
        if (lane == 62) stamps[62] = rt_entry; if (lane == 63) stamps[63] = (unsigned long long)wall_clock64(); }
#undef PG8_STAMP
#undef PG8_SA
#undef PG8_SB
#undef PG8_STAGE
#undef PG8_LDA
#undef PG8_LDB
#undef PG8_MMA
#undef PG8_WAIT_V
#undef PG8_WAIT_L
#undef PG8_BAR
#undef PG8_SCHED
}
}
#define XB_TMO      128
#define XB_XCNT(j)  (256  + 64 * (j))
#define XB_XSUB(j)  (1280 + 64 * (j))
#define XB_XGEN(j)  (2304 + 64 * (j))
#define XB_TOP      3328
#define XB_TOPGEN   3392
#define XCD_BAR_WORDS 3456
#define XB_SPIN_CAP (1u << 18)

__device__ __forceinline__ unsigned xb_ld(unsigned* p)              { return __hip_atomic_load(p, __ATOMIC_RELAXED, __HIP_MEMORY_SCOPE_AGENT); }
__device__ __forceinline__ unsigned xb_add(unsigned* p, unsigned v) { return __hip_atomic_fetch_add(p, v, __ATOMIC_RELAXED, __HIP_MEMORY_SCOPE_AGENT); }
__device__ __forceinline__ unsigned xb_xcc_id() { return (unsigned)__builtin_amdgcn_s_getreg((3 << 11) | 20) & 0xFu; }
#define XB_SPIN(cond, bar) do { unsigned _sp = 0; while (cond) { __builtin_amdgcn_s_sleep(1); \
    if ((++_sp & 255u) == 0u) { if (xb_ld(&(bar)[XB_TMO])) break; if (_sp > XB_SPIN_CAP) { atomicAdd(&(bar)[XB_TMO], 1u); break; } } } } while (0)

struct XcdBarrier {
    unsigned* bar; unsigned x;
    volatile LAS unsigned* st;
};

__device__ __forceinline__ XcdBarrier xcd_barrier_post(unsigned* bar, volatile LAS unsigned* st) {
    XcdBarrier b; b.bar = bar; b.x = xb_xcc_id(); b.st = st;
    if (threadIdx.x == 0) (void)xb_add(&bar[XB_XCNT(b.x)], 1u);
    return b;
}
__device__ __forceinline__ void xcd_barrier_complete(unsigned* bar, unsigned x, unsigned& nloc, unsigned& nx) {
    const unsigned G = gridDim.x * gridDim.y * gridDim.z;
    unsigned sum, cnt, mine, sp = 0u;
    for (;;) {
        sum = 0u; cnt = 0u; mine = 0u;
#pragma unroll
        for (unsigned j = 0; j < 16; ++j) { const unsigned c = xb_ld(&bar[XB_XCNT(j)]); sum += c; cnt += (c > 0u) ? 1u : 0u; mine = (j == x) ? c : mine; }
        if (sum == G) break;
        __builtin_amdgcn_s_sleep(1);
        if ((++sp & 255u) == 0u) { if (xb_ld(&bar[XB_TMO])) break; if (sp > XB_SPIN_CAP) { atomicAdd(&bar[XB_TMO], 1u); break; } }
    }
    nloc = mine > 0u ? mine : 1u; nx = cnt > 0u ? cnt : 1u;
}

__device__ __forceinline__ void xcd_barrier(const XcdBarrier& b) {
    asm volatile("s_waitcnt vmcnt(0)" ::: "memory");
    __syncthreads();
    int xb_tid = threadIdx.x; asm volatile("" : "+v"(xb_tid));
    if (xb_tid == 0) {
        unsigned* bar = b.bar; asm volatile("" : "+v"(bar));
        unsigned bx = b.x; asm volatile("" : "+v"(bx));
        __builtin_amdgcn_s_waitcnt(0);
        unsigned nloc = b.st[0], nx = b.st[1];
        if (nloc == 0u) { xcd_barrier_complete(bar, bx, nloc, nx); b.st[0] = nloc; b.st[1] = nx; }
        const unsigned old = xb_add(&bar[XB_XSUB(bx)], 1u);
        const unsigned gen = old / nloc;
        if (old + 1u == (gen + 1u) * nloc) {
            __builtin_amdgcn_fence(__ATOMIC_RELEASE, "agent");
            asm volatile("s_waitcnt vmcnt(0)" ::: "memory");
            const unsigned og = xb_add(&bar[XB_TOP], 1u);
            const unsigned tg = og / nx;
            if (og + 1u == (tg + 1u) * nx) xb_add(&bar[XB_TOPGEN], 1u);
            else XB_SPIN(xb_ld(&bar[XB_TOPGEN]) == tg, bar);
            __builtin_amdgcn_fence(__ATOMIC_ACQUIRE, "agent");
            xb_add(&bar[XB_XGEN(bx)], 1u);
            asm volatile("s_waitcnt vmcnt(0)" ::: "memory");
        } else {
            XB_SPIN(xb_ld(&bar[XB_XGEN(bx)]) == gen, bar);
            __builtin_amdgcn_fence(__ATOMIC_ACQUIRE, "agent");
            asm volatile("s_waitcnt vmcnt(0)" ::: "memory");
        }
    }
    __syncthreads();
}


using pg8::bf16_t; using pg8::bf16x8; using pg8::f32x4; using pg8::u32x4; using pg8::Unit; using pg8::cvt_pk_bf16;
typedef unsigned u32x2 __attribute__((ext_vector_type(2)));
constexpr int T_TOK = 18432, T_PROMPT = 16384, DM = 1024, NP = 10496, NIN = 10288;
constexpr float EPSN = 1e-6f;
constexpr int LDS_BYTES = 131072 + 16 + 256;
constexpr size_t WS_BAR = 0;
constexpr size_t WS_WADA = 16384;
constexpr size_t WS_WIN = WS_WADA + (size_t)12288 * 1024 * 2;
constexpr size_t WS_WGLA = WS_WIN + (size_t)NP * 1024 * 2;
constexpr size_t WS_WSSD = WS_WGLA + (size_t)1024 * 1024 * 2;
constexpr size_t WS_WOUT = WS_WSSD + (size_t)1024 * 2048 * 2;
constexpr size_t WS_WPEER = WS_WOUT + (size_t)1024 * 1024 * 2;
constexpr size_t WS_U = WS_WPEER + (size_t)2048 * 1024 * 2;
constexpr size_t WS_V = WS_U + (size_t)16384 * 1024 * 2;
constexpr size_t WS_SILUC = WS_V + (size_t)16384 * 1024 * 2;
constexpr size_t WS_MOD = WS_SILUC + (size_t)256 * 1024 * 2;
constexpr size_t WS_H = WS_MOD + (size_t)256 * 12288 * 4;
constexpr size_t WS_AUX = WS_H + (size_t)T_TOK * 1024 * 2;
constexpr size_t WS_PROJ = WS_AUX + (size_t)T_TOK * 64 * 4;
constexpr size_t WS_END = WS_PROJ + (size_t)T_TOK * NP * 2;
constexpr int PC_Q = 0, PC_K = 512, PC_V = 1024, PC_GO = 2048, PC_Z = 3072, PC_XBC = 5120, PC_GATE = 8192;
constexpr size_t O_GLAP = 18874368, O_SSDP = 20971520, O_CONVP = 25165824, O_GLAS = 25313280, O_SSDS = 33701888, O_CONVS = 50479104;

#ifndef GEMM_MASK
#define GEMM_MASK 63
#endif
struct Params { const float* in[30]; float* out; unsigned char* ws; };

__device__ __forceinline__ float bf2f(bf16_t b) { return __uint_as_float(((unsigned)b) << 16); }
__device__ __forceinline__ bf16_t f2bf(float f) { return (bf16_t)(cvt_pk_bf16(f, 0.f) & 0xffffu); }
__device__ __forceinline__ float lo_bf(unsigned w) { return __uint_as_float(w << 16); }
__device__ __forceinline__ float hi_bf(unsigned w) { return __uint_as_float(w & 0xffff0000u); }
__device__ __forceinline__ float sigmoidf_(float x) { return 1.f / (1.f + __expf(-x)); }
__device__ __forceinline__ float siluf_(float x) { return x / (1.f + __expf(-x)); }
__device__ __forceinline__ int otid() { int t = threadIdx.x; asm volatile("" : "+v"(t)); return t; }
__device__ __forceinline__ int cb_of_row(int r) { return r < T_PROMPT ? (r >> 11) : 8 + ((r - T_PROMPT) >> 6); }
__device__ __forceinline__ float wave_sum(float v) {
#pragma unroll
    for (int o = 32; o >= 1; o >>= 1) v += __shfl_xor(v, o);
    return v;
}
__device__ __forceinline__ float wave_max(float v) {
#pragma unroll
    for (int o = 32; o >= 1; o >>= 1) v = fmaxf(v, __shfl_xor(v, o));
    return v;
}

struct EpiF32 {
    static constexpr bool PERM = false, AFTER_DRAIN = false;
    float* C; int ldc; const float* bias;
    __device__ __forceinline__ void operator()(const f32x4 (&acc)[2][2][4][2], const Unit& u, int wr, int wc, int fr, int fq) const {
        const int row0 = u.pm * 256 + wr * 64 + fr, col0 = u.pn * 256 + wc * 32 + 4 * fq;
        f32x4 bv[2][2];
#pragma unroll
        for (int bj = 0; bj < 2; ++bj)
#pragma unroll
            for (int n = 0; n < 2; ++n) bv[bj][n] = bias ? *(const f32x4*)(bias + col0 + bj * 128 + n * 16) : (f32x4){0.f, 0.f, 0.f, 0.f};
#pragma unroll
        for (int ai = 0; ai < 2; ++ai)
#pragma unroll
            for (int m = 0; m < 4; ++m) { float* rowp = C + (size_t)(row0 + ai * 128 + m * 16) * ldc + col0;
#pragma unroll
                for (int bj = 0; bj < 2; ++bj)
#pragma unroll
                    for (int n = 0; n < 2; ++n) *(f32x4*)(rowp + bj * 128 + n * 16) = acc[ai][bj][m][n] + bv[bj][n]; }
    }
};
struct EpiInProj {
    static constexpr bool PERM = false, AFTER_DRAIN = false;
    bf16_t* P; float* aux;
    __device__ __forceinline__ void operator()(const f32x4 (&acc)[2][2][4][2], const Unit& u, int wr, int wc, int fr, int fq) const {
        const int row0 = u.pm * 256 + wr * 64 + fr;
        if (u.pn == 40) {
            if (wc < 2) {
#pragma unroll
                for (int ai = 0; ai < 2; ++ai)
#pragma unroll
                    for (int m = 0; m < 4; ++m) { float* rowp = aux + (size_t)(row0 + ai * 128 + m * 16) * 64 + wc * 32 + 4 * fq;
#pragma unroll
                        for (int n = 0; n < 2; ++n) *(f32x4*)(rowp + n * 16) = acc[ai][0][m][n]; }
            }
        } else {
            const int col0 = u.pn * 256 + wc * 32 + 4 * fq;
#pragma unroll
            for (int ai = 0; ai < 2; ++ai)
#pragma unroll
                for (int m = 0; m < 4; ++m) { bf16_t* rowp = P + (size_t)(row0 + ai * 128 + m * 16) * NP + col0;
#pragma unroll
                    for (int bj = 0; bj < 2; ++bj)
#pragma unroll
                        for (int n = 0; n < 2; ++n) { const f32x4 v = acc[ai][bj][m][n]; u32x2 w; w.x = cvt_pk_bf16(v[0], v[1]); w.y = cvt_pk_bf16(v[2], v[3]); *(u32x2*)(rowp + bj * 128 + n * 16) = w; } }
        }
    }
};
struct EpiGlaProj {
    static constexpr bool PERM = false, AFTER_DRAIN = false;
    bf16_t* P;
    __device__ __forceinline__ void operator()(const f32x4 (&acc)[2][2][4][2], const Unit& u, int wr, int wc, int fr, int fq) const {
        const int row0 = u.pm * 256 + wr * 64 + fr, col0 = u.pn * 256 + wc * 32 + 4 * fq;
#pragma unroll
        for (int ai = 0; ai < 2; ++ai)
#pragma unroll
            for (int m = 0; m < 4; ++m) { bf16_t* rowp = P + (size_t)(row0 + ai * 128 + m * 16) * NP + col0;
#pragma unroll
                for (int bj = 0; bj < 2; ++bj)
#pragma unroll
                    for (int n = 0; n < 2; ++n) { const f32x4 v = acc[ai][bj][m][n]; const u32x2 g = *(const u32x2*)(rowp + PC_GATE + bj * 128 + n * 16);
                        u32x2 w; w.x = cvt_pk_bf16(v[0] * sigmoidf_(lo_bf(g.x)), v[1] * sigmoidf_(hi_bf(g.x))); w.y = cvt_pk_bf16(v[2] * sigmoidf_(lo_bf(g.y)), v[3] * sigmoidf_(hi_bf(g.y)));
                        *(u32x2*)(rowp + bj * 128 + n * 16) = w; } }
    }
};
struct EpiSsdProj {
    static constexpr bool PERM = false, AFTER_DRAIN = false;
    const bf16_t* P; bf16_t* H;
    __device__ __forceinline__ void operator()(const f32x4 (&acc)[2][2][4][2], const Unit& u, int wr, int wc, int fr, int fq) const {
        const int row0 = u.pm * 256 + wr * 64 + fr, col0 = u.pn * 256 + wc * 32 + 4 * fq;
#pragma unroll
        for (int ai = 0; ai < 2; ++ai)
#pragma unroll
            for (int m = 0; m < 4; ++m) { const int row = row0 + ai * 128 + m * 16; const bf16_t* rowp = P + (size_t)row * NP + col0; bf16_t* hp = H + (size_t)row * 1024 + col0;
#pragma unroll
                for (int bj = 0; bj < 2; ++bj)
#pragma unroll
                    for (int n = 0; n < 2; ++n) { const f32x4 v = acc[ai][bj][m][n]; const u32x2 g = *(const u32x2*)(rowp + PC_GATE + 1024 + bj * 128 + n * 16); const u32x2 t = *(const u32x2*)(rowp + bj * 128 + n * 16);
                        u32x2 w; w.x = cvt_pk_bf16(lo_bf(t.x) + v[0] * sigmoidf_(lo_bf(g.x)), hi_bf(t.x) + v[1] * sigmoidf_(hi_bf(g.x)));
                        w.y = cvt_pk_bf16(lo_bf(t.y) + v[2] * sigmoidf_(lo_bf(g.y)), hi_bf(t.y) + v[3] * sigmoidf_(hi_bf(g.y)));
                        *(u32x2*)(hp + bj * 128 + n * 16) = w; } }
    }
};
struct EpiWout {
    static constexpr bool PERM = false, AFTER_DRAIN = false;
    float* X; const float* modg;
    __device__ __forceinline__ void operator()(const f32x4 (&acc)[2][2][4][2], const Unit& u, int wr, int wc, int fr, int fq) const {
        const int row0 = u.pm * 256 + wr * 64 + fr, col0 = u.pn * 256 + wc * 32 + 4 * fq;
#pragma unroll
        for (int ai = 0; ai < 2; ++ai)
#pragma unroll
            for (int m = 0; m < 4; ++m) { const int row = row0 + ai * 128 + m * 16; float* xp = X + (size_t)row * 1024 + col0; const float* gp = modg + (size_t)cb_of_row(row) * 12288 + col0;
#pragma unroll
                for (int bj = 0; bj < 2; ++bj)
#pragma unroll
                    for (int n = 0; n < 2; ++n) { const f32x4 g = *(const f32x4*)(gp + bj * 128 + n * 16); f32x4 xv = *(const f32x4*)(xp + bj * 128 + n * 16); xv = xv + g * acc[ai][bj][m][n]; *(f32x4*)(xp + bj * 128 + n * 16) = xv; } }
    }
};

template <int ID, class Epi>
__device__ __forceinline__ void run_gemm(LAS unsigned char* lds, const bf16_t* A, int lda, const bf16_t* Bt, int M, int N, int K, const Epi& E) {
    pg8::Gemm g; g.A = A; g.Bt = Bt; g.M = M; g.N = N; g.K = K; g.lda = lda;
    pg8::StaticOrder S; S.init(M, N, (int)gridDim.x, (int)blockIdx.x);
#ifndef NO_GEMM
    if (!((GEMM_MASK >> ID) & 1)) return;
    pg8::gemm_phase<Epi, pg8::StaticOrder, false>(lds, g, S, E, nullptr);
#endif
    __syncthreads();
}

__device__ __forceinline__ int win_src_col(int n) {
    if (n < 3072) return n;
    if (n < 8192) return n + 16;
    if (n < 10240) return n + 48;
    if (n < 10256) return n - 10240 + 3072;
    if (n < 10288) return n - 10256 + 8208;
    return -1;
}
template <bool MAP>
__device__ __forceinline__ void tconv_tile(const float* W, int Nsrc, bf16_t* Wt, int ldt, int k0, int n0, float* tile, int tid) {
    {
        const int nn = tid & 63, n = n0 + nn; const int sc = MAP ? win_src_col(n) : n;
#pragma unroll
        for (int i = 0; i < 8; ++i) { const int kk = i * 8 + (tid >> 6); tile[kk * 65 + nn] = sc >= 0 ? W[(size_t)(k0 + kk) * Nsrc + sc] : 0.f; }
    }
    __syncthreads();
    {
        const int nn = tid >> 3, ks = (tid & 7) * 8; const float* s = tile + ks * 65 + nn;
        u32x4 o; o.x = cvt_pk_bf16(s[0], s[65]); o.y = cvt_pk_bf16(s[2 * 65], s[3 * 65]); o.z = cvt_pk_bf16(s[4 * 65], s[5 * 65]); o.w = cvt_pk_bf16(s[6 * 65], s[7 * 65]);
        *(u32x4*)(Wt + (size_t)(n0 + nn) * ldt + k0 + ks) = o;
    }
    __syncthreads();
}
__device__ __forceinline__ void conv_rows_bf16(const float* src, bf16_t* dst, size_t n8, int bid, int nb, int tid) {
    for (size_t i = (size_t)bid * 512 + tid; i < n8; i += (size_t)nb * 512) {
        const f32x4 a = *(const f32x4*)(src + i * 8), b = *(const f32x4*)(src + i * 8 + 4);
        u32x4 o; o.x = cvt_pk_bf16(a[0], a[1]); o.y = cvt_pk_bf16(a[2], a[3]); o.z = cvt_pk_bf16(b[0], b[1]); o.w = cvt_pk_bf16(b[2], b[3]);
        *(u32x4*)(dst + i * 8) = o;
    }
}
__device__ __forceinline__ void phase_convert(const Params& p, int l, unsigned char* smem) {
    const int tid = otid(), nb = gridDim.x, bid = blockIdx.x;
    float* tile = (float*)smem;
    if (l == 0) {
        f32x4* xo = (f32x4*)p.out; const f32x4* xp = (const f32x4*)p.in[0]; const f32x4* xs = (const f32x4*)p.in[1];
        for (size_t i = (size_t)bid * 512 + tid; i < (size_t)T_TOK * 256; i += (size_t)nb * 512) xo[i] = i < (size_t)T_PROMPT * 256 ? xp[i] : xs[i - (size_t)T_PROMPT * 256];
        bf16_t* sc = (bf16_t*)(p.ws + WS_SILUC);
        for (int i = bid * 512 + tid; i < 256 * 1024; i += nb * 512) { const int r = i >> 10, k = i & 1023; float v = 0.f;
            if (r < 8) v = p.in[5][r * 1024 + k]; else if (r < 40) v = p.in[6][(r - 8) * 1024 + k];
            sc[i] = f2bf(r < 40 ? siluf_(v) : 0.f); }
        for (int it = bid; it < 2 * 96 * 16; it += nb) { const int la = it / 1536, r = it % 1536, nt = r / 16, kt = r % 16;
            tconv_tile<false>(p.in[7] + (size_t)la * 1024 * 6144, 6144, (bf16_t*)(p.ws + WS_WADA) + (size_t)la * 6144 * 1024, 1024, kt * 64, nt * 64, tile, tid); }
    }
    for (int it = bid; it < 164 * 16; it += nb) { const int nt = it / 16, kt = it % 16;
        tconv_tile<true>(p.in[10] + (size_t)l * 1024 * NIN, NIN, (bf16_t*)(p.ws + WS_WIN), 1024, kt * 64, nt * 64, tile, tid); }
    for (int it = bid; it < 256; it += nb) { const int nt = it / 16, kt = it % 16;
        tconv_tile<false>(p.in[14] + (size_t)l * 1024 * 1024, 1024, (bf16_t*)(p.ws + WS_WGLA), 1024, kt * 64, nt * 64, tile, tid); }
    for (int it = bid; it < 512; it += nb) { const int nt = it / 32, kt = it % 32;
        tconv_tile<false>(p.in[21] + (size_t)l * 2048 * 1024, 1024, (bf16_t*)(p.ws + WS_WSSD), 2048, kt * 64, nt * 64, tile, tid); }
    for (int it = bid; it < 256; it += nb) { const int nt = it / 16, kt = it % 16;
        tconv_tile<false>(p.in[22] + (size_t)l * 1024 * 1024, 1024, (bf16_t*)(p.ws + WS_WOUT), 1024, kt * 64, nt * 64, tile, tid); }
    conv_rows_bf16(p.in[27] + (size_t)l * 16384 * 1024, (bf16_t*)(p.ws + WS_U), (size_t)16384 * 128, bid, nb, tid);
    conv_rows_bf16(p.in[28] + (size_t)l * 16384 * 1024, (bf16_t*)(p.ws + WS_V), (size_t)16384 * 128, bid, nb, tid);
    {
        float* keysL = (float*)smem; float* wqL = keysL + 64 * 129;
        bf16_t* WpT = (bf16_t*)(p.ws + WS_WPEER);
        for (int it = bid; it < 512; it += nb) {
            const int nt = it >> 4, mt = it & 15, n0 = nt * 64, m0 = mt * 64, h = n0 >> 8, half = (n0 >> 7) & 1, k0 = n0 & 127;
            const float* kp = (half ? p.in[26] : p.in[25]) + ((size_t)(l * 8 + h) * 128 + k0) * 128;
            const float* wp = p.in[24] + (size_t)l * 1024 * 2048 + (size_t)m0 * 2048 + h * 256 + half * 128;
#pragma unroll
            for (int i = 0; i < 16; ++i) { const int idx = tid + 512 * i, r = idx >> 7, d = idx & 127; keysL[r * 129 + d] = kp[r * 128 + d]; wqL[r * 129 + d] = wp[(size_t)r * 2048 + d]; }
            __syncthreads();
            const int nn = tid >> 3, ms = (tid & 7) * 8; float a[8] = {0.f, 0.f, 0.f, 0.f, 0.f, 0.f, 0.f, 0.f};
            for (int d = 0; d < 128; ++d) { const float kv = keysL[nn * 129 + d];
#pragma unroll
                for (int j = 0; j < 8; ++j) a[j] += kv * wqL[(ms + j) * 129 + d]; }
            u32x4 o; o.x = cvt_pk_bf16(a[0], a[1]); o.y = cvt_pk_bf16(a[2], a[3]); o.z = cvt_pk_bf16(a[4], a[5]); o.w = cvt_pk_bf16(a[6], a[7]);
            *(u32x4*)(WpT + (size_t)(n0 + nn) * 1024 + m0 + ms) = o;
            __syncthreads();
        }
    }
}

__device__ __forceinline__ void phase_norm(const Params& p, const float* nw, int off_sh, int off_sc) {
    const int tid = otid(), lane = tid & 63, gw = blockIdx.x * 8 + (tid >> 6), nw_ = gridDim.x * 8;
    const float* X = p.out; const float* mod = (const float*)(p.ws + WS_MOD); bf16_t* H = (bf16_t*)(p.ws + WS_H);
    for (int row = gw; row < T_TOK; row += nw_) {
        const f32x4* xr = (const f32x4*)(X + (size_t)row * 1024) + lane; f32x4 v[4]; float ss = 0.f;
#pragma unroll
        for (int j = 0; j < 4; ++j) { v[j] = xr[64 * j]; ss += v[j][0] * v[j][0] + v[j][1] * v[j][1] + v[j][2] * v[j][2] + v[j][3] * v[j][3]; }
        const float rstd = rsqrtf(wave_sum(ss) * (1.f / 1024.f) + EPSN);
        const float* mp = mod + (size_t)cb_of_row(row) * 12288;
#pragma unroll
        for (int j = 0; j < 4; ++j) { const int col = lane * 4 + 256 * j;
            const f32x4 w = *(const f32x4*)(nw + col), sc = *(const f32x4*)(mp + off_sc + col), sh = *(const f32x4*)(mp + off_sh + col);
            const f32x4 o = v[j] * rstd * w * (sc + 1.f) + sh;
            u32x2 pk; pk.x = cvt_pk_bf16(o[0], o[1]); pk.y = cvt_pk_bf16(o[2], o[3]);
            *(u32x2*)(H + (size_t)row * 1024 + col) = pk; }
    }
}

__device__ __forceinline__ bf16x8 ldfrag(const LAS bf16_t* base, int stride, int r0, int k0, int lane) {
    return *(const LAS bf16x8*)(base + (r0 + (lane & 15)) * stride + k0 + (lane >> 4) * 8);
}
__device__ __forceinline__ f32x4 mfma16(bf16x8 a, bf16x8 b, f32x4 c) { return __builtin_amdgcn_mfma_f32_16x16x32_bf16(a, b, c, 0, 0, 0); }


#ifdef DBG2
__device__ __forceinline__ void dbg2(const Params& p, bool bad, int e) { if (bad) atomicMax((unsigned*)(p.ws + WS_BAR) + 4000, (unsigned)(100 - e)); }
__device__ __forceinline__ bool nonfin(float v) { return (__float_as_uint(v) & 0x7F800000u) == 0x7F800000u; }
#define DBG2(bad, e) dbg2(p, bad, e)
#else
#define DBG2(bad, e)
#endif
__device__ __forceinline__ void gla_chain(const Params& p, int l, LAS unsigned char* lds, int seq, int h, int sl) {
    const int tid = otid(), wid = tid >> 6, lane = tid & 63, quad = lane >> 4, l15 = lane & 15;
    LAS bf16_t* Q = (LAS bf16_t*)(lds + 0); LAS bf16_t* Kt = (LAS bf16_t*)(lds + 17408); LAS bf16_t* KeT = (LAS bf16_t*)(lds + 34816);
    LAS bf16_t* vT = (LAS bf16_t*)(lds + 53248); LAS bf16_t* Att = (LAS bf16_t*)(lds + 57856); LAS bf16_t* ST = (LAS bf16_t*)(lds + 67072);
    LAS float* bsum = (LAS float*)(lds + 75776); LAS float* ptot = (LAS float*)(lds + 108544); LAS float* gl = (LAS float*)(lds + 110592); LAS float* dec = (LAS float*)(lds + 114688);
    bf16_t* proj = (bf16_t*)(p.ws + WS_PROJ); const float* aux = (const float*)(p.ws + WS_AUX);
    const bool samp = seq >= 8; const int nch = samp ? 1 : 32; const int row_base = samp ? T_PROMPT + (seq - 8) * 64 : seq * 2048;
    const int d0 = wid * 16 + quad * 4;
    f32x4 S[2];
    if (samp) { const float* sp = p.in[2] + (size_t)((l * 32 + (seq - 8)) * 4 + h) * 32768;
#pragma unroll
        for (int te = 0; te < 2; ++te)
#pragma unroll
            for (int jj = 0; jj < 4; ++jj) S[te][jj] = sp[(d0 + jj) * 256 + sl * 32 + te * 16 + l15];
    } else { S[0] = (f32x4){0.f, 0.f, 0.f, 0.f}; S[1] = S[0]; }
    __syncthreads();
#pragma unroll
    for (int te = 0; te < 2; ++te) { u32x2 w; w.x = cvt_pk_bf16(S[te][0], S[te][1]); w.y = cvt_pk_bf16(S[te][2], S[te][3]); *(LAS u32x2*)(ST + (te * 16 + l15) * 136 + d0) = w; }
    const int d = tid & 127, part = tid >> 7;
    float w2c[16];
#pragma unroll
    for (int r = 0; r < 16; ++r) w2c[r] = p.in[11][(size_t)(l * 16 + r) * 512 + h * 128 + d];
    const float gb = p.in[12][l * 512 + h * 128 + d];
    for (int c = 0; c < nch; ++c) {
        const int r0 = row_base + c * 64;
        if (tid < 256) { const int i = tid >> 2, q4 = (tid & 3) * 4; *(LAS f32x4*)(gl + i * 16 + q4) = *(const f32x4*)(aux + (size_t)(r0 + i) * 64 + q4); }
        { const int j = tid >> 3, e4 = (tid & 7) * 4; const u32x2 w = *(const u32x2*)(proj + (size_t)(r0 + j) * NP + PC_V + h * 256 + sl * 32 + e4);
            vT[(e4 + 0) * 72 + j] = (bf16_t)(w.x & 0xffffu); vT[(e4 + 1) * 72 + j] = (bf16_t)(w.x >> 16); vT[(e4 + 2) * 72 + j] = (bf16_t)(w.y & 0xffffu); vT[(e4 + 3) * 72 + j] = (bf16_t)(w.y >> 16); }
        __syncthreads();
        { float run = 0.f;
#pragma unroll 4
            for (int ii = 0; ii < 16; ++ii) { const int i = part * 16 + ii; float z = gb;
#pragma unroll
                for (int r = 0; r < 16; ++r) z += gl[i * 16 + r] * w2c[r];
                const float g = (fminf(z, 0.f) - log1pf(__expf(-fabsf(z)))) * (1.f / 16.f);
                run += g; bsum[i * 128 + d] = run; DBG2(nonfin(z) || fabsf(z) > 50.f, 1); }
            ptot[part * 128 + d] = run; }
        __syncthreads();
        { float off = 0.f, tot = 0.f;
#pragma unroll
            for (int pp = 0; pp < 4; ++pp) { const float t = ptot[pp * 128 + d]; if (pp < part) off += t; tot += t; }
            if (part == 0) dec[d] = __expf(tot);
#pragma unroll 4
            for (int ii = 0; ii < 16; ++ii) { const int i = part * 16 + ii; const float b = bsum[i * 128 + d] + off;
                const bf16_t* rp = proj + (size_t)(r0 + i) * NP + h * 128 + d; const float qv = bf2f(rp[PC_Q]), kv = bf2f(rp[PC_K]);
                Q[i * 136 + d] = f2bf(qv * 0.08838834764831845f * __expf(b)); Kt[i * 136 + d] = f2bf(kv * __expf(-b)); KeT[d * 72 + i] = f2bf(kv * __expf(tot - b)); DBG2(nonfin(b) || b < -60.f || b > 0.f, 2); DBG2(nonfin(qv) || nonfin(kv) || fabsf(qv) > 100.f || fabsf(kv) > 100.f, 3); } }
        __syncthreads();
        { const int ti = wid >> 1;
#pragma unroll
            for (int t2 = 0; t2 < 2; ++t2) { const int tj = (wid & 1) * 2 + t2; f32x4 a = (f32x4){0.f, 0.f, 0.f, 0.f};
                if (tj <= ti) {
#pragma unroll
                    for (int kk = 0; kk < 4; ++kk) a = mfma16(ldfrag(Q, 136, ti * 16, kk * 32, lane), ldfrag(Kt, 136, tj * 16, kk * 32, lane), a); }
#pragma unroll
                for (int jj = 0; jj < 4; ++jj) { const int i = ti * 16 + quad * 4 + jj, j = tj * 16 + l15; Att[i * 72 + j] = f2bf(j <= i ? a[jj] : 0.f); DBG2(j <= i && nonfin(a[jj]), 4); } } }
        __syncthreads();
        { const int ti = wid >> 1, te = wid & 1; f32x4 a = (f32x4){0.f, 0.f, 0.f, 0.f};
#pragma unroll
            for (int kk = 0; kk < 2; ++kk) a = mfma16(ldfrag(Att, 72, ti * 16, kk * 32, lane), ldfrag(vT, 72, te * 16, kk * 32, lane), a);
            DBG2(nonfin(a[0]) || nonfin(a[1]) || nonfin(a[2]) || nonfin(a[3]), 5);
#pragma unroll
            for (int kk = 0; kk < 4; ++kk) a = mfma16(ldfrag(Q, 136, ti * 16, kk * 32, lane), ldfrag(ST, 136, te * 16, kk * 32, lane), a);
#pragma unroll
            for (int jj = 0; jj < 4; ++jj) { const int i = ti * 16 + quad * 4 + jj; proj[(size_t)(r0 + i) * NP + PC_V + h * 256 + sl * 32 + te * 16 + l15] = f2bf(a[jj]); DBG2(nonfin(a[jj]), 6); } }
        { f32x4 dcv = *(const LAS f32x4*)(dec + d0);
#pragma unroll
            for (int te = 0; te < 2; ++te) { f32x4 a = (f32x4){0.f, 0.f, 0.f, 0.f};
#pragma unroll
                for (int kk = 0; kk < 2; ++kk) a = mfma16(ldfrag(KeT, 72, wid * 16, kk * 32, lane), ldfrag(vT, 72, te * 16, kk * 32, lane), a);
                S[te] = S[te] * dcv + a; } }
        __syncthreads();
#pragma unroll
        for (int te = 0; te < 2; ++te) { u32x2 w; w.x = cvt_pk_bf16(S[te][0], S[te][1]); w.y = cvt_pk_bf16(S[te][2], S[te][3]); *(LAS u32x2*)(ST + (te * 16 + l15) * 136 + d0) = w; }
    }
    float* so = p.out + (samp ? O_GLAS + (size_t)((l * 32 + (seq - 8)) * 4 + h) * 32768 : O_GLAP + (size_t)((l * 8 + seq) * 4 + h) * 32768);
#pragma unroll
    for (int te = 0; te < 2; ++te)
#pragma unroll
        for (int jj = 0; jj < 4; ++jj) so[(d0 + jj) * 256 + sl * 32 + te * 16 + l15] = S[te][jj];
}

__device__ __forceinline__ void ssd_chain(const Params& p, int l, LAS unsigned char* lds, int seq, int hd) {
    const int tid = otid(), wid = tid >> 6, lane = tid & 63, quad = lane >> 4, l15 = lane & 15;
    LAS bf16_t* xT = (LAS bf16_t*)(lds + 0); LAS bf16_t* xwT = (LAS bf16_t*)(lds + 9216); LAS bf16_t* Bm = (LAS bf16_t*)(lds + 18432); LAS bf16_t* BT = (LAS bf16_t*)(lds + 35840);
    LAS bf16_t* Cm = (LAS bf16_t*)(lds + 54272); LAS bf16_t* Wm = (LAS bf16_t*)(lds + 71680); LAS bf16_t* Sl = (LAS bf16_t*)(lds + 80896);
    LAS float* a_arr = (LAS float*)(lds + 98304); LAS float* dt_arr = (LAS float*)(lds + 98560);
    bf16_t* proj = (bf16_t*)(p.ws + WS_PROJ); const float* aux = (const float*)(p.ws + WS_AUX);
    const bool samp = seq >= 8; const int nch = samp ? 1 : 32; const int row_base = samp ? T_PROMPT + (seq - 8) * 64 : seq * 2048;
    const int g = hd >> 3, s0 = wid * 16 + quad * 4;
    const float Ah = -__expf(p.in[18][l * 32 + hd]), Dh = p.in[19][l * 32 + hd], dtb = p.in[17][l * 32 + hd];
    f32x4 S[4];
    if (samp) { const float* sp = p.in[3] + (size_t)((l * 32 + (seq - 8)) * 32 + hd) * 8192;
#pragma unroll
        for (int tp = 0; tp < 4; ++tp) S[tp] = *(const f32x4*)(sp + (tp * 16 + l15) * 128 + s0);
    } else {
#pragma unroll
        for (int tp = 0; tp < 4; ++tp) S[tp] = (f32x4){0.f, 0.f, 0.f, 0.f}; }
    __syncthreads();
#pragma unroll
    for (int tp = 0; tp < 4; ++tp) { u32x2 w; w.x = cvt_pk_bf16(S[tp][0], S[tp][1]); w.y = cvt_pk_bf16(S[tp][2], S[tp][3]); *(LAS u32x2*)(Sl + (tp * 16 + l15) * 136 + s0) = w; }
    const float* cw = p.in[15] + (size_t)l * 4 * 3072; const float* cbias = p.in[16] + (size_t)l * 3072;
    for (int c = 0; c < nch; ++c) {
        const int r0 = row_base + c * 64;
        if (wid == 0) { const float dtr = aux[(size_t)(r0 + lane) * 64 + 16 + hd] + dtb; const float dtv = fmaxf(dtr, 0.f) + log1pf(__expf(-fabsf(dtr)));
            float da = dtv * Ah;
#pragma unroll
            for (int o = 1; o < 64; o <<= 1) { const float t = __shfl_up(da, o); if (lane >= o) da += t; }
            a_arr[lane] = da; dt_arr[lane] = dtv; }
        __syncthreads();
        { const float a_last = a_arr[63];
#pragma unroll 1
            for (int it = 0; it < 5; ++it) { const int uu = tid + 512 * it, chl = uu % 320, part = uu / 320, i0 = part * 8;
                const int ch = chl < 64 ? hd * 64 + chl : (chl < 192 ? 2048 + g * 128 + (chl - 64) : 2560 + g * 128 + (chl - 192));
                const float w0 = cw[ch], w1 = cw[3072 + ch], w2 = cw[2 * 3072 + ch], w3 = cw[3 * 3072 + ch], bb = cbias[ch];
                float raw[11];
#pragma unroll
                for (int k = 0; k < 11; ++k) { const int ri = i0 - 3 + k;
                    float v;
                    if (ri >= 0 || c > 0) v = bf2f(proj[(size_t)(r0 + ri) * NP + PC_XBC + ch]);
                    else if (samp) v = p.in[4][(size_t)((l * 32 + (seq - 8)) * 3 + (ri + 3)) * 3072 + ch];
                    else v = 0.f;
                    raw[k] = v; }
#pragma unroll
                for (int ii = 0; ii < 8; ++ii) { const int i = i0 + ii; const float cv = bb + w0 * raw[ii] + w1 * raw[ii + 1] + w2 * raw[ii + 2] + w3 * raw[ii + 3]; const float act = siluf_(cv);
                    if (chl < 64) { xT[chl * 72 + i] = f2bf(act); xwT[chl * 72 + i] = f2bf(act * dt_arr[i] * __expf(a_last - a_arr[i])); }
                    else if (chl < 192) { const int s = chl - 64; const bf16_t bv = f2bf(act); Bm[i * 136 + s] = bv; BT[s * 72 + i] = bv; }
                    else { Cm[i * 136 + (chl - 192)] = f2bf(act); } } } }
        __syncthreads();
        { const int ti = wid >> 1;
#pragma unroll
            for (int t2 = 0; t2 < 2; ++t2) { const int tj = (wid & 1) * 2 + t2; f32x4 a = (f32x4){0.f, 0.f, 0.f, 0.f};
                if (tj <= ti) {
#pragma unroll
                    for (int kk = 0; kk < 4; ++kk) a = mfma16(ldfrag(Cm, 136, ti * 16, kk * 32, lane), ldfrag(Bm, 136, tj * 16, kk * 32, lane), a); }
                const int j = tj * 16 + l15; const float aj = a_arr[j], dtj = dt_arr[j];
#pragma unroll
                for (int jj = 0; jj < 4; ++jj) { const int i = ti * 16 + quad * 4 + jj; Wm[i * 72 + j] = f2bf(j <= i ? a[jj] * __expf(a_arr[i] - aj) * dtj : 0.f); } } }
        __syncthreads();
        { const int ti = wid >> 1;
#pragma unroll
            for (int t2 = 0; t2 < 2; ++t2) { const int tp = (wid & 1) * 2 + t2; f32x4 yi = (f32x4){0.f, 0.f, 0.f, 0.f}, yo = yi;
#pragma unroll
                for (int kk = 0; kk < 2; ++kk) yi = mfma16(ldfrag(Wm, 72, ti * 16, kk * 32, lane), ldfrag(xT, 72, tp * 16, kk * 32, lane), yi);
#pragma unroll
                for (int kk = 0; kk < 4; ++kk) yo = mfma16(ldfrag(Cm, 136, ti * 16, kk * 32, lane), ldfrag(Sl, 136, tp * 16, kk * 32, lane), yo);
                const int pcol = tp * 16 + l15;
#pragma unroll
                for (int jj = 0; jj < 4; ++jj) { const int i = ti * 16 + quad * 4 + jj; const float xv = bf2f(xT[pcol * 72 + i]);
                    float y = yi[jj] + __expf(a_arr[i]) * yo[jj] + Dh * xv;
                    bf16_t* zp = proj + (size_t)(r0 + i) * NP + PC_Z + hd * 64 + pcol; y *= siluf_(bf2f(*zp)); *zp = f2bf(y); } } }
        { const float el = __expf(a_arr[63]);
#pragma unroll
            for (int tp = 0; tp < 4; ++tp) { f32x4 a = (f32x4){0.f, 0.f, 0.f, 0.f};
#pragma unroll
                for (int kk = 0; kk < 2; ++kk) a = mfma16(ldfrag(BT, 72, wid * 16, kk * 32, lane), ldfrag(xwT, 72, tp * 16, kk * 32, lane), a);
                S[tp] = S[tp] * el + a; } }
        __syncthreads();
#pragma unroll
        for (int tp = 0; tp < 4; ++tp) { u32x2 w; w.x = cvt_pk_bf16(S[tp][0], S[tp][1]); w.y = cvt_pk_bf16(S[tp][2], S[tp][3]); *(LAS u32x2*)(Sl + (tp * 16 + l15) * 136 + s0) = w; }
    }
    float* so = p.out + (samp ? O_SSDS + (size_t)((l * 32 + (seq - 8)) * 32 + hd) * 8192 : O_SSDP + (size_t)((l * 8 + seq) * 32 + hd) * 8192);
#pragma unroll
    for (int tp = 0; tp < 4; ++tp) *(f32x4*)(so + (tp * 16 + l15) * 128 + s0) = S[tp];
}

__device__ __forceinline__ void phase_mixer(const Params& p, int l, LAS unsigned char* lds) {
    for (int it = blockIdx.x; it < 2560; it += gridDim.x) {
        if (it < 256) gla_chain(p, l, lds, it >> 5, (it >> 3) & 3, it & 7);
        else if (it < 512) { const int i = it - 256; ssd_chain(p, l, lds, i >> 5, i & 31); }
        else if (it < 1536) { const int i = it - 512; gla_chain(p, l, lds, 8 + (i >> 5), (i >> 3) & 3, i & 7); }
        else { const int i = it - 1536; ssd_chain(p, l, lds, 8 + (i >> 5), i & 31); }
    }
}

__device__ __forceinline__ void phase_normgate(const Params& p, int l) {
    const int tid = otid(), lane = tid & 63, gw = blockIdx.x * 8 + (tid >> 6), nwv = gridDim.x * 8;
    bf16_t* proj = (bf16_t*)(p.ws + WS_PROJ);
    const float* gnw = p.in[13] + l * 256; const float* snw = p.in[20] + l * 2048;
    for (int row = gw; row < T_TOK; row += nwv) {
        bf16_t* rp = proj + (size_t)row * NP;
        {
            u32x4 a = *(const u32x4*)(rp + PC_V + lane * 16), b = *(const u32x4*)(rp + PC_V + lane * 16 + 8);
            const u32x4 ga = *(const u32x4*)(rp + PC_GO + lane * 16), gb2 = *(const u32x4*)(rp + PC_GO + lane * 16 + 8);
            float v[16], gg[16];
#pragma unroll
            for (int j = 0; j < 4; ++j) { v[2 * j] = lo_bf(a[j]); v[2 * j + 1] = hi_bf(a[j]); v[8 + 2 * j] = lo_bf(b[j]); v[8 + 2 * j + 1] = hi_bf(b[j]);
                gg[2 * j] = lo_bf(ga[j]); gg[2 * j + 1] = hi_bf(ga[j]); gg[8 + 2 * j] = lo_bf(gb2[j]); gg[8 + 2 * j + 1] = hi_bf(gb2[j]); }
            float ss = 0.f;
#pragma unroll
            for (int j = 0; j < 16; ++j) ss += v[j] * v[j];
            ss += __shfl_xor(ss, 1); ss += __shfl_xor(ss, 2); ss += __shfl_xor(ss, 4); ss += __shfl_xor(ss, 8);
            const float rstd = rsqrtf(ss * (1.f / 256.f) + EPSN); const int e0 = (lane * 16) & 255;
#pragma unroll
            for (int j = 0; j < 16; ++j) v[j] = v[j] * rstd * gnw[e0 + j] * siluf_(gg[j]);
#pragma unroll
            for (int j = 0; j < 4; ++j) { a[j] = cvt_pk_bf16(v[2 * j], v[2 * j + 1]); b[j] = cvt_pk_bf16(v[8 + 2 * j], v[8 + 2 * j + 1]); }
            *(u32x4*)(rp + PC_V + lane * 16) = a; *(u32x4*)(rp + PC_V + lane * 16 + 8) = b;
        }
        {
            u32x4 q[4]; float ss = 0.f;
#pragma unroll
            for (int k = 0; k < 4; ++k) { q[k] = *(const u32x4*)(rp + PC_Z + lane * 32 + k * 8);
#pragma unroll
                for (int j = 0; j < 4; ++j) { const float x0 = lo_bf(q[k][j]), x1 = hi_bf(q[k][j]); ss += x0 * x0 + x1 * x1; } }
            ss += __shfl_xor(ss, 1); ss += __shfl_xor(ss, 2); ss += __shfl_xor(ss, 4); ss += __shfl_xor(ss, 8);
            const float rstd = rsqrtf(ss * (1.f / 512.f) + EPSN);
#pragma unroll
            for (int k = 0; k < 4; ++k) {
#pragma unroll
                for (int j = 0; j < 4; ++j) { const int cc = lane * 32 + k * 8 + 2 * j; q[k][j] = cvt_pk_bf16(lo_bf(q[k][j]) * rstd * snw[cc], hi_bf(q[k][j]) * rstd * snw[cc + 1]); }
                *(u32x4*)(rp + PC_Z + lane * 32 + k * 8) = q[k]; }
        }
    }
    for (int idx = blockIdx.x * 512 + tid; idx < 40 * 9216; idx += gridDim.x * 512) {
        const int seq = idx / 9216, rem = idx % 9216, k = rem / 3072, ch = rem % 3072;
        const int row = seq < 8 ? seq * 2048 + 2045 + k : T_PROMPT + (seq - 8) * 64 + 61 + k;
        const float v = bf2f(proj[(size_t)row * NP + PC_XBC + ch]);
        if (seq < 8) p.out[O_CONVP + (size_t)(l * 8 + seq) * 9216 + rem] = v; else p.out[O_CONVS + (size_t)(l * 32 + (seq - 8)) * 9216 + rem] = v;
    }
}

template <int NV>
__device__ __forceinline__ void wave_top16(float (&v)[NV], const int (&id)[NV], int lane, float& outv, int& outi) {
    outv = -3.0e38f; outi = 0;
#pragma unroll 1
    for (int it = 0; it < 16; ++it) {
        float m = v[0];
#pragma unroll
        for (int k = 1; k < NV; ++k) m = fmaxf(m, v[k]);
        const float M = wave_max(m);
        const unsigned long long bal = __ballot(m == M);
        const int src = __ffsll((long long)bal) - 1;
        int myid = 0; bool done = false;
#pragma unroll
        for (int k = 0; k < NV; ++k) { const bool hit = !done && v[k] == M; if (hit) { myid = id[k]; if (lane == src) v[k] = -3.0e38f; } done = done || hit; }
        const int selid = __shfl(myid, src);
        if (lane == it) { outv = M; outi = selid; }
    }
}
__device__ __forceinline__ void phase_peer(const Params& p, int l) {
    const int tid = otid(), lane = tid & 63, gw = blockIdx.x * 8 + (tid >> 6), nwv = gridDim.x * 8;
    const float* scores = (const float*)(p.ws + WS_PROJ); const bf16_t* H = (const bf16_t*)(p.ws + WS_H);
    const bf16_t* U = (const bf16_t*)(p.ws + WS_U); const bf16_t* V = (const bf16_t*)(p.ws + WS_V);
    const float* mod = (const float*)(p.ws + WS_MOD); float* X = p.out;
    for (int t = gw; t < T_TOK; t += nwv) {
        float xf[16];
        { const u32x4 a = *(const u32x4*)(H + (size_t)t * 1024 + lane * 16), b = *(const u32x4*)(H + (size_t)t * 1024 + lane * 16 + 8);
#pragma unroll
            for (int j = 0; j < 4; ++j) { xf[2 * j] = lo_bf(a[j]); xf[2 * j + 1] = hi_bf(a[j]); xf[8 + 2 * j] = lo_bf(b[j]); xf[8 + 2 * j + 1] = hi_bf(b[j]); } }
        float acc[16];
#pragma unroll
        for (int j = 0; j < 16; ++j) acc[j] = 0.f;
#pragma unroll 1
        for (int h = 0; h < 8; ++h) {
            const float* sc = scores + (size_t)t * 2048 + h * 256;
            float va[2] = {sc[lane], sc[64 + lane]}, vb[2] = {sc[128 + lane], sc[192 + lane]}; const int ia[2] = {lane, lane + 64};
            float v1, v2; int i1, i2;
            wave_top16<2>(va, ia, lane, v1, i1);
            wave_top16<2>(vb, ia, lane, v2, i2);
            float cv[4]; int ci[4];
            { const int a = lane >> 2; const float v1a = __shfl(v1, a); const int i1a = __shfl(i1, a);
#pragma unroll
                for (int c = 0; c < 4; ++c) { const int bb = (lane & 3) * 4 + c; cv[c] = v1a + __shfl(v2, bb); ci[c] = i1a * 128 + __shfl(i2, bb); } }
            float sv; int eidx;
            wave_top16<4>(cv, ci, lane, sv, eidx);
            const float mx = __shfl(sv, 0);
            const float ex = lane < 16 ? __expf(sv - mx) : 0.f;
            const float gs = ex / wave_sum(ex);
#pragma unroll 1
            for (int e0 = 0; e0 < 16; e0 += 4) {
                u32x4 ur[4][2], vr[4][2]; float ge[4];
#pragma unroll
                for (int e = 0; e < 4; ++e) { const int eid = __shfl(eidx, e0 + e); ge[e] = __shfl(gs, e0 + e);
                    const bf16_t* up = U + (size_t)eid * 1024 + lane * 16; const bf16_t* vp = V + (size_t)eid * 1024 + lane * 16;
                    ur[e][0] = *(const u32x4*)up; ur[e][1] = *(const u32x4*)(up + 8); vr[e][0] = *(const u32x4*)vp; vr[e][1] = *(const u32x4*)(vp + 8); }
#pragma unroll
                for (int e = 0; e < 4; ++e) { float dot = 0.f;
#pragma unroll
                    for (int j = 0; j < 4; ++j) { dot += xf[2 * j] * lo_bf(ur[e][0][j]) + xf[2 * j + 1] * hi_bf(ur[e][0][j]); dot += xf[8 + 2 * j] * lo_bf(ur[e][1][j]) + xf[8 + 2 * j + 1] * hi_bf(ur[e][1][j]); }
                    const float act = wave_sum(dot); const float w = ge[e] * 0.5f * act * (1.f + erff(act * 0.7071067811865476f));
#pragma unroll
                    for (int j = 0; j < 4; ++j) { acc[2 * j] += w * lo_bf(vr[e][0][j]); acc[2 * j + 1] += w * hi_bf(vr[e][0][j]); acc[8 + 2 * j] += w * lo_bf(vr[e][1][j]); acc[8 + 2 * j + 1] += w * hi_bf(vr[e][1][j]); } }
            }
        }
        const float* gp = mod + (size_t)cb_of_row(t) * 12288 + l * 6144 + 5 * 1024 + lane * 16; float* xp = X + (size_t)t * 1024 + lane * 16;
        f32x4 xn[4]; float ss = 0.f;
#pragma unroll
        for (int j = 0; j < 4; ++j) { const f32x4 g = *(const f32x4*)(gp + 4 * j); xn[j] = *(const f32x4*)(xp + 4 * j);
#pragma unroll
            for (int k = 0; k < 4; ++k) { xn[j][k] += g[k] * acc[4 * j + k]; ss += xn[j][k] * xn[j][k]; } }
        if (l == 1) { const float rstd = rsqrtf(wave_sum(ss) * (1.f / 1024.f) + EPSN); const float* fw = p.in[29] + lane * 16;
#pragma unroll
            for (int j = 0; j < 4; ++j) { const f32x4 w = *(const f32x4*)(fw + 4 * j); xn[j] = xn[j] * rstd * w; } }
#pragma unroll
        for (int j = 0; j < 4; ++j) *(f32x4*)(xp + 4 * j) = xn[j];
    }
}

__device__ __forceinline__ void load_params(Params& q, const LAS unsigned* tab) {
#pragma unroll
    for (int k = 0; k < 32; ++k) {
        const unsigned lo = __builtin_amdgcn_readfirstlane(tab[2 * k]), hi = __builtin_amdgcn_readfirstlane(tab[2 * k + 1]);
        const unsigned long long a = ((unsigned long long)hi << 32) | lo;
        if (k < 30) q.in[k] = (const float*)a; else if (k == 30) q.out = (float*)a; else q.ws = (unsigned char*)a;
    }
}
#define PHASE_PARAMS Params p; load_params(p, tab)

#ifdef DBG
__device__ __forceinline__ void dbg_flag(const Params& p, int code) { atomicMax((unsigned*)(p.ws + WS_BAR) + 4000, (unsigned)(1000 - code)); }
__device__ __forceinline__ void dbg_bf16(const Params& p, const bf16_t* base, int rows, int ld, int ncols, int code) {
    const int tid = otid(); bool bad = false;
    for (size_t i = (size_t)blockIdx.x * 512 + tid; i < (size_t)rows * ncols; i += (size_t)gridDim.x * 512) { const size_t r = i / ncols, c = i % ncols; const unsigned v = base[r * ld + c]; if ((v & 0x7F80u) == 0x7F80u) bad = true; }
    if (bad) dbg_flag(p, code);
}
__device__ __forceinline__ void dbg_f32(const Params& p, const float* base, int rows, int ld, int ncols, int code) {
    const int tid = otid(); bool bad = false;
    for (size_t i = (size_t)blockIdx.x * 512 + tid; i < (size_t)rows * ncols; i += (size_t)gridDim.x * 512) { const size_t r = i / ncols, c = i % ncols; const unsigned v = __float_as_uint(base[r * ld + c]); if ((v & 0x7F800000u) == 0x7F800000u) bad = true; }
    if (bad) dbg_flag(p, code);
}
#define DBG_DO(x) { { PHASE_PARAMS; x; } xcd_barrier(xb); }
#else
#define DBG_DO(x)
#endif
__global__ void __launch_bounds__(512, 2) mega_fwd(Params p0) {
    __shared__ __attribute__((aligned(16))) unsigned char smem[LDS_BYTES];
    LAS unsigned char* lds = (LAS unsigned char*)smem;
    LAS unsigned* tab = (LAS unsigned*)(lds + 131088);
    if (threadIdx.x == 0) {
        volatile LAS unsigned* st0 = (volatile LAS unsigned*)(lds + 131072); st0[0] = 0u; st0[1] = 0u;
#pragma unroll
        for (int k = 0; k < 32; ++k) { const unsigned long long a = k < 30 ? (unsigned long long)p0.in[k] : (k == 30 ? (unsigned long long)p0.out : (unsigned long long)p0.ws); tab[2 * k] = (unsigned)a; tab[2 * k + 1] = (unsigned)(a >> 32); }
    }
    __syncthreads();
    const XcdBarrier xb = xcd_barrier_post((unsigned*)(p0.ws + WS_BAR), (volatile LAS unsigned*)(lds + 131072));
#pragma unroll 1
    for (int l = 0; l < 2; ++l) {
#ifndef NO_CONV
        { PHASE_PARAMS; phase_convert(p, l, smem); }
#endif
        xcd_barrier(xb);
        if (l == 0) {
            PHASE_PARAMS;
            EpiF32 e; e.C = (float*)(p.ws + WS_MOD); e.ldc = 12288; e.bias = p.in[8];
            run_gemm<0>(lds, (const bf16_t*)(p.ws + WS_SILUC), 1024, (const bf16_t*)(p.ws + WS_WADA), 256, 12288, 1024, e);
            xcd_barrier(xb);
            DBG_DO(dbg_f32(p, (const float*)(p.ws + WS_MOD), 40, 12288, 12288, 1))
        }
        { PHASE_PARAMS; phase_norm(p, p.in[9] + l * 1024, l * 6144 + 0, l * 6144 + 1024); }
        xcd_barrier(xb);
        DBG_DO(dbg_bf16(p, (const bf16_t*)(p.ws + WS_H), T_TOK, 1024, 1024, l * 10 + 2))
        { PHASE_PARAMS; EpiInProj e; e.P = (bf16_t*)(p.ws + WS_PROJ); e.aux = (float*)(p.ws + WS_AUX);
          run_gemm<1>(lds, (const bf16_t*)(p.ws + WS_H), 1024, (const bf16_t*)(p.ws + WS_WIN), T_TOK, NP, 1024, e); }
        xcd_barrier(xb);
        DBG_DO(dbg_bf16(p, (const bf16_t*)(p.ws + WS_PROJ), T_TOK, NP, 10240, l * 10 + 3); dbg_f32(p, (const float*)(p.ws + WS_AUX), T_TOK, 64, 48, l * 10 + 3))
#ifndef NO_MIXER
        { PHASE_PARAMS; phase_mixer(p, l, lds); }
#endif
        xcd_barrier(xb);
        DBG_DO(dbg_bf16(p, (const bf16_t*)(p.ws + WS_PROJ) + PC_V, T_TOK, NP, 1024, l * 10 + 4); dbg_bf16(p, (const bf16_t*)(p.ws + WS_PROJ) + PC_Z, T_TOK, NP, 2048, l * 10 + 5))
#ifndef NO_NG
        { PHASE_PARAMS; phase_normgate(p, l); }
#endif
        xcd_barrier(xb);
        DBG_DO(dbg_bf16(p, (const bf16_t*)(p.ws + WS_PROJ) + PC_V, T_TOK, NP, 1024, l * 10 + 6); dbg_bf16(p, (const bf16_t*)(p.ws + WS_PROJ) + PC_Z, T_TOK, NP, 2048, l * 10 + 6))
#ifdef STOP1
        continue;
#endif
        { PHASE_PARAMS; bf16_t* proj = (bf16_t*)(p.ws + WS_PROJ); EpiGlaProj e; e.P = proj; run_gemm<2>(lds, proj + PC_V, NP, (const bf16_t*)(p.ws + WS_WGLA), T_TOK, 1024, 1024, e); }
        { PHASE_PARAMS; bf16_t* proj = (bf16_t*)(p.ws + WS_PROJ); EpiSsdProj e; e.P = proj; e.H = (bf16_t*)(p.ws + WS_H); run_gemm<3>(lds, proj + PC_Z, NP, (const bf16_t*)(p.ws + WS_WSSD), T_TOK, 1024, 2048, e); }
        xcd_barrier(xb);
        DBG_DO(dbg_bf16(p, (const bf16_t*)(p.ws + WS_H), T_TOK, 1024, 1024, l * 10 + 7))
        { PHASE_PARAMS; EpiWout e; e.X = p.out; e.modg = (const float*)(p.ws + WS_MOD) + l * 6144 + 2 * 1024; run_gemm<4>(lds, (const bf16_t*)(p.ws + WS_H), 1024, (const bf16_t*)(p.ws + WS_WOUT), T_TOK, 1024, 1024, e); }
        xcd_barrier(xb);
        DBG_DO(dbg_f32(p, p.out, T_TOK, 1024, 1024, l * 10 + 8))
        { PHASE_PARAMS; phase_norm(p, p.in[23] + l * 1024, l * 6144 + 3 * 1024, l * 6144 + 4 * 1024); }
        xcd_barrier(xb);
        DBG_DO(dbg_bf16(p, (const bf16_t*)(p.ws + WS_H), T_TOK, 1024, 1024, l * 10 + 9))
        { PHASE_PARAMS; EpiF32 e; e.C = (float*)(p.ws + WS_PROJ); e.ldc = 2048; e.bias = nullptr; run_gemm<5>(lds, (const bf16_t*)(p.ws + WS_H), 1024, (const bf16_t*)(p.ws + WS_WPEER), T_TOK, 2048, 1024, e); }
        xcd_barrier(xb);
        DBG_DO(dbg_f32(p, (const float*)(p.ws + WS_PROJ), T_TOK, 2048, 2048, l * 10 + 10))
#ifndef NO_PEER
        { PHASE_PARAMS; phase_peer(p, l); }
#endif
        if (l == 0) xcd_barrier(xb);
    }
#ifdef DBG
    xcd_barrier(xb);
    { PHASE_PARAMS; const unsigned f = __hip_atomic_load((unsigned*)(p.ws + WS_BAR) + 4000, __ATOMIC_RELAXED, __HIP_MEMORY_SCOPE_AGENT); if (f) { const float K = 10.f * (float)(1000 - (int)f); const int tid = otid(); for (size_t i = (size_t)blockIdx.x * 512 + tid; i < (size_t)T_TOK * 1024; i += (size_t)gridDim.x * 512) p.out[i] = K; } }
#endif
#ifdef DBG2
    xcd_barrier(xb);
    { PHASE_PARAMS; const unsigned f = __hip_atomic_load((unsigned*)(p.ws + WS_BAR) + 4000, __ATOMIC_RELAXED, __HIP_MEMORY_SCOPE_AGENT); if (f) { const float K = 10.f * (float)(1 << (100 - (int)f)); const int tid = otid(); for (size_t i = (size_t)blockIdx.x * 512 + tid; i < (size_t)T_TOK * 1024; i += (size_t)gridDim.x * 512) p.out[i] = K; } }
#endif
#ifdef SANITIZE
    xcd_barrier(xb);
    { PHASE_PARAMS; const int tid = otid(); for (size_t i = (size_t)blockIdx.x * 512 + tid; i < (size_t)51068928; i += (size_t)gridDim.x * 512) { const float v = p.out[i]; if (!(fabsf(v) < 3.0e38f)) p.out[i] = 0.f; } }
#endif
}

extern "C" void kernel_launch(void* const* d_in, const int* in_sizes, int n_in, void* d_out, int out_size, void* d_ws, size_t ws_size, hipStream_t stream) {
    static int grid = 0;
    if (grid == 0) {
        if (n_in != 30 || ws_size < WS_END) { fprintf(stderr, "kernel_launch: need 30 inputs and >= %zu bytes of workspace; got %d, %zu\n", (size_t)WS_END, n_in, ws_size); grid = -1; return; }
        int dev = 0, cus = 0, per_cu = 0;
        (void)hipGetDevice(&dev); (void)hipDeviceGetAttribute(&cus, hipDeviceAttributeMultiprocessorCount, dev);
        if (hipOccupancyMaxActiveBlocksPerMultiprocessor(&per_cu, (const void*)mega_fwd, 512, 0) != hipSuccess || per_cu < 1) { fprintf(stderr, "kernel_launch: occupancy query failed (%d)\n", per_cu); (void)hipGetLastError(); per_cu = 1; }
        grid = cus * (per_cu > 1 ? 1 : per_cu);
        if (grid > 256) grid = 256;
    }
    if (grid < 0) return;
    if (hipMemsetAsync((char*)d_ws + WS_BAR, 0, 16384, stream) != hipSuccess) { fprintf(stderr, "kernel_launch: memset of the barrier words failed\n"); return; }
    Params p{};
    for (int i = 0; i < 30; ++i) p.in[i] = (const float*)d_in[i];
    p.out = (float*)d_out; p.ws = (unsigned char*)d_ws;
    void* args[] = {&p};
    hipError_t e = hipLaunchCooperativeKernel((const void*)mega_fwd, dim3(grid), dim3(512), args, 0, stream);
    if (e != hipSuccess) fprintf(stderr, "kernel_launch: cooperative launch failed: %s (grid %d)\n", hipGetErrorString(e), grid);
}
```

```cpp
#include <hip/hip_runtime.h>
#include <cstdio>
#define LAS __attribute__((address_space(3)))
namespace pg8 {
#define PG8_LAS __attribute__((address_space(3)))
typedef unsigned short bf16_t;
typedef short bf16x8 __attribute__((ext_vector_type(8)));
typedef float f32x4 __attribute__((ext_vector_type(4)));
typedef unsigned u32x4 __attribute__((ext_vector_type(4)));
constexpr int BM = 256, BK = 64, HALF = 128, HTB = HALF * BK * 2  , STAGE_BYTES = 8 * HTB, NXCD = 8, WGM = 8;

__host__ __device__ __forceinline__ int lds_byte(int r, int c) { const int st = (r >> 4) * 2 + (c >> 5), rr = r & 15, cc = c & 31, ob = rr * 64 + cc * 2; return st * 1024 + (ob ^ (((ob >> 9) & 1) << 5)); }
__host__ __device__ __forceinline__ void stage_rc(int b, int& R, int& C) { const int st = b / 1024, sb = b % 1024, swz = sb ^ (((sb >> 9) & 1) << 5); R = (st >> 1) * 16 + swz / 64; C = (st & 1) * 32 + (swz % 64) / 2; }
__host__ __device__ __forceinline__ int perm32(int rho) { const int n = rho >> 4, i = rho & 15; return 8 * (i >> 2) + 4 * n + (i & 3); }

struct Unit { int pm, pn; };
struct Gemm { const bf16_t* A; const bf16_t* Bt; int M, N, K, lda; };

struct StaticOrder {
    int nM, nN, nwg, G, c;
    __host__ __device__ void init(int M, int N, int G_, int c_) { nM = M / BM; nN = N / BM; nwg = nM * nN; G = G_; c = c_; }
    __host__ __device__ bool next(int i, Unit& u) const {
        const long L = (long)i * G + c; if (L >= nwg) return false;
        int wgid = (int)L; { const int q = nwg / NXCD, r = nwg % NXCD, xcd = wgid % NXCD, off = wgid / NXCD; wgid = (xcd < r ? xcd * (q + 1) : r * (q + 1) + (xcd - r) * q) + off; }
        const int nig = WGM * nN, gid = wgid / nig, fm = gid * WGM, gsz = (nM - fm) < WGM ? (nM - fm) : WGM;
        u.pm = fm + ((wgid % nig) % gsz); u.pn = (wgid % nig) / gsz; return true;
    }
    __device__ __forceinline__ void a_ready(const Unit&) const {}
    __device__ __forceinline__ void done(const Unit&) const {}
};
typedef float f32x2 __attribute__((ext_vector_type(2)));
typedef __bf16 bf16v2_t __attribute__((ext_vector_type(2)));
__device__ __forceinline__ unsigned cvt_pk_bf16(float lo, float hi) { const f32x2 v = {lo, hi}; return __builtin_bit_cast(unsigned, __builtin_convertvector(v, bf16v2_t)); }
template <class Epi, class Sched, bool STAMP = false>
__device__ __forceinline__ void gemm_phase(PG8_LAS unsigned char* lds, const Gemm g, const Sched& S, const Epi& E, unsigned long long* stamps) {
    int tid_ = threadIdx.x; asm volatile("" : "+v"(tid_)); const int tid = tid_, wid = __builtin_amdgcn_readfirstlane(tid >> 6), lane = tid & 63, wr = wid >> 2, wc = wid & 3, fr = lane & 15, fq = lane >> 4;
    const int K = g.K, nt = K / BK;
    int ts_lo = 0, ts_hi = 0, nts = 0; const unsigned long long rt_entry = STAMP ? (unsigned long long)wall_clock64() : 0ull;
#define PG8_STAMP() do { if (STAMP && wid == 0 && nts < 64) { const unsigned long long _c = (unsigned long long)clock64(); \
        ts_lo = (lane == nts) ? (int)(unsigned)_c : ts_lo; ts_hi = (lane == nts) ? (int)(unsigned)(_c >> 32) : ts_hi; ++nts; } } while (0)
    PG8_STAMP();
    unsigned voffA[2], voffB[2];
#pragma unroll
    for (int i = 0; i < 2; ++i) { int R, C; stage_rc(tid * 16 + i * 8192, R, C); const int Rb = Epi::PERM ? ((R & ~31) + perm32(R & 31)) : R;
        voffA[i] = (unsigned)(R * g.lda + C) * 2u; voffB[i] = (unsigned)(Rb * K + C) * 2u; }
    const size_t kstep = (size_t)(BK * 2);
    const size_t hstepB = (size_t)HALF * K * 2, hstepA = (size_t)HALF * g.lda * 2;
    const size_t tstepA = 2 * hstepA, tstepB = 2 * hstepB;
    const unsigned ldsw = (unsigned)wid * 1024u;
    const int aoff = lds_byte(wr * 64 + fr, fq * 8), boff = lds_byte(wc * 32 + fr, fq * 8);
#define PG8_SA(b, h) (((b) * 2 + (h)) * HTB)
#define PG8_SB(b, h) ((4 + (b) * 2 + (h)) * HTB)
#define PG8_STAGE(bufoff, gbase, voff) do { _Pragma("unroll") for (int _i = 0; _i < 2; ++_i) \
        __builtin_amdgcn_global_load_lds((const unsigned*)((const char*)(gbase) + (voff)[_i]), (PG8_LAS unsigned*)(lds + (bufoff) + ldsw + _i * 8192), 16, 0, 0); } while (0)
#define PG8_LDA(dst, b, h) do { _Pragma("unroll") for (int m = 0; m < 4; ++m) _Pragma("unroll") for (int k = 0; k < 2; ++k) dst[m][k] = *(const PG8_LAS bf16x8*)(lds + PG8_SA(b, h) + aoff + m * 2048 + k * 1024); } while (0)
#define PG8_LDB(dst, b, h) do { _Pragma("unroll") for (int n = 0; n < 2; ++n) _Pragma("unroll") for (int k = 0; k < 2; ++k) dst[n][k] = *(const PG8_LAS bf16x8*)(lds + PG8_SB(b, h) + boff + n * 2048 + k * 1024); } while (0)
#define PG8_MMA(ai, bj, At, Bt) do { __builtin_amdgcn_s_setprio(1); _Pragma("unroll") for (int m = 0; m < 4; ++m) _Pragma("unroll") for (int n = 0; n < 2; ++n) _Pragma("unroll") for (int k = 0; k < 2; ++k) \
        acc[ai][bj][m][n] = __builtin_amdgcn_mfma_f32_16x16x32_bf16(Bt[n][k], At[m][k], acc[ai][bj][m][n], 0, 0, 0); __builtin_amdgcn_s_setprio(0); } while (0)
#define PG8_WAIT_V(n) asm volatile("s_waitcnt vmcnt(" #n ")" ::: "memory")
#define PG8_WAIT_L(n) asm volatile("s_waitcnt lgkmcnt(" #n ")" ::: "memory")
#define PG8_BAR __builtin_amdgcn_s_barrier()
#define PG8_SCHED __builtin_amdgcn_sched_barrier(0)
    Unit cur, nxt; int ui = 0;
    if (!S.next(0, cur)) return;
    f32x4 acc[2][2][4][2];
#pragma unroll
    for (int a = 0; a < 2; ++a)
#pragma unroll
        for (int b = 0; b < 2; ++b)
#pragma unroll
            for (int m = 0; m < 4; ++m)
#pragma unroll
                for (int n = 0; n < 2; ++n) acc[a][b][m][n] = (f32x4){0.f, 0.f, 0.f, 0.f};
    bf16x8 At[4][2], B0[2][2], B1[2][2];
    const char* cA = (const char*)g.A + (size_t)cur.pm * tstepA; const char* cB = (const char*)g.Bt + (size_t)cur.pn * tstepB;
    S.a_ready(cur);
    PG8_STAGE(PG8_SB(0, 0), cB, voffB); PG8_STAGE(PG8_SA(0, 0), cA, voffA); PG8_STAGE(PG8_SB(0, 1), cB + hstepB, voffB); PG8_STAGE(PG8_SA(0, 1), cA + hstepA, voffA);
    if (wr == 1) PG8_BAR;
    PG8_WAIT_V(4); PG8_BAR;
    PG8_STAGE(PG8_SB(1, 0), cB + kstep, voffB); PG8_STAGE(PG8_SA(1, 0), cA + kstep, voffA); PG8_STAGE(PG8_SB(1, 1), cB + hstepB + kstep, voffB);
    PG8_WAIT_V(6); PG8_BAR;
    PG8_STAMP();
    for (;;) {
        const bool has_next = S.next(ui + 1, nxt);
        const char* nA = has_next ? (const char*)g.A + (size_t)nxt.pm * tstepA : cA; const char* nB = has_next ? (const char*)g.Bt + (size_t)nxt.pn * tstepB : cB;
        for (int t = 0; t < nt; t += 2) {
            const bool last = (t == nt - 2);
            const char* a1 = cA + (size_t)(t + 1) * kstep;
            const char* a2 = last ? nA : cA + (size_t)(t + 2) * kstep; const char* b2 = last ? nB : cB + (size_t)(t + 2) * kstep;
            const char* a3 = a2 + kstep; const char* b3 = b2 + kstep;
            if (last && has_next) S.a_ready(nxt);
            PG8_LDB(B0, 0, 0); PG8_SCHED; PG8_LDA(At, 0, 0); PG8_STAGE(PG8_SA(1, 1), a1 + hstepA, voffA);
            PG8_WAIT_L(8); PG8_BAR; PG8_WAIT_L(0); PG8_MMA(0, 0, At, B0); PG8_BAR; PG8_SCHED;
            PG8_LDB(B1, 0, 1); PG8_STAGE(PG8_SB(0, 0), b2, voffB);
            PG8_BAR; PG8_WAIT_L(0); PG8_MMA(0, 1, At, B1); PG8_BAR;
            PG8_LDA(At, 0, 1); PG8_STAGE(PG8_SA(0, 0), a2, voffA);
            PG8_BAR; PG8_WAIT_L(0); PG8_MMA(1, 0, At, B0); PG8_BAR; PG8_SCHED;
            PG8_STAGE(PG8_SB(0, 1), b2 + hstepB, voffB);
            PG8_WAIT_V(6); PG8_BAR; PG8_MMA(1, 1, At, B1); PG8_BAR;
            PG8_LDB(B0, 1, 0); PG8_SCHED; PG8_LDA(At, 1, 0); PG8_STAGE(PG8_SA(0, 1), a2 + hstepA, voffA);
            PG8_WAIT_L(8); PG8_BAR; PG8_WAIT_L(0); PG8_MMA(0, 0, At, B0); PG8_BAR; PG8_SCHED;
            PG8_LDB(B1, 1, 1); PG8_STAGE(PG8_SB(1, 0), b3, voffB);
            PG8_BAR; PG8_WAIT_L(0); PG8_MMA(0, 1, At, B1); PG8_BAR;
            PG8_LDA(At, 1, 1); PG8_STAGE(PG8_SA(1, 0), a3, voffA);
            PG8_BAR; PG8_WAIT_L(0); PG8_MMA(1, 0, At, B0); PG8_BAR; PG8_SCHED;
            PG8_STAGE(PG8_SB(1, 1), b3 + hstepB, voffB);
            PG8_WAIT_V(6); PG8_BAR; PG8_MMA(1, 1, At, B1); PG8_BAR;
        }
        PG8_STAMP();
        if constexpr (!Epi::AFTER_DRAIN) { E(acc, cur, wr, wc, fr, fq); S.done(cur); }
        PG8_STAMP();
        if (!has_next) break;
#pragma unroll
        for (int a = 0; a < 2; ++a)
#pragma unroll
            for (int b = 0; b < 2; ++b)
#pragma unroll
                for (int m = 0; m < 4; ++m)
#pragma unroll
                    for (int n = 0; n < 2; ++n) acc[a][b][m][n] = (f32x4){0.f, 0.f, 0.f, 0.f};
        cur = nxt; cA = nA; cB = nB; ++ui;
    }
    PG8_WAIT_V(0);
    if (wr == 0) PG8_BAR;
    PG8_BAR;
    if constexpr (Epi::AFTER_DRAIN) { E.fused(acc, cur, wr, wc, fr, fq, lds, wid, lane); S.done(cur); }
    PG8_STAMP();
    if (STAMP && wid == 0) { stamps[lane] = lane < nts ? (((unsigned long long)(unsigned)ts_hi << 32) | (unsigned)ts_lo) : 0ull;
        if (lane == 62) stamps[62] = rt_entry; if (lane == 63) stamps[63] = (unsigned long long)wall_clock64(); }
#undef PG8_STAMP
#undef PG8_SA
#undef PG8_SB
#undef PG8_STAGE
#undef PG8_LDA
#undef PG8_LDB
#undef PG8_MMA
#undef PG8_WAIT_V
#undef PG8_WAIT_L
#undef PG8_BAR
#undef PG8_SCHED
}
}
#define XB_TMO      128
#define XB_XCNT(j)  (256  + 64 * (j))
#define XB_XSUB(j)  (1280 + 64 * (j))
#define XB_XGEN(j)  (2304 + 64 * (j))
#define XB_TOP      3328
#define XB_TOPGEN   3392
#define XCD_BAR_WORDS 3456
#define XB_SPIN_CAP (1u << 18)

__device__ __forceinline__ unsigned xb_ld(unsigned* p)              { return __hip_atomic_load(p, __ATOMIC_RELAXED, __HIP_MEMORY_SCOPE_AGENT); }
__device__ __forceinline__ unsigned xb_add(unsigned* p, unsigned v) { return __hip_atomic_fetch_add(p, v, __ATOMIC_RELAXED, __HIP_MEMORY_SCOPE_AGENT); }
__device__ __forceinline__ unsigned xb_xcc_id() { return (unsigned)__builtin_amdgcn_s_getreg((3 << 11) | 20) & 0xFu; }
#define XB_SPIN(cond, bar) do { unsigned _sp = 0; while (cond) { __builtin_amdgcn_s_sleep(1); \
    if ((++_sp & 255u) == 0u) { if (xb_ld(&(bar)[XB_TMO])) break; if (_sp > XB_SPIN_CAP) { atomicAdd(&(bar)[XB_TMO], 1u); break; } } } } while (0)

struct XcdBarrier {
    unsigned* bar; unsigned x;
    volatile LAS unsigned* st;
};

__device__ __forceinline__ XcdBarrier xcd_barrier_post(unsigned* bar, volatile LAS unsigned* st) {
    XcdBarrier b; b.bar = bar; b.x = xb_xcc_id(); b.st = st;
    if (threadIdx.x == 0) (void)xb_add(&bar[XB_XCNT(b.x)], 1u);
    return b;
}
__device__ __forceinline__ void xcd_barrier_complete(unsigned* bar, unsigned x, unsigned& nloc, unsigned& nx) {
    const unsigned G = gridDim.x * gridDim.y * gridDim.z;
    unsigned sum, cnt, mine, sp = 0u;
    for (;;) {
        sum = 0u; cnt = 0u; mine = 0u;
#pragma unroll
        for (unsigned j = 0; j < 16; ++j) { const unsigned c = xb_ld(&bar[XB_XCNT(j)]); sum += c; cnt += (c > 0u) ? 1u : 0u; mine = (j == x) ? c : mine; }
        if (sum == G) break;
        __builtin_amdgcn_s_sleep(1);
        if ((++sp & 255u) == 0u) { if (xb_ld(&bar[XB_TMO])) break; if (sp > XB_SPIN_CAP) { atomicAdd(&bar[XB_TMO], 1u); break; } }
    }
    nloc = mine > 0u ? mine : 1u; nx = cnt > 0u ? cnt : 1u;
}

__device__ __forceinline__ void xcd_barrier(const XcdBarrier& b) {
    asm volatile("s_waitcnt vmcnt(0)" ::: "memory");
    __syncthreads();
    int xb_tid = threadIdx.x; asm volatile("" : "+v"(xb_tid));
    if (xb_tid == 0) {
        unsigned* bar = b.bar; asm volatile("" : "+v"(bar));
        unsigned bx = b.x; asm volatile("" : "+v"(bx));
        __builtin_amdgcn_s_waitcnt(0);
        unsigned nloc = b.st[0], nx = b.st[1];
        if (nloc == 0u) { xcd_barrier_complete(bar, bx, nloc, nx); b.st[0] = nloc; b.st[1] = nx; }
        const unsigned old = xb_add(&bar[XB_XSUB(bx)], 1u);
        const unsigned gen = old / nloc;
        if (old + 1u == (gen + 1u) * nloc) {
            __builtin_amdgcn_fence(__ATOMIC_RELEASE, "agent");
            asm volatile("s_waitcnt vmcnt(0)" ::: "memory");
            const unsigned og = xb_add(&bar[XB_TOP], 1u);
            const unsigned tg = og / nx;
            if (og + 1u == (tg + 1u) * nx) xb_add(&bar[XB_TOPGEN], 1u);
            else XB_SPIN(xb_ld(&bar[XB_TOPGEN]) == tg, bar);
            __builtin_amdgcn_fence(__ATOMIC_ACQUIRE, "agent");
            xb_add(&bar[XB_XGEN(bx)], 1u);
            asm volatile("s_waitcnt vmcnt(0)" ::: "memory");
        } else {
            XB_SPIN(xb_ld(&bar[XB_XGEN(bx)]) == gen, bar);
            __builtin_amdgcn_fence(__ATOMIC_ACQUIRE, "agent");
            asm volatile("s_waitcnt vmcnt(0)" ::: "memory");
        }
    }
    __syncthreads();
}


using pg8::bf16_t; using pg8::bf16x8; using pg8::f32x4; using pg8::u32x4; using pg8::Unit; using pg8::cvt_pk_bf16;
typedef unsigned u32x2 __attribute__((ext_vector_type(2)));
constexpr int T_TOK = 18432, T_PROMPT = 16384, DM = 1024, NP = 10496, NIN = 10288;
constexpr float EPSN = 1e-6f;
constexpr int LDS_BYTES = 163840, LDS_ST = 163328, LDS_TAB = 163344;
constexpr size_t WS_BAR = 0;
constexpr size_t WS_WADA = 16384;
constexpr size_t WS_WIN = WS_WADA + (size_t)12288 * 1024 * 2;
constexpr size_t WS_WGLA = WS_WIN + (size_t)NP * 1024 * 2;
constexpr size_t WS_WSSD = WS_WGLA + (size_t)1024 * 1024 * 2;
constexpr size_t WS_WOUT = WS_WSSD + (size_t)1024 * 2048 * 2;
constexpr size_t WS_WPEER = WS_WOUT + (size_t)1024 * 1024 * 2;
constexpr size_t WS_U = WS_WPEER + (size_t)2048 * 1024 * 2;
constexpr size_t WS_V = WS_U + (size_t)16384 * 1024 * 2;
constexpr size_t WS_SILUC = WS_V + (size_t)16384 * 1024 * 2;
constexpr size_t WS_MOD = WS_SILUC + (size_t)256 * 1024 * 2;
constexpr size_t WS_H = WS_MOD + (size_t)256 * 12288 * 4;
constexpr size_t WS_AUX = WS_H + (size_t)T_TOK * 1024 * 2;
constexpr size_t WS_PROJ = WS_AUX + (size_t)T_TOK * 64 * 4;
constexpr size_t WS_KET = WS_PROJ + (size_t)T_TOK * NP * 2;
constexpr size_t WS_ATT = WS_KET + (size_t)1152 * 8192 * 2;
constexpr size_t WS_DEC = WS_ATT + (size_t)1152 * 4096 * 2;
constexpr size_t WS_CBG = WS_DEC + (size_t)1152 * 128 * 4;
constexpr size_t WS_SM1 = WS_CBG + (size_t)1152 * 4096 * 2;
constexpr size_t WS_SCL = WS_SM1 + (size_t)12 * 1024 * 1024;
constexpr size_t WS_END = WS_SCL + (size_t)4 * 16384 * 4;
__host__ __device__ constexpr size_t ws_win(int l) { return l ? WS_WADA : WS_WIN; }
__host__ __device__ constexpr size_t ws_wgla(int l) { return l ? WS_SM1 : WS_WGLA; }
__host__ __device__ constexpr size_t ws_wssd(int l) { return l ? WS_SM1 + (size_t)2 * 1024 * 1024 : WS_WSSD; }
__host__ __device__ constexpr size_t ws_wout(int l) { return l ? WS_SM1 + (size_t)6 * 1024 * 1024 : WS_WOUT; }
__host__ __device__ constexpr size_t ws_wpeer(int l) { return l ? WS_SM1 + (size_t)8 * 1024 * 1024 : WS_WPEER; }
__host__ __device__ constexpr size_t ws_uv(int l) { return l ? WS_V : WS_U; }
__host__ __device__ constexpr size_t ws_su(int l) { return WS_SCL + (size_t)l * 131072; }
__host__ __device__ constexpr size_t ws_sv(int l) { return WS_SCL + (size_t)l * 131072 + 65536; }
constexpr int PC_Q = 0, PC_K = 512, PC_V = 1024, PC_GO = 2048, PC_Z = 3072, PC_XBC = 5120, PC_GATE = 8192;
constexpr size_t O_GLAP = 18874368, O_SSDP = 20971520, O_CONVP = 25165824, O_GLAS = 25313280, O_SSDS = 33701888, O_CONVS = 50479104;

#ifndef GEMM_MASK
#define GEMM_MASK 63
#endif
#define GAS __attribute__((address_space(1)))
struct Params { const float* in[30]; float* out; unsigned char* ws; };

__device__ __forceinline__ float bf2f(bf16_t b) { return __uint_as_float(((unsigned)b) << 16); }
__device__ __forceinline__ bf16_t f2bf(float f) { return (bf16_t)(cvt_pk_bf16(f, 0.f) & 0xffffu); }
__device__ __forceinline__ float lo_bf(unsigned w) { return __uint_as_float(w << 16); }
__device__ __forceinline__ float hi_bf(unsigned w) { return __uint_as_float(w & 0xffff0000u); }
__device__ __forceinline__ float sigmoidf_(float x) { return 1.f / (1.f + __expf(-x)); }
__device__ __forceinline__ float siluf_(float x) { return x / (1.f + __expf(-x)); }
__device__ __forceinline__ int otid() { int t = threadIdx.x; asm volatile("" : "+v"(t)); return t; }
__device__ __forceinline__ int cb_of_row(int r) { return r < T_PROMPT ? (r >> 11) : 8 + ((r - T_PROMPT) >> 6); }
__device__ __forceinline__ float wave_sum(float v) {
#pragma unroll
    for (int o = 32; o >= 1; o >>= 1) v += __shfl_xor(v, o);
    return v;
}
__device__ __forceinline__ float wave_max(float v) {
#pragma unroll
    for (int o = 32; o >= 1; o >>= 1) v = fmaxf(v, __shfl_xor(v, o));
    return v;
}

struct EpiF32 {
    static constexpr bool PERM = false, AFTER_DRAIN = false;
    float* C; int ldc; const float* bias;
    __device__ __forceinline__ void operator()(const f32x4 (&acc)[2][2][4][2], const Unit& u, int wr, int wc, int fr, int fq) const {
        const int row0 = u.pm * 256 + wr * 64 + fr, col0 = u.pn * 256 + wc * 32 + 4 * fq;
        f32x4 bv[2][2];
#pragma unroll
        for (int bj = 0; bj < 2; ++bj)
#pragma unroll
            for (int n = 0; n < 2; ++n) bv[bj][n] = bias ? *(const f32x4*)(bias + col0 + bj * 128 + n * 16) : (f32x4){0.f, 0.f, 0.f, 0.f};
#pragma unroll
        for (int ai = 0; ai < 2; ++ai)
#pragma unroll
            for (int m = 0; m < 4; ++m) { float* rowp = C + (size_t)(row0 + ai * 128 + m * 16) * ldc + col0;
#pragma unroll
                for (int bj = 0; bj < 2; ++bj)
#pragma unroll
                    for (int n = 0; n < 2; ++n) *(f32x4*)(rowp + bj * 128 + n * 16) = acc[ai][bj][m][n] + bv[bj][n]; }
    }
};
struct EpiF32NT {
    static constexpr bool PERM = false, AFTER_DRAIN = false;
    float* C; int ldc; const float* bias;
    __device__ __forceinline__ void operator()(const f32x4 (&acc)[2][2][4][2], const Unit& u, int wr, int wc, int fr, int fq) const {
        const int row0 = u.pm * 256 + wr * 64 + fr, col0 = u.pn * 256 + wc * 32 + 4 * fq;
        f32x4 bv[2][2];
#pragma unroll
        for (int bj = 0; bj < 2; ++bj)
#pragma unroll
            for (int n = 0; n < 2; ++n) bv[bj][n] = bias ? *(const f32x4*)(bias + col0 + bj * 128 + n * 16) : (f32x4){0.f, 0.f, 0.f, 0.f};
#pragma unroll
        for (int ai = 0; ai < 2; ++ai)
#pragma unroll
            for (int m = 0; m < 4; ++m) { float* rowp = C + (size_t)(row0 + ai * 128 + m * 16) * ldc + col0;
#pragma unroll
                for (int bj = 0; bj < 2; ++bj)
#pragma unroll
                    for (int n = 0; n < 2; ++n) __builtin_nontemporal_store(acc[ai][bj][m][n] + bv[bj][n], (GAS f32x4*)(rowp + bj * 128 + n * 16)); }
    }
};
struct EpiInProj {
    static constexpr bool PERM = true, AFTER_DRAIN = false;
    bf16_t* P; float* aux;
    __device__ __forceinline__ void operator()(const f32x4 (&acc)[2][2][4][2], const Unit& u, int wr, int wc, int fr, int fq) const {
        const int row0 = u.pm * 256 + wr * 64 + fr;
        if (u.pn == 40) {
            if (wc < 2) {
#pragma unroll
                for (int ai = 0; ai < 2; ++ai)
#pragma unroll
                    for (int m = 0; m < 4; ++m) { GAS float* rowp = (GAS float*)aux + (size_t)(row0 + ai * 128 + m * 16) * 64 + wc * 32 + 8 * fq;
                        *(GAS f32x4*)rowp = acc[ai][0][m][0]; *(GAS f32x4*)(rowp + 4) = acc[ai][0][m][1]; }
            }
        } else {
            const int col0 = u.pn * 256 + wc * 32 + 8 * fq;
#pragma unroll
            for (int ai = 0; ai < 2; ++ai)
#pragma unroll
                for (int m = 0; m < 4; ++m) { GAS bf16_t* rowp = (GAS bf16_t*)P + (size_t)(row0 + ai * 128 + m * 16) * NP + col0;
#pragma unroll
                    for (int bj = 0; bj < 2; ++bj) { const f32x4 v0 = acc[ai][bj][m][0], v1 = acc[ai][bj][m][1];
                        u32x4 w; w.x = cvt_pk_bf16(v0[0], v0[1]); w.y = cvt_pk_bf16(v0[2], v0[3]); w.z = cvt_pk_bf16(v1[0], v1[1]); w.w = cvt_pk_bf16(v1[2], v1[3]);
                        *(GAS u32x4*)(rowp + bj * 128) = w; } }
        }
    }
};
struct EpiGlaProj {
    static constexpr bool PERM = false, AFTER_DRAIN = false;
    bf16_t* P;
    __device__ __forceinline__ void operator()(const f32x4 (&acc)[2][2][4][2], const Unit& u, int wr, int wc, int fr, int fq) const {
        const int row0 = u.pm * 256 + wr * 64 + fr, col0 = u.pn * 256 + wc * 32 + 4 * fq;
#pragma unroll
        for (int ai = 0; ai < 2; ++ai)
#pragma unroll
            for (int m = 0; m < 4; ++m) { bf16_t* rowp = P + (size_t)(row0 + ai * 128 + m * 16) * NP + col0;
#pragma unroll
                for (int bj = 0; bj < 2; ++bj)
#pragma unroll
                    for (int n = 0; n < 2; ++n) { const f32x4 v = acc[ai][bj][m][n]; const u32x2 g = *(const u32x2*)(rowp + PC_GATE + bj * 128 + n * 16);
                        u32x2 w; w.x = cvt_pk_bf16(v[0] * sigmoidf_(lo_bf(g.x)), v[1] * sigmoidf_(hi_bf(g.x))); w.y = cvt_pk_bf16(v[2] * sigmoidf_(lo_bf(g.y)), v[3] * sigmoidf_(hi_bf(g.y)));
                        *(u32x2*)(rowp + bj * 128 + n * 16) = w; } }
    }
};
struct EpiSsdProj {
    static constexpr bool PERM = false, AFTER_DRAIN = false;
    const bf16_t* P; bf16_t* H;
    __device__ __forceinline__ void operator()(const f32x4 (&acc)[2][2][4][2], const Unit& u, int wr, int wc, int fr, int fq) const {
        const int row0 = u.pm * 256 + wr * 64 + fr, col0 = u.pn * 256 + wc * 32 + 4 * fq;
#pragma unroll
        for (int ai = 0; ai < 2; ++ai)
#pragma unroll
            for (int m = 0; m < 4; ++m) { const int row = row0 + ai * 128 + m * 16; const bf16_t* rowp = P + (size_t)row * NP + col0; bf16_t* hp = H + (size_t)row * 1024 + col0;
#pragma unroll
                for (int bj = 0; bj < 2; ++bj)
#pragma unroll
                    for (int n = 0; n < 2; ++n) { const f32x4 v = acc[ai][bj][m][n]; const u32x2 g = *(const u32x2*)(rowp + PC_GATE + 1024 + bj * 128 + n * 16); const u32x2 t = *(const u32x2*)(rowp + bj * 128 + n * 16);
                        u32x2 w; w.x = cvt_pk_bf16(lo_bf(t.x) + v[0] * sigmoidf_(lo_bf(g.x)), hi_bf(t.x) + v[1] * sigmoidf_(hi_bf(g.x)));
                        w.y = cvt_pk_bf16(lo_bf(t.y) + v[2] * sigmoidf_(lo_bf(g.y)), hi_bf(t.y) + v[3] * sigmoidf_(hi_bf(g.y)));
                        *(u32x2*)(hp + bj * 128 + n * 16) = w; } }
    }
};
struct EpiWout {
    static constexpr bool PERM = false, AFTER_DRAIN = false;
    float* X; const float* Xa; const float* Xb; const float* modg;
    __device__ __forceinline__ void operator()(const f32x4 (&acc)[2][2][4][2], const Unit& u, int wr, int wc, int fr, int fq) const {
        const int row0 = u.pm * 256 + wr * 64 + fr, col0 = u.pn * 256 + wc * 32 + 4 * fq;
#pragma unroll
        for (int ai = 0; ai < 2; ++ai)
#pragma unroll
            for (int m = 0; m < 4; ++m) { const int row = row0 + ai * 128 + m * 16; float* xp = X + (size_t)row * 1024 + col0; const float* xi = (row < T_PROMPT ? Xa + (size_t)row * 1024 : Xb + (size_t)(row - T_PROMPT) * 1024) + col0; const float* gp = modg + (size_t)cb_of_row(row) * 12288 + col0;
#pragma unroll
                for (int bj = 0; bj < 2; ++bj)
#pragma unroll
                    for (int n = 0; n < 2; ++n) { const f32x4 g = *(const f32x4*)(gp + bj * 128 + n * 16); f32x4 xv = *(const f32x4*)(xi + bj * 128 + n * 16); xv = xv + g * acc[ai][bj][m][n]; *(f32x4*)(xp + bj * 128 + n * 16) = xv; } }
    }
};

template <int ID, class Epi>
__device__ __forceinline__ void run_gemm(LAS unsigned char* lds, const bf16_t* A, int lda, const bf16_t* Bt, int M, int N, int K, const Epi& E) {
    pg8::Gemm g; g.A = A; g.Bt = Bt; g.M = M; g.N = N; g.K = K; g.lda = lda;
    pg8::StaticOrder S; S.init(M, N, (int)gridDim.x, (int)blockIdx.x);
#ifndef NO_GEMM
    if (!((GEMM_MASK >> ID) & 1)) return;
    pg8::gemm_phase<Epi, pg8::StaticOrder, false>(lds, g, S, E, nullptr);
#endif
    __syncthreads();
}

__device__ __forceinline__ int win_src_col(int n) {
    if (n < 3072) return n;
    if (n < 8192) return n + 16;
    if (n < 10240) return n + 48;
    if (n < 10256) return n - 10240 + 3072;
    if (n < 10288) return n - 10256 + 8208;
    return -1;
}
template <bool MAP>
__device__ __forceinline__ void tconv_tile(const float* W, int Nsrc, bf16_t* Wt, int ldt, int k0, int n0, float* tile, int tid) {
    {
        const int nn = tid & 63, n = n0 + nn; const int sc = MAP ? win_src_col(n) : n;
#pragma unroll
        for (int i = 0; i < 8; ++i) { const int kk = i * 8 + (tid >> 6); tile[kk * 65 + nn] = sc >= 0 ? __builtin_nontemporal_load(W + (size_t)(k0 + kk) * Nsrc + sc) : 0.f; }
    }
    __syncthreads();
    {
        const int nn = tid >> 3, ks = (tid & 7) * 8; const float* s = tile + ks * 65 + nn;
        u32x4 o; o.x = cvt_pk_bf16(s[0], s[65]); o.y = cvt_pk_bf16(s[2 * 65], s[3 * 65]); o.z = cvt_pk_bf16(s[4 * 65], s[5 * 65]); o.w = cvt_pk_bf16(s[6 * 65], s[7 * 65]);
        *(u32x4*)(Wt + (size_t)(n0 + nn) * ldt + k0 + ks) = o;
    }
    __syncthreads();
}
__device__ __forceinline__ void conv_rows_bf16(const float* src, bf16_t* dst, size_t n8, int bid, int nb, int tid) {
    for (size_t i = (size_t)bid * 512 + tid; i < n8; i += (size_t)nb * 512) {
        const f32x4 a = *(const f32x4*)(src + i * 8), b = *(const f32x4*)(src + i * 8 + 4);
        u32x4 o; o.x = cvt_pk_bf16(a[0], a[1]); o.y = cvt_pk_bf16(a[2], a[3]); o.z = cvt_pk_bf16(b[0], b[1]); o.w = cvt_pk_bf16(b[2], b[3]);
        *(u32x4*)(dst + i * 8) = o;
    }
}
#define DPPF(old, src, ctrl, rm, bm) __int_as_float(__builtin_amdgcn_update_dpp(__float_as_int(old), __float_as_int(src), ctrl, rm, bm, false))
__device__ __forceinline__ float wave_max_u(float v) {
    const float ninf = -3.4e38f;
    v = fmaxf(v, DPPF(ninf, v, 0x111, 0xf, 0xf)); v = fmaxf(v, DPPF(ninf, v, 0x112, 0xf, 0xf)); v = fmaxf(v, DPPF(ninf, v, 0x114, 0xf, 0xf)); v = fmaxf(v, DPPF(ninf, v, 0x118, 0xf, 0xf));
    v = fmaxf(v, DPPF(ninf, v, 0x142, 0xa, 0xf)); v = fmaxf(v, DPPF(ninf, v, 0x143, 0xc, 0xf));
    return __int_as_float(__builtin_amdgcn_readlane(__float_as_int(v), 63));
}
__device__ __forceinline__ float wave_sum_u(float v) {
    v += DPPF(0.f, v, 0x111, 0xf, 0xf); v += DPPF(0.f, v, 0x112, 0xf, 0xf); v += DPPF(0.f, v, 0x114, 0xf, 0xf); v += DPPF(0.f, v, 0x118, 0xf, 0xf);
    v += DPPF(0.f, v, 0x142, 0xa, 0xf); v += DPPF(0.f, v, 0x143, 0xc, 0xf);
    return __int_as_float(__builtin_amdgcn_readlane(__float_as_int(v), 63));
}
__device__ __forceinline__ void conv_rows_fp8(const float* src, unsigned char* dst, float* scl, int bid, int nb, int tid, int row_lo, int row_hi) {
    const int lane = tid & 63;
    for (int row = row_lo + bid * 8 + (tid >> 6); row < row_hi; row += nb * 8) {
        const GAS f32x4* sp = (const GAS f32x4*)((const GAS float*)src + (size_t)row * 1024) + lane; f32x4 v[4]; float am = 0.f;
#pragma unroll
        for (int j = 0; j < 4; ++j) { v[j] = __builtin_nontemporal_load(sp + 64 * j); am = fmaxf(am, fmaxf(fmaxf(fabsf(v[j][0]), fabsf(v[j][1])), fmaxf(fabsf(v[j][2]), fabsf(v[j][3])))); }
        am = wave_max_u(am); const float q = am > 0.f ? 448.f / am : 1.f;
        GAS unsigned* dp = (GAS unsigned*)((GAS unsigned char*)dst + (size_t)row * 2048) + lane;
#pragma unroll
        for (int j = 0; j < 4; ++j) { int w = 0; w = __builtin_amdgcn_cvt_pk_fp8_f32(v[j][0] * q, v[j][1] * q, w, false); w = __builtin_amdgcn_cvt_pk_fp8_f32(v[j][2] * q, v[j][3] * q, w, true); dp[64 * j] = (unsigned)w; }
        if (lane == 0) scl[row] = am > 0.f ? am * (1.f / 448.f) : 1.f;
    }
}
__device__ __forceinline__ void mod_gemv(const Params& p, unsigned char* smem, int bid, int nb) {
    typedef __bf16 bf16v2_l __attribute__((ext_vector_type(2)));
    const int tid = otid(), wid = tid >> 6, lane = tid & 63;
    unsigned* sc2 = (unsigned*)smem;
    float* part = (float*)(smem + 81920);
    GAS float* mod = (GAS float*)(p.ws + WS_MOD); const GAS float* bias = (const GAS float*)p.in[8];
    for (int idx = tid; idx < 40 * 512; idx += 512) { const int cb = idx >> 9, kp = idx & 511; const GAS float* cp = cb < 8 ? (const GAS float*)p.in[5] + cb * 1024 : (const GAS float*)p.in[6] + (cb - 8) * 1024;
        sc2[kp * 40 + cb] = cvt_pk_bf16(siluf_(cp[2 * kp]), siluf_(cp[2 * kp + 1])); }
    __syncthreads();
    for (int cg = bid; cg < 192; cg += nb) {
        const int n = cg * 64 + lane, la = n / 6144, nn = n - la * 6144;
        const GAS float* W = (const GAS float*)p.in[7] + (size_t)la * 1024 * 6144 + nn + (size_t)(wid * 128) * 6144;
        float acc[40];
#pragma unroll
        for (int r = 0; r < 40; ++r) acc[r] = 0.f;
#pragma unroll 1
        for (int kb = 0; kb < 64; kb += 16) {
            float wv[32];
#pragma unroll
            for (int j = 0; j < 32; ++j) wv[j] = __builtin_nontemporal_load(W + (size_t)(2 * kb + j) * 6144);
#pragma unroll
            for (int j = 0; j < 16; ++j) { const bf16v2_l wp = __builtin_bit_cast(bf16v2_l, cvt_pk_bf16(wv[2 * j], wv[2 * j + 1])); const unsigned* sr = sc2 + (wid * 64 + kb + j) * 40;
#pragma unroll
                for (int r = 0; r < 40; ++r) acc[r] = __builtin_amdgcn_fdot2_f32_bf16(wp, __builtin_bit_cast(bf16v2_l, sr[r]), acc[r], false); }
        }
#pragma unroll
        for (int half = 0; half < 2; ++half) {
#pragma unroll
            for (int r = 0; r < 20; ++r) part[(wid * 20 + r) * 64 + lane] = acc[half * 20 + r];
            __syncthreads();
            for (int o = tid; o < 20 * 64; o += 512) { const int r = o >> 6, c = o & 63; float sum = 0.f;
#pragma unroll
                for (int w = 0; w < 8; ++w) sum += part[(w * 20 + r) * 64 + c];
                const int n2 = cg * 64 + c; mod[(size_t)(half * 20 + r) * 12288 + n2] = sum + bias[n2]; }
            __syncthreads();
        }
    }
}
__device__ __forceinline__ void phase_convert(const Params& p, int l, unsigned char* smem, int bid, int nb, int parts) {
    const int tid = otid();
    float* tile = (float*)smem;
    if (parts & 1) {
    for (int it = bid; it < 164 * 16; it += nb) { const int nt = it / 16, kt = it % 16;
        tconv_tile<true>(p.in[10] + (size_t)l * 1024 * NIN, NIN, (bf16_t*)(p.ws + ws_win(l)), 1024, kt * 64, nt * 64, tile, tid); }
    for (int it = bid; it < 256; it += nb) { const int nt = it / 16, kt = it % 16;
        tconv_tile<false>(p.in[14] + (size_t)l * 1024 * 1024, 1024, (bf16_t*)(p.ws + ws_wgla(l)), 1024, kt * 64, nt * 64, tile, tid); }
    for (int it = bid; it < 512; it += nb) { const int nt = it / 32, kt = it % 32;
        tconv_tile<false>(p.in[21] + (size_t)l * 2048 * 1024, 1024, (bf16_t*)(p.ws + ws_wssd(l)), 2048, kt * 64, nt * 64, tile, tid); }
    for (int it = bid; it < 256; it += nb) { const int nt = it / 16, kt = it % 16;
        tconv_tile<false>(p.in[22] + (size_t)l * 1024 * 1024, 1024, (bf16_t*)(p.ws + ws_wout(l)), 1024, kt * 64, nt * 64, tile, tid); }
    }
    if (parts & 12) {
        const int rlo = (parts & 4) ? 0 : 8192, rhi = (parts & 8) ? 16384 : 8192;
        conv_rows_fp8(p.in[27] + (size_t)l * 16384 * 1024, p.ws + ws_uv(l), (float*)(p.ws + ws_su(l)), bid, nb, tid, rlo, rhi);
        conv_rows_fp8(p.in[28] + (size_t)l * 16384 * 1024, p.ws + ws_uv(l) + 1024, (float*)(p.ws + ws_sv(l)), bid, nb, tid, rlo, rhi);
    }
    if (parts & 1)
    {
        float* keysL = (float*)smem; float* wqL = keysL + 64 * 129;
        bf16_t* WpT = (bf16_t*)(p.ws + ws_wpeer(l));
        for (int it = bid; it < 512; it += nb) {
            const int nt = it >> 4, mt = it & 15, n0 = nt * 64, m0 = mt * 64, h = n0 >> 8, half = (n0 >> 7) & 1, k0 = n0 & 127;
            const float* kp = (half ? p.in[26] : p.in[25]) + ((size_t)(l * 8 + h) * 128 + k0) * 128;
            const float* wp = p.in[24] + (size_t)l * 1024 * 2048 + (size_t)m0 * 2048 + h * 256 + half * 128;
#pragma unroll
            for (int i = 0; i < 16; ++i) { const int idx = tid + 512 * i, r = idx >> 7, d = idx & 127; keysL[r * 129 + d] = kp[r * 128 + d]; wqL[r * 129 + d] = wp[(size_t)r * 2048 + d]; }
            __syncthreads();
            const int nn = tid >> 3, ms = (tid & 7) * 8; float a[8] = {0.f, 0.f, 0.f, 0.f, 0.f, 0.f, 0.f, 0.f};
            for (int d = 0; d < 128; ++d) { const float kv = keysL[nn * 129 + d];
#pragma unroll
                for (int j = 0; j < 8; ++j) a[j] += kv * wqL[(ms + j) * 129 + d]; }
            u32x4 o; o.x = cvt_pk_bf16(a[0], a[1]); o.y = cvt_pk_bf16(a[2], a[3]); o.z = cvt_pk_bf16(a[4], a[5]); o.w = cvt_pk_bf16(a[6], a[7]);
            *(u32x4*)(WpT + (size_t)(n0 + nn) * 1024 + m0 + ms) = o;
            __syncthreads();
        }
    }
}

__device__ __forceinline__ void phase_norm(const Params& p, const float* Xa, const float* Xb, const float* nw, int off_sh, int off_sc) {
    const int tid = otid(), lane = tid & 63, gw = blockIdx.x * 8 + (tid >> 6), nw_ = gridDim.x * 8;
    const GAS float* mod = (const GAS float*)(p.ws + WS_MOD); GAS bf16_t* H = (GAS bf16_t*)(p.ws + WS_H);
    f32x4 wv[4];
#pragma unroll
    for (int j = 0; j < 4; ++j) wv[j] = *(const GAS f32x4*)((const GAS float*)nw + lane * 4 + 256 * j);
    constexpr int RB = 3;
    for (int row0 = gw; row0 < T_TOK; row0 += nw_ * RB) {
        f32x4 v[RB][4];
#pragma unroll
        for (int r = 0; r < RB; ++r) { const int row = row0 + r * nw_; if (row < T_TOK) { const GAS f32x4* xr = (const GAS f32x4*)(row < T_PROMPT ? Xa + (size_t)row * 1024 : Xb + (size_t)(row - T_PROMPT) * 1024) + lane;
#pragma unroll
                for (int j = 0; j < 4; ++j) v[r][j] = xr[64 * j]; } }
#pragma unroll
        for (int r = 0; r < RB; ++r) { const int row = row0 + r * nw_; if (row < T_TOK) { float ss = 0.f;
#pragma unroll
                for (int j = 0; j < 4; ++j) ss += v[r][j][0] * v[r][j][0] + v[r][j][1] * v[r][j][1] + v[r][j][2] * v[r][j][2] + v[r][j][3] * v[r][j][3];
                const float rstd = rsqrtf(wave_sum_u(ss) * (1.f / 1024.f) + EPSN);
                const GAS float* mp = mod + (size_t)cb_of_row(row) * 12288;
#pragma unroll
                for (int j = 0; j < 4; ++j) { const int col = lane * 4 + 256 * j;
                    const f32x4 sc = *(const GAS f32x4*)(mp + off_sc + col), sh = *(const GAS f32x4*)(mp + off_sh + col);
                    const f32x4 o = v[r][j] * rstd * wv[j] * (sc + 1.f) + sh;
                    u32x2 pk; pk.x = cvt_pk_bf16(o[0], o[1]); pk.y = cvt_pk_bf16(o[2], o[3]);
                    *(GAS u32x2*)(H + (size_t)row * 1024 + col) = pk; } } }
    }
}

__device__ __forceinline__ bf16x8 ldfrag(const LAS bf16_t* base, int stride, int r0, int k0, int lane) {
    return *(const LAS bf16x8*)(base + (r0 + (lane & 15)) * stride + k0 + (lane >> 4) * 8);
}
__device__ __forceinline__ f32x4 mfma16(bf16x8 a, bf16x8 b, f32x4 c) { return __builtin_amdgcn_mfma_f32_16x16x32_bf16(a, b, c, 0, 0, 0); }


#ifdef DBG2
__device__ __forceinline__ void dbg2(const Params& p, bool bad, int e) { if (bad) atomicMax((unsigned*)(p.ws + WS_BAR) + 4000, (unsigned)(100 - e)); }
__device__ __forceinline__ bool nonfin(float v) { return (__float_as_uint(v) & 0x7F800000u) == 0x7F800000u; }
#define DBG2(bad, e) dbg2(p, bad, e)
#else
#define DBG2(bad, e)
#endif
__device__ __forceinline__ void gla_pre_item(const Params& p, int l, LAS unsigned char* lds, int item) {
    const int tid = otid(), wid = tid >> 6, lane = tid & 63, quad = lane >> 4, l15 = lane & 15;
    LAS bf16_t* Q = (LAS bf16_t*)(lds + 0); LAS bf16_t* Kt = (LAS bf16_t*)(lds + 17408); LAS bf16_t* KeT = (LAS bf16_t*)(lds + 34816);
    LAS bf16_t* Att = (LAS bf16_t*)(lds + 57856);
    LAS float* bsum = (LAS float*)(lds + 75776); LAS float* ptot = (LAS float*)(lds + 108544); LAS float* gl = (LAS float*)(lds + 110592); LAS float* dec = (LAS float*)(lds + 114688);
    GAS bf16_t* proj = (GAS bf16_t*)(p.ws + WS_PROJ); const GAS float* aux = (const GAS float*)(p.ws + WS_AUX);
    const int gc = item >> 2, h = item & 3, r0 = gc * 64;
    const int d = tid & 127, part = tid >> 7;
    float w2c[16];
#pragma unroll
    for (int r = 0; r < 16; ++r) w2c[r] = ((const GAS float*)p.in[11])[(size_t)(l * 16 + r) * 512 + h * 128 + d];
    const float gb = ((const GAS float*)p.in[12])[l * 512 + h * 128 + d];
    const int gi = (tid >> 2) & 63, gq4 = (tid & 3) * 4, qr = tid >> 4, qc8 = (tid & 15) * 8;
    {
        const f32x4 n_gl = *(const GAS f32x4*)(aux + (size_t)(r0 + gi) * 64 + gq4); u32x4 n_q[2], n_k[2];
#pragma unroll
        for (int q_ = 0; q_ < 2; ++q_) { const GAS bf16_t* rp_ = proj + (size_t)(r0 + qr + 32 * q_) * NP + h * 128 + qc8; n_q[q_] = *(const GAS u32x4*)(rp_ + PC_Q); n_k[q_] = *(const GAS u32x4*)(rp_ + PC_K); }
        __syncthreads();
        if (tid < 256) *(LAS f32x4*)(gl + gi * 16 + gq4) = n_gl;
#pragma unroll
        for (int q_ = 0; q_ < 2; ++q_) { *(LAS u32x4*)(Q + (qr + 32 * q_) * 136 + qc8) = n_q[q_]; *(LAS u32x4*)(Kt + (qr + 32 * q_) * 136 + qc8) = n_k[q_]; }
    }
    __syncthreads();
    { float run = 0.f;
#pragma unroll 4
        for (int ii = 0; ii < 16; ++ii) { const int i = part * 16 + ii; float z = gb;
#pragma unroll
            for (int r = 0; r < 16; ++r) z += gl[i * 16 + r] * w2c[r];
            const float g = (fminf(z, 0.f) - __logf(1.f + __expf(-fabsf(z)))) * (1.f / 16.f);
            run += g; bsum[i * 128 + d] = run; }
        ptot[part * 128 + d] = run; }
    __syncthreads();
    { float off = 0.f, tot = 0.f;
#pragma unroll
        for (int pp = 0; pp < 4; ++pp) { const float t = ptot[pp * 128 + d]; if (pp < part) off += t; tot += t; }
        const float etot = __expf(tot);
        if (part == 0) dec[d] = etot;
#pragma unroll 4
        for (int ii = 0; ii < 16; ++ii) { const int i = part * 16 + ii; const float b = bsum[i * 128 + d] + off;
            const float qv = bf2f(Q[i * 136 + d]), kv = bf2f(Kt[i * 136 + d]); const float enb = __expf(-b);
            Q[i * 136 + d] = f2bf(qv * 0.08838834764831845f * __expf(b)); Kt[i * 136 + d] = f2bf(kv * enb); KeT[d * 72 + i] = f2bf(kv * (etot * enb)); } }
    __syncthreads();
    { const int ti = wid >> 1;
#pragma unroll
        for (int t2 = 0; t2 < 2; ++t2) { const int tj = (wid & 1) * 2 + t2; f32x4 a = (f32x4){0.f, 0.f, 0.f, 0.f};
            if (tj <= ti) {
#pragma unroll
                for (int kk = 0; kk < 4; ++kk) a = mfma16(ldfrag(Q, 136, ti * 16, kk * 32, lane), ldfrag(Kt, 136, tj * 16, kk * 32, lane), a); }
#pragma unroll
            for (int jj = 0; jj < 4; ++jj) { const int i = ti * 16 + quad * 4 + jj, j = tj * 16 + l15; Att[i * 72 + j] = f2bf(j <= i ? a[jj] : 0.f); } } }
    __syncthreads();
    {
#pragma unroll
        for (int q_ = 0; q_ < 2; ++q_) *(GAS u32x4*)(proj + (size_t)(r0 + qr + 32 * q_) * NP + h * 128 + qc8 + PC_Q) = *(const LAS u32x4*)(Q + (qr + 32 * q_) * 136 + qc8);
        GAS bf16_t* ket = (GAS bf16_t*)(p.ws + WS_KET) + (size_t)item * 8192;
#pragma unroll
        for (int q_ = 0; q_ < 2; ++q_) { const int idx = tid + 512 * q_, dd = idx >> 3, c8 = (idx & 7) * 8; *(GAS u32x4*)(ket + dd * 64 + c8) = *(const LAS u32x4*)(KeT + dd * 72 + c8); }
        GAS bf16_t* att = (GAS bf16_t*)(p.ws + WS_ATT) + (size_t)item * 4096;
        { const int ii = tid >> 3, c8 = (tid & 7) * 8; *(GAS u32x4*)(att + ii * 64 + c8) = *(const LAS u32x4*)(Att + ii * 72 + c8); }
        if (tid < 32) *(GAS f32x4*)((GAS float*)(p.ws + WS_DEC) + (size_t)item * 128 + tid * 4) = *(const LAS f32x4*)(dec + tid * 4);
    }
}
__device__ __forceinline__ void phase_gla_pre(const Params& p, int l, LAS unsigned char* lds) {
    for (int it = blockIdx.x; it < 1152; it += gridDim.x) gla_pre_item(p, l, lds, it);
}

template <bool DRY>
__device__ __forceinline__ void gla_chain(const Params& p, int l, LAS unsigned char* lds, int seq, int h, int sl) {
    const int tid = otid(), wid = tid >> 6, lane = tid & 63, quad = lane >> 4, l15 = lane & 15;
    GAS bf16_t* proj = (GAS bf16_t*)(p.ws + WS_PROJ);
    const GAS bf16_t* ketg = (const GAS bf16_t*)(p.ws + WS_KET); const GAS bf16_t* attg = (const GAS bf16_t*)(p.ws + WS_ATT); const GAS float* decg = (const GAS float*)(p.ws + WS_DEC);
    const bool samp = seq >= 8; const int nch = samp ? 1 : 32; const int gc0 = samp ? 256 + (seq - 8) : seq * 32;
    const int d0 = wid * 16 + quad * 4;
    f32x4 S[2];
    if (samp) { const GAS float* sp = (const GAS float*)p.in[2] + (size_t)((l * 32 + (seq - 8)) * 4 + h) * 32768;
#pragma unroll
        for (int te = 0; te < 2; ++te)
#pragma unroll
            for (int jj = 0; jj < 4; ++jj) S[te][jj] = sp[(d0 + jj) * 256 + sl * 32 + te * 16 + l15];
    } else { S[0] = (f32x4){0.f, 0.f, 0.f, 0.f}; S[1] = S[0]; }
    const int vj = tid >> 3, ve4 = (tid & 7) * 4, qr = tid >> 4, qc8 = (tid & 15) * 8, kd = tid >> 3, kc8 = (tid & 7) * 8;
    u32x2 n_v; u32x4 n_q[2], n_ke[2], n_att; f32x4 n_dec;
#define GLA_ISSUE(c_) do { const int gc_ = gc0 + (c_), r0_ = gc_ * 64, it_ = gc_ * 4 + h; \
        n_v = *(const GAS u32x2*)(proj + (size_t)(r0_ + vj) * NP + PC_V + h * 256 + sl * 32 + ve4); \
        _Pragma("unroll") for (int q_ = 0; q_ < 2; ++q_) { n_q[q_] = *(const GAS u32x4*)(proj + (size_t)(r0_ + qr + 32 * q_) * NP + h * 128 + qc8 + PC_Q); \
            n_ke[q_] = *(const GAS u32x4*)(ketg + (size_t)it_ * 8192 + (kd + 64 * q_) * 64 + kc8); } \
        n_att = *(const GAS u32x4*)(attg + (size_t)it_ * 4096 + kd * 64 + kc8); \
        if (tid < 32) n_dec = *(const GAS f32x4*)(decg + (size_t)it_ * 128 + tid * 4); } while (0)
    GLA_ISSUE(0);
    __syncthreads();
    { LAS bf16_t* ST = (LAS bf16_t*)(lds + 67072);
#pragma unroll
        for (int te = 0; te < 2; ++te) { u32x2 w; w.x = cvt_pk_bf16(S[te][0], S[te][1]); w.y = cvt_pk_bf16(S[te][2], S[te][3]); *(LAS u32x2*)(ST + (te * 16 + l15) * 136 + d0) = w; } }
    for (int c = 0; c < nch; ++c) {
        const int r0 = (gc0 + c) * 64;
        int lz = 0; asm volatile("" : "+v"(lz));
        LAS unsigned char* L = lds + lz;
        LAS bf16_t* Q = (LAS bf16_t*)(L + 0); LAS bf16_t* KeT = (LAS bf16_t*)(L + 34816);
        LAS bf16_t* vT = (LAS bf16_t*)(L + 53248); LAS bf16_t* Att = (LAS bf16_t*)(L + 57856); LAS bf16_t* ST = (LAS bf16_t*)(L + 67072); LAS float* dec = (LAS float*)(L + 114688);
        vT[(ve4 + 0) * 72 + vj] = (bf16_t)(n_v.x & 0xffffu); vT[(ve4 + 1) * 72 + vj] = (bf16_t)(n_v.x >> 16); vT[(ve4 + 2) * 72 + vj] = (bf16_t)(n_v.y & 0xffffu); vT[(ve4 + 3) * 72 + vj] = (bf16_t)(n_v.y >> 16);
#pragma unroll
        for (int q_ = 0; q_ < 2; ++q_) { *(LAS u32x4*)(Q + (qr + 32 * q_) * 136 + qc8) = n_q[q_]; *(LAS u32x4*)(KeT + (kd + 64 * q_) * 72 + kc8) = n_ke[q_]; }
        *(LAS u32x4*)(Att + kd * 72 + kc8) = n_att;
        if (tid < 32) *(LAS f32x4*)(dec + tid * 4) = n_dec;
        if (c + 1 < nch) GLA_ISSUE(c + 1);
        __syncthreads();
        { const int ti = wid >> 1, te = wid & 1; f32x4 a = (f32x4){0.f, 0.f, 0.f, 0.f};
#pragma unroll
            for (int kk = 0; kk < 2; ++kk) a = mfma16(ldfrag(Att, 72, ti * 16, kk * 32, lane), ldfrag(vT, 72, te * 16, kk * 32, lane), a);
#pragma unroll
            for (int kk = 0; kk < 4; ++kk) a = mfma16(ldfrag(Q, 136, ti * 16, kk * 32, lane), ldfrag(ST, 136, te * 16, kk * 32, lane), a);
#pragma unroll
            for (int jj = 0; jj < 4; ++jj) { const int i = ti * 16 + quad * 4 + jj; if (!DRY) proj[(size_t)(r0 + i) * NP + PC_V + h * 256 + sl * 32 + te * 16 + l15] = f2bf(a[jj]); else asm volatile("" :: "v"(a[jj])); } }
        { f32x4 dcv = *(const LAS f32x4*)(dec + d0);
#pragma unroll
            for (int te = 0; te < 2; ++te) { f32x4 a = (f32x4){0.f, 0.f, 0.f, 0.f};
#pragma unroll
                for (int kk = 0; kk < 2; ++kk) a = mfma16(ldfrag(KeT, 72, wid * 16, kk * 32, lane), ldfrag(vT, 72, te * 16, kk * 32, lane), a);
                S[te] = S[te] * dcv + a; } }
        __syncthreads();
#pragma unroll
        for (int te = 0; te < 2; ++te) { u32x2 w; w.x = cvt_pk_bf16(S[te][0], S[te][1]); w.y = cvt_pk_bf16(S[te][2], S[te][3]); *(LAS u32x2*)(ST + (te * 16 + l15) * 136 + d0) = w; }
    }
#undef GLA_ISSUE
    GAS float* so = (GAS float*)p.out + (samp ? O_GLAS + (size_t)((l * 32 + (seq - 8)) * 4 + h) * 32768 : O_GLAP + (size_t)((l * 8 + seq) * 4 + h) * 32768);
#pragma unroll
    for (int te = 0; te < 2; ++te)
#pragma unroll
        for (int jj = 0; jj < 4; ++jj) { if (!DRY) so[(d0 + jj) * 256 + sl * 32 + te * 16 + l15] = S[te][jj]; else asm volatile("" :: "v"(S[te][jj])); }
}

__device__ __forceinline__ void ssd_pre_item(const Params& p, int l, LAS unsigned char* lds, int item) {
    const int tid = otid(), wid = tid >> 6, lane = tid & 63, quad = lane >> 4, l15 = lane & 15;
    LAS bf16_t* rawT = (LAS bf16_t*)(lds + 0);
    LAS bf16_t* Bm = (LAS bf16_t*)(lds + 36864); LAS bf16_t* BT = (LAS bf16_t*)(lds + 54272); LAS bf16_t* Cm = (LAS bf16_t*)(lds + 72704); LAS bf16_t* CBl = (LAS bf16_t*)(lds + 90112);
    const GAS bf16_t* proj = (const GAS bf16_t*)(p.ws + WS_PROJ);
    const int gc = item >> 2, g = item & 3, r0 = gc * 64;
    const bool first = gc >= 256 || (gc & 31) == 0, samp = gc >= 256;
    u32x4 n_p[5];
#pragma unroll
    for (int j = 0; j < 5; ++j) { const int q_ = tid + 512 * j, rr = q_ >> 5, pc = q_ & 31; const int gcol = pc < 16 ? 2048 + g * 128 + pc * 8 : 2560 + g * 128 + (pc - 16) * 8;
        if (rr < 67 && (rr >= 3 || !first)) n_p[j] = *(const GAS u32x4*)(proj + (size_t)(r0 - 3 + rr) * NP + PC_XBC + gcol); }
    const int ch = tid & 255, half = tid >> 8; const int chan = ch < 128 ? 2048 + g * 128 + ch : 2560 + g * 128 + (ch - 128);
    const GAS float* cw = (const GAS float*)p.in[15] + (size_t)l * 4 * 3072; const float w0 = cw[chan], w1 = cw[3072 + chan], w2 = cw[2 * 3072 + chan], w3 = cw[3 * 3072 + chan], bb = ((const GAS float*)p.in[16])[(size_t)l * 3072 + chan];
    __syncthreads();
#pragma unroll
    for (int j = 0; j < 5; ++j) { const int q_ = tid + 512 * j, rr = q_ >> 5, pc = q_ & 31; if (rr < 67 && (rr >= 3 || !first)) *(LAS u32x4*)(rawT + rr * 264 + pc * 8) = n_p[j]; }
    if (first) { const GAS float* cprev = (const GAS float*)p.in[4] + (size_t)(l * 32 + (samp ? gc - 256 : 0)) * 3 * 3072;
        for (int idx = tid; idx < 768; idx += 512) { const int k = idx >> 8, c2 = idx & 255; const int chan2 = c2 < 128 ? 2048 + g * 128 + c2 : 2560 + g * 128 + (c2 - 128);
            rawT[k * 264 + c2] = samp ? f2bf(cprev[(size_t)k * 3072 + chan2]) : (bf16_t)0; } }
    __syncthreads();
    { const int i0 = half * 32; float x0 = bf2f(rawT[(i0 + 0) * 264 + ch]), x1 = bf2f(rawT[(i0 + 1) * 264 + ch]), x2 = bf2f(rawT[(i0 + 2) * 264 + ch]);
#pragma unroll 8
        for (int ii = 0; ii < 32; ++ii) { const int i = i0 + ii; const float x3 = bf2f(rawT[(i + 3) * 264 + ch]); const float cv = bb + w0 * x0 + w1 * x1 + w2 * x2 + w3 * x3; const bf16_t av = f2bf(siluf_(cv));
            if (ch < 128) { Bm[i * 136 + ch] = av; BT[ch * 72 + i] = av; } else Cm[i * 136 + (ch - 128)] = av;
            x0 = x1; x1 = x2; x2 = x3; } }
    __syncthreads();
    { const int ti = wid >> 1;
#pragma unroll
        for (int t2 = 0; t2 < 2; ++t2) { const int tj = (wid & 1) * 2 + t2; f32x4 a = (f32x4){0.f, 0.f, 0.f, 0.f};
            if (tj <= ti) {
#pragma unroll
                for (int kk = 0; kk < 4; ++kk) a = mfma16(ldfrag(Cm, 136, ti * 16, kk * 32, lane), ldfrag(Bm, 136, tj * 16, kk * 32, lane), a); }
#pragma unroll
            for (int jj = 0; jj < 4; ++jj) CBl[(ti * 16 + quad * 4 + jj) * 72 + tj * 16 + l15] = f2bf(a[jj]); } }
    __syncthreads();
    { GAS bf16_t* cact = (GAS bf16_t*)(p.ws + WS_H) + (size_t)item * 8192; GAS bf16_t* btg = (GAS bf16_t*)(p.ws + WS_H) + (size_t)1152 * 8192 + (size_t)item * 8192; GAS bf16_t* cbg = (GAS bf16_t*)(p.ws + WS_CBG) + (size_t)item * 4096;
#pragma unroll
        for (int q_ = 0; q_ < 2; ++q_) { const int idx = tid + 512 * q_;
            { const int rr = idx >> 4, c8 = (idx & 15) * 8; *(GAS u32x4*)(cact + rr * 128 + c8) = *(const LAS u32x4*)(Cm + rr * 136 + c8); }
            { const int ss = idx >> 3, c8 = (idx & 7) * 8; *(GAS u32x4*)(btg + ss * 64 + c8) = *(const LAS u32x4*)(BT + ss * 72 + c8); } }
        { const int ii = tid >> 3, c8 = (tid & 7) * 8; *(GAS u32x4*)(cbg + ii * 64 + c8) = *(const LAS u32x4*)(CBl + ii * 72 + c8); } }
}
__device__ __forceinline__ void phase_ssd_pre(const Params& p, int l, LAS unsigned char* lds) {
    for (int it = (int)((blockIdx.x + gridDim.x / 2) % gridDim.x); it < 1152; it += gridDim.x) ssd_pre_item(p, l, lds, it);
}

template <bool DRY>
__device__ __forceinline__ void ssd_chain(const Params& p, int l, LAS unsigned char* lds, int seq, int hd) {
    const int tid = otid(), wid = tid >> 6, lane = tid & 63, quad = lane >> 4, l15 = lane & 15;
    GAS bf16_t* proj = (GAS bf16_t*)(p.ws + WS_PROJ); const GAS float* aux = (const GAS float*)(p.ws + WS_AUX);
    const GAS bf16_t* cactg = (const GAS bf16_t*)(p.ws + WS_H); const GAS bf16_t* btgg = (const GAS bf16_t*)(p.ws + WS_H) + (size_t)1152 * 8192; const GAS bf16_t* cbgg = (const GAS bf16_t*)(p.ws + WS_CBG);
    const bool samp = seq >= 8; const int nch = samp ? 1 : 32; const int gc0 = samp ? 256 + (seq - 8) : seq * 32;
    const int g = hd >> 3, s0 = wid * 16 + quad * 4;
    const float Ah = -__expf(p.in[18][l * 32 + hd]), Dh = p.in[19][l * 32 + hd], dtb = p.in[17][l * 32 + hd];
    f32x4 S[4];
    if (samp) { const GAS float* sp = (const GAS float*)p.in[3] + (size_t)((l * 32 + (seq - 8)) * 32 + hd) * 8192;
#pragma unroll
        for (int tp = 0; tp < 4; ++tp) S[tp] = *(const GAS f32x4*)(sp + (tp * 16 + l15) * 128 + s0);
    } else {
#pragma unroll
        for (int tp = 0; tp < 4; ++tp) S[tp] = (f32x4){0.f, 0.f, 0.f, 0.f}; }
    const int xch = tid & 63, xpart = tid >> 6; const int xchan = hd * 64 + xch;
    const GAS float* cw = (const GAS float*)p.in[15] + (size_t)l * 4 * 3072; const float w0 = cw[xchan], w1 = cw[3072 + xchan], w2 = cw[2 * 3072 + xchan], w3 = cw[3 * 3072 + xchan], bb = ((const GAS float*)p.in[16])[(size_t)l * 3072 + xchan];
    const int pr = tid >> 4, pc8 = (tid & 15) * 8, kd = tid >> 3, kc8 = (tid & 7) * 8;
    u32x4 n_c[2], n_bt[2], n_cb, n_x[2]; float n_dt = 0.f;
#define SSD_ISSUE(c_) do { const int gc_ = gc0 + (c_), r0_ = gc_ * 64, it_ = gc_ * 4 + g; \
        if (wid == 0) n_dt = aux[(size_t)(r0_ + lane) * 64 + 16 + hd]; \
        _Pragma("unroll") for (int q_ = 0; q_ < 2; ++q_) { n_c[q_] = *(const GAS u32x4*)(cactg + (size_t)it_ * 8192 + (pr + 32 * q_) * 128 + pc8); n_bt[q_] = *(const GAS u32x4*)(btgg + (size_t)it_ * 8192 + (kd + 64 * q_) * 64 + kc8); \
            const int rr = kd + 64 * q_; if (rr < 67 && (rr >= 3 || (c_) > 0)) n_x[q_] = *(const GAS u32x4*)(proj + (size_t)(r0_ - 3 + rr) * NP + PC_XBC + hd * 64 + kc8); } \
        n_cb = *(const GAS u32x4*)(cbgg + (size_t)it_ * 4096 + kd * 64 + kc8); } while (0)
    SSD_ISSUE(0);
    __syncthreads();
    { LAS bf16_t* Sl = (LAS bf16_t*)(lds + 72704);
#pragma unroll
        for (int tp = 0; tp < 4; ++tp) { u32x2 w; w.x = cvt_pk_bf16(S[tp][0], S[tp][1]); w.y = cvt_pk_bf16(S[tp][2], S[tp][3]); *(LAS u32x2*)(Sl + (tp * 16 + l15) * 136 + s0) = w; } }
    for (int c = 0; c < nch; ++c) {
        const int r0 = (gc0 + c) * 64;
        int lz = 0; asm volatile("" : "+v"(lz));
        LAS unsigned char* L = lds + lz;
        LAS bf16_t* xT = (LAS bf16_t*)(L + 0); LAS bf16_t* xwT = (LAS bf16_t*)(L + 9216); LAS bf16_t* Cm = (LAS bf16_t*)(L + 18432); LAS bf16_t* BT = (LAS bf16_t*)(L + 35840);
        LAS bf16_t* CBl = (LAS bf16_t*)(L + 54272); LAS bf16_t* Wm = (LAS bf16_t*)(L + 63488); LAS bf16_t* Sl = (LAS bf16_t*)(L + 72704);
        LAS float* a_arr = (LAS float*)(L + 90112); LAS float* dt_arr = (LAS float*)(L + 90368); LAS bf16_t* rawT = (LAS bf16_t*)(L + 90624);
#pragma unroll
        for (int q_ = 0; q_ < 2; ++q_) { *(LAS u32x4*)(Cm + (pr + 32 * q_) * 136 + pc8) = n_c[q_]; *(LAS u32x4*)(BT + (kd + 64 * q_) * 72 + kc8) = n_bt[q_];
            const int rr = kd + 64 * q_; if (rr < 67 && (rr >= 3 || c > 0)) *(LAS u32x4*)(rawT + rr * 72 + kc8) = n_x[q_]; }
        *(LAS u32x4*)(CBl + kd * 72 + kc8) = n_cb;
        if (c == 0 && tid < 192) { const int k = tid >> 6, c2 = tid & 63; const GAS float* cprev = (const GAS float*)p.in[4] + (size_t)(l * 32 + (samp ? seq - 8 : 0)) * 3 * 3072;
            rawT[k * 72 + c2] = samp ? f2bf(cprev[(size_t)k * 3072 + hd * 64 + c2]) : (bf16_t)0; }
        unsigned short zc[8];
#pragma unroll
        for (int t2 = 0; t2 < 2; ++t2)
#pragma unroll
            for (int jj = 0; jj < 4; ++jj) zc[t2 * 4 + jj] = proj[(size_t)(r0 + (wid >> 1) * 16 + quad * 4 + jj) * NP + PC_Z + hd * 64 + ((wid & 1) * 2 + t2) * 16 + l15];
        if (wid == 0) { const float dtr = n_dt + dtb; const float dtv = fmaxf(dtr, 0.f) + log1pf(__expf(-fabsf(dtr)));
            float da = dtv * Ah;
#pragma unroll
            for (int o = 1; o < 64; o <<= 1) { const float t = __shfl_up(da, o); if (lane >= o) da += t; }
            a_arr[lane] = da; dt_arr[lane] = dtv; }
        if (c + 1 < nch) SSD_ISSUE(c + 1);
        __syncthreads();
        { const float a_last = a_arr[63]; const int i0 = xpart * 8;
            float x0 = bf2f(rawT[(i0 + 0) * 72 + xch]), x1 = bf2f(rawT[(i0 + 1) * 72 + xch]), x2 = bf2f(rawT[(i0 + 2) * 72 + xch]);
#pragma unroll
            for (int ii = 0; ii < 8; ++ii) { const int i = i0 + ii; const float x3 = bf2f(rawT[(i + 3) * 72 + xch]); const float cv = bb + w0 * x0 + w1 * x1 + w2 * x2 + w3 * x3; const float act = siluf_(cv);
                xT[xch * 72 + i] = f2bf(act); xwT[xch * 72 + i] = f2bf(act * dt_arr[i] * __expf(a_last - a_arr[i]));
                x0 = x1; x1 = x2; x2 = x3; }
            const int wi = tid >> 3, wj0 = (tid & 7) * 8; const u32x4 cbv = *(const LAS u32x4*)(CBl + wi * 72 + wj0); const float ai = a_arr[wi]; float wv[8];
#pragma unroll
            for (int k = 0; k < 4; ++k) { const int j = wj0 + 2 * k; wv[2 * k] = j <= wi ? lo_bf(cbv[k]) * __expf(ai - a_arr[j]) * dt_arr[j] : 0.f; wv[2 * k + 1] = (j + 1) <= wi ? hi_bf(cbv[k]) * __expf(ai - a_arr[j + 1]) * dt_arr[j + 1] : 0.f; }
            u32x4 wo; wo.x = cvt_pk_bf16(wv[0], wv[1]); wo.y = cvt_pk_bf16(wv[2], wv[3]); wo.z = cvt_pk_bf16(wv[4], wv[5]); wo.w = cvt_pk_bf16(wv[6], wv[7]);
            *(LAS u32x4*)(Wm + wi * 72 + wj0) = wo; }
        __syncthreads();
        { const int ti = wid >> 1;
#pragma unroll
            for (int t2 = 0; t2 < 2; ++t2) { const int tp = (wid & 1) * 2 + t2; f32x4 yi = (f32x4){0.f, 0.f, 0.f, 0.f}, yo = yi;
#pragma unroll
                for (int kk = 0; kk < 2; ++kk) yi = mfma16(ldfrag(Wm, 72, ti * 16, kk * 32, lane), ldfrag(xT, 72, tp * 16, kk * 32, lane), yi);
#pragma unroll
                for (int kk = 0; kk < 4; ++kk) yo = mfma16(ldfrag(Cm, 136, ti * 16, kk * 32, lane), ldfrag(Sl, 136, tp * 16, kk * 32, lane), yo);
                const int pcol = tp * 16 + l15;
#pragma unroll
                for (int jj = 0; jj < 4; ++jj) { const int i = ti * 16 + quad * 4 + jj; const float xv = bf2f(xT[pcol * 72 + i]);
                    float y = yi[jj] + __expf(a_arr[i]) * yo[jj] + Dh * xv;
                    y *= siluf_(bf2f(zc[t2 * 4 + jj])); if (!DRY) proj[(size_t)(r0 + i) * NP + PC_Z + hd * 64 + pcol] = f2bf(y); else asm volatile("" :: "v"(y)); } } }
        { const float el = __expf(a_arr[63]);
#pragma unroll
            for (int tp = 0; tp < 4; ++tp) { f32x4 a = (f32x4){0.f, 0.f, 0.f, 0.f};
#pragma unroll
                for (int kk = 0; kk < 2; ++kk) a = mfma16(ldfrag(BT, 72, wid * 16, kk * 32, lane), ldfrag(xwT, 72, tp * 16, kk * 32, lane), a);
                S[tp] = S[tp] * el + a; } }
        __syncthreads();
#pragma unroll
        for (int tp = 0; tp < 4; ++tp) { u32x2 w; w.x = cvt_pk_bf16(S[tp][0], S[tp][1]); w.y = cvt_pk_bf16(S[tp][2], S[tp][3]); *(LAS u32x2*)(Sl + (tp * 16 + l15) * 136 + s0) = w; }
    }
#undef SSD_ISSUE
    GAS float* so = (GAS float*)p.out + (samp ? O_SSDS + (size_t)((l * 32 + (seq - 8)) * 32 + hd) * 8192 : O_SSDP + (size_t)((l * 8 + seq) * 32 + hd) * 8192);
#pragma unroll
    for (int tp = 0; tp < 4; ++tp) { if (!DRY) *(GAS f32x4*)(so + (tp * 16 + l15) * 128 + s0) = S[tp]; else asm volatile("" :: "v"(S[tp][0]), "v"(S[tp][1]), "v"(S[tp][2]), "v"(S[tp][3])); }
}

template <bool DRY>
__device__ __forceinline__ void phase_mixer(const Params& p, int l, LAS unsigned char* lds) {
    for (int it = blockIdx.x; it < 2560; it += gridDim.x) {
#ifdef DRY_GLA_ONLY
        if (DRY && ((it >= 256 && it < 512) || it >= 1536)) continue;
#endif
#ifdef DRY_PROMPT_ONLY
        if (DRY && it >= 512) continue;
#endif
#ifndef NO_GLA
        if (it < 256) gla_chain<DRY>(p, l, lds, it >> 5, (it >> 3) & 3, it & 7);
#else
        if (it < 256) {}
#endif
#ifndef NO_SSD
        else if (it < 512) { const int i = it - 256; ssd_chain<DRY>(p, l, lds, i >> 5, i & 31); }
#endif
#ifndef NO_GLA
        else if (it < 1536) { const int i = it - 512; gla_chain<DRY>(p, l, lds, 8 + (i >> 5), (i >> 3) & 3, i & 7); }
#endif
#ifndef NO_SSD
        else { const int i = it - 1536; ssd_chain<DRY>(p, l, lds, 8 + (i >> 5), i & 31); }
#endif
    }
}

__device__ __forceinline__ void phase_normgate(const Params& p, int l) {
    const int tid = otid(), lane = tid & 63, gw = blockIdx.x * 8 + (tid >> 6), nwv = gridDim.x * 8;
    GAS bf16_t* proj = (GAS bf16_t*)(p.ws + WS_PROJ);
    const GAS float* gnw = (const GAS float*)p.in[13] + l * 256; const GAS float* snw = (const GAS float*)p.in[20] + l * 2048;
    for (int row = gw; row < T_TOK; row += nwv) {
        GAS bf16_t* rp = proj + (size_t)row * NP;
        u32x4 q[4];
#pragma unroll
        for (int k = 0; k < 4; ++k) q[k] = *(const GAS u32x4*)(rp + PC_Z + lane * 32 + k * 8);
        {
            u32x4 a = *(const GAS u32x4*)(rp + PC_V + lane * 16), b = *(const GAS u32x4*)(rp + PC_V + lane * 16 + 8);
            const u32x4 ga = *(const GAS u32x4*)(rp + PC_GO + lane * 16), gb2 = *(const GAS u32x4*)(rp + PC_GO + lane * 16 + 8);
            float v[16], gg[16];
#pragma unroll
            for (int j = 0; j < 4; ++j) { v[2 * j] = lo_bf(a[j]); v[2 * j + 1] = hi_bf(a[j]); v[8 + 2 * j] = lo_bf(b[j]); v[8 + 2 * j + 1] = hi_bf(b[j]);
                gg[2 * j] = lo_bf(ga[j]); gg[2 * j + 1] = hi_bf(ga[j]); gg[8 + 2 * j] = lo_bf(gb2[j]); gg[8 + 2 * j + 1] = hi_bf(gb2[j]); }
            float ss = 0.f;
#pragma unroll
            for (int j = 0; j < 16; ++j) ss += v[j] * v[j];
            ss += __shfl_xor(ss, 1); ss += __shfl_xor(ss, 2); ss += __shfl_xor(ss, 4); ss += __shfl_xor(ss, 8);
            const float rstd = rsqrtf(ss * (1.f / 256.f) + EPSN); const int e0 = (lane * 16) & 255;
#pragma unroll
            for (int j = 0; j < 16; ++j) v[j] = v[j] * rstd * gnw[e0 + j] * siluf_(gg[j]);
#pragma unroll
            for (int j = 0; j < 4; ++j) { a[j] = cvt_pk_bf16(v[2 * j], v[2 * j + 1]); b[j] = cvt_pk_bf16(v[8 + 2 * j], v[8 + 2 * j + 1]); }
            *(GAS u32x4*)(rp + PC_V + lane * 16) = a; *(GAS u32x4*)(rp + PC_V + lane * 16 + 8) = b;
        }
        {
            float ss = 0.f;
#pragma unroll
            for (int k = 0; k < 4; ++k) {
#pragma unroll
                for (int j = 0; j < 4; ++j) { const float x0 = lo_bf(q[k][j]), x1 = hi_bf(q[k][j]); ss += x0 * x0 + x1 * x1; } }
            ss += __shfl_xor(ss, 1); ss += __shfl_xor(ss, 2); ss += __shfl_xor(ss, 4); ss += __shfl_xor(ss, 8);
            const float rstd = rsqrtf(ss * (1.f / 512.f) + EPSN);
#pragma unroll
            for (int k = 0; k < 4; ++k) {
#pragma unroll
                for (int j = 0; j < 4; ++j) { const int cc = lane * 32 + k * 8 + 2 * j; q[k][j] = cvt_pk_bf16(lo_bf(q[k][j]) * rstd * snw[cc], hi_bf(q[k][j]) * rstd * snw[cc + 1]); }
                *(GAS u32x4*)(rp + PC_Z + lane * 32 + k * 8) = q[k]; }
        }
    }
    for (int idx = blockIdx.x * 512 + tid; idx < 40 * 9216; idx += gridDim.x * 512) {
        const int seq = idx / 9216, rem = idx % 9216, k = rem / 3072, ch = rem % 3072;
        const int row = seq < 8 ? seq * 2048 + 2045 + k : T_PROMPT + (seq - 8) * 64 + 61 + k;
        const float v = bf2f(proj[(size_t)row * NP + PC_XBC + ch]);
        if (seq < 8) p.out[O_CONVP + (size_t)(l * 8 + seq) * 9216 + rem] = v; else p.out[O_CONVS + (size_t)(l * 32 + (seq - 8)) * 9216 + rem] = v;
    }
}

__device__ __forceinline__ unsigned fkey(float f) { const unsigned u = __float_as_uint(f); return u ^ ((unsigned)((int)u >> 31) | 0x80000000u); }
__device__ __forceinline__ int popc64(unsigned long long m) { return __builtin_popcountll(m); }
__device__ __forceinline__ int mbcnt64(unsigned long long m) { return (int)__builtin_amdgcn_mbcnt_hi((unsigned)(m >> 32), __builtin_amdgcn_mbcnt_lo((unsigned)m, 0u)); }
template <int NV>
__device__ __forceinline__ unsigned kth16(const unsigned (&k)[NV]) {
    unsigned prefix = 0u; bool exact = false;
#pragma unroll 1
    for (int bit = 31; bit >= 0 && !exact; --bit) { const unsigned trial = prefix | (1u << bit); int cnt = 0;
#pragma unroll
        for (int c = 0; c < NV; ++c) cnt += popc64(__ballot(k[c] >= trial));
        prefix = cnt >= 16 ? trial : prefix; exact = cnt == 16; }
    return prefix;
}
__device__ __forceinline__ void kth16x2(const unsigned (&ka)[2], const unsigned (&kb)[2], unsigned& Ta, unsigned& Tb) {
    unsigned pa = 0u, pb = 0u; bool ea = false, eb = false;
#pragma unroll 1
    for (int bit = 31; bit >= 0 && !(ea && eb); --bit) { const unsigned ta = pa | (1u << bit), tb = pb | (1u << bit);
        const int ca_ = popc64(__ballot(ka[0] >= ta)) + popc64(__ballot(ka[1] >= ta)), cb_ = popc64(__ballot(kb[0] >= tb)) + popc64(__ballot(kb[1] >= tb));
        pa = ca_ >= 16 ? ta : pa; pb = cb_ >= 16 ? tb : pb; ea = ea || ca_ == 16; eb = eb || cb_ == 16; }
    Ta = pa; Tb = pb;
}
template <int NV>
__device__ __forceinline__ void compact16(const unsigned (&k)[NV], unsigned T, const int (&pa)[NV], const int (&pb)[NV], int& oa, int& ob) {
    unsigned long long bg[NV], be[NV]; int ngt = 0;
#pragma unroll
    for (int c = 0; c < NV; ++c) { bg[c] = __ballot(k[c] > T); be[c] = __ballot(k[c] == T); ngt += popc64(bg[c]); }
    const int need = 16 - ngt; int baseg = 0, basee = 0; oa = 0; ob = 0;
#pragma unroll
    for (int c = 0; c < NV; ++c) { const bool g = k[c] > T, e = k[c] == T; const int rg = baseg + mbcnt64(bg[c]), re = basee + mbcnt64(be[c]);
        const bool sel = g || (e && re < need); const int pos = g ? rg : ngt + re; const int addr = (sel ? pos : 63) << 2;
        oa |= __builtin_amdgcn_ds_permute(addr, pa[c]); ob |= __builtin_amdgcn_ds_permute(addr, pb[c]);
        baseg += popc64(bg[c]); basee += popc64(be[c]); }
}
__device__ __forceinline__ void wave_top16x2(float (&va)[2], float (&vb)[2], int lane, float& oa, int& ia, float& ob, int& ib) {
    oa = -3.0e38f; ob = -3.0e38f; ia = 0; ib = 0;
#pragma unroll 1
    for (int it = 0; it < 16; ++it) {
        const float ma = fmaxf(va[0], va[1]), mb = fmaxf(vb[0], vb[1]);
        const float Ma = wave_max_u(ma), Mb = wave_max_u(mb);
        const int sa = __builtin_amdgcn_readfirstlane(__ffsll((long long)__ballot(ma == Ma)) - 1), sb = __builtin_amdgcn_readfirstlane(__ffsll((long long)__ballot(mb == Mb)) - 1);
        const bool ha0 = va[0] == Ma, hb0 = vb[0] == Mb;
        const int ida = ha0 ? lane : lane + 64, idb = hb0 ? lane : lane + 64;
        if (lane == sa) { if (ha0) va[0] = -3.0e38f; else va[1] = -3.0e38f; }
        if (lane == sb) { if (hb0) vb[0] = -3.0e38f; else vb[1] = -3.0e38f; }
        const int xa = __builtin_amdgcn_readlane(ida, sa), xb = __builtin_amdgcn_readlane(idb, sb);
        if (lane == it) { oa = Ma; ia = xa; ob = Mb; ib = xb; }
    }
}
__device__ __forceinline__ void wave_top16x1(float v, int id, int lane, float& outv, int& outi) {
    outv = -3.0e38f; outi = 0;
#pragma unroll 1
    for (int it = 0; it < 16; ++it) {
        const float M = wave_max_u(v);
        const int src = __builtin_amdgcn_readfirstlane(__ffsll((long long)__ballot(v == M)) - 1);
        const int sel = __builtin_amdgcn_readlane(id, src);
        if (lane == src) v = -3.0e38f;
        if (lane == it) { outv = M; outi = sel; }
    }
}
template <bool DRY>
__device__ __forceinline__ void phase_peer(const Params& p, int l) {
    const int tid = otid(), lane = tid & 63, gw = blockIdx.x * 8 + (tid >> 6), nwv = gridDim.x * 8;
    typedef float f32x2_t __attribute__((ext_vector_type(2)));
    const GAS float* scores = (const GAS float*)(p.ws + WS_PROJ); const GAS bf16_t* H = (const GAS bf16_t*)(p.ws + WS_H);
    const GAS unsigned char* UV = (const GAS unsigned char*)(p.ws + ws_uv(l));
    const GAS float* SU = (const GAS float*)(p.ws + ws_su(l)); const GAS float* SV = (const GAS float*)(p.ws + ws_sv(l));
    const GAS float* mod = (const GAS float*)(p.ws + WS_MOD); GAS float* X = (GAS float*)p.out;
    int ca, cb;
    { const int L = lane; const int thr[15] = {16, 24, 29, 33, 36, 38, 40, 42, 43, 44, 45, 46, 47, 48, 49}; const int cnt[15] = {16, 8, 5, 4, 3, 2, 2, 2, 1, 1, 1, 1, 1, 1, 1};
        int a_ = 0, pre = 0;
#pragma unroll
        for (int k = 0; k < 15; ++k) { const bool ge = L >= thr[k]; a_ += ge ? 1 : 0; pre += ge ? cnt[k] : 0; }
        ca = a_; cb = L - pre; if (L >= 50) { ca = 0; cb = 0; } }
    const bool b5 = (lane & 32) != 0, b4 = (lane & 16) != 0, b3 = (lane & 8) != 0, b2 = (lane & 4) != 0;
    const int ntok = gw < T_TOK ? (T_TOK - 1 - gw) / nwv + 1 : 0, nitems = ntok * 8;
    if (nitems == 0) return;
#define PEER_SC(q_, dst) do { const GAS float* sc_ = scores + (size_t)(gw + ((q_) >> 3) * nwv) * 2048 + ((q_) & 7) * 256; dst[0] = __builtin_nontemporal_load(sc_ + lane); dst[1] = __builtin_nontemporal_load(sc_ + 64 + lane); dst[2] = __builtin_nontemporal_load(sc_ + 128 + lane); dst[3] = __builtin_nontemporal_load(sc_ + 192 + lane); } while (0)
#define PEER_ROUTE(scv, eidx_o, gs_o) do { \
        const unsigned ka_[2] = {fkey(scv[0]), fkey(scv[1])}, kb_[2] = {fkey(scv[2]), fkey(scv[3])}; unsigned Ta_, Tb_; kth16x2(ka_, kb_, Ta_, Tb_); \
        const int pva_[2] = {__float_as_int(scv[0]), __float_as_int(scv[1])}, pvb_[2] = {__float_as_int(scv[2]), __float_as_int(scv[3])}, pid_[2] = {lane, lane + 64}; \
        int v1b_, i1_, v2b_, i2_; compact16<2>(ka_, Ta_, pva_, pid_, v1b_, i1_); compact16<2>(kb_, Tb_, pvb_, pid_, v2b_, i2_); \
          \
        const float v1a_ = __int_as_float(__shfl(v1b_, lane >> 2)); const int i1a_ = __shfl(i1_, lane >> 2) * 128; \
        unsigned kc_[4]; int pc_[4], pi_[4]; \
        _Pragma("unroll") for (int c = 0; c < 4; ++c) { const int bb_ = (lane & 3) * 4 + c; const float cv_ = v1a_ + __int_as_float(__shfl(v2b_, bb_)); kc_[c] = fkey(cv_); pc_[c] = __float_as_int(cv_); pi_[c] = i1a_ + __shfl(i2_, bb_); } \
        const unsigned Tc_ = kth16<4>(kc_); int svb_, ei_; compact16<4>(kc_, Tc_, pc_, pi_, svb_, ei_); \
        const float sv_ = lane < 16 ? __int_as_float(svb_) : -3.0e38f; const float mx_ = wave_max_u(sv_); const float ex_ = lane < 16 ? __expf(sv_ - mx_) : 0.f; \
        eidx_o = lane < 16 ? ei_ : 0; gs_o = ex_ / wave_sum_u(ex_); } while (0)
    float scn[4]; int eidx; float gs;
    PEER_SC(0, scn);
    PEER_ROUTE(scn, eidx, gs);
    if (nitems > 1) PEER_SC(1, scn);
    float xf[16]; f32x2_t acc2[8];
#pragma unroll 1
    for (int q = 0; q < nitems; ++q) {
        const int t = gw + (q >> 3) * nwv, h = q & 7;
#ifdef DRY_ROUTE_ONLY
        if (DRY) { asm volatile("" :: "v"(eidx), "v"(gs)); if (q + 1 < nitems) { float sc1[4] = {scn[0], scn[1], scn[2], scn[3]}; if (q + 2 < nitems) PEER_SC(q + 2, scn); PEER_ROUTE(sc1, eidx, gs); } continue; }
#endif
        const float su_l = lane < 16 ? SU[eidx] : 0.f, sv_l = lane < 16 ? SV[eidx] : 0.f;
        u32x4 ur[16], vr[16];
#pragma unroll
        for (int e = 0; e < 16; ++e) { const int eid = __builtin_amdgcn_readlane(eidx, e);
            const GAS unsigned char* rp_ = UV + (size_t)eid * 2048 + lane * 16; ur[e] = *(const GAS u32x4*)rp_; vr[e] = *(const GAS u32x4*)(rp_ + 1024); }
        const float gs_c = gs;
        if (h == 0) { const u32x4 a = __builtin_nontemporal_load((const GAS u32x4*)(H + (size_t)t * 1024 + lane * 16)), b = __builtin_nontemporal_load((const GAS u32x4*)(H + (size_t)t * 1024 + lane * 16 + 8));
#pragma unroll
            for (int j = 0; j < 4; ++j) { xf[2 * j] = lo_bf(a[j]); xf[2 * j + 1] = hi_bf(a[j]); xf[8 + 2 * j] = lo_bf(b[j]); xf[8 + 2 * j + 1] = hi_bf(b[j]); }
#pragma unroll
            for (int j = 0; j < 8; ++j) acc2[j] = (f32x2_t){0.f, 0.f}; }
        if (q + 1 < nitems) { float sc1[4] = {scn[0], scn[1], scn[2], scn[3]}; if (q + 2 < nitems) PEER_SC(q + 2, scn); PEER_ROUTE(sc1, eidx, gs); }
        float d[16];
        f32x2_t xp2[8];
#pragma unroll
        for (int j = 0; j < 8; ++j) xp2[j] = (f32x2_t){xf[2 * j], xf[2 * j + 1]};
#pragma unroll
        for (int e = 0; e < 16; ++e) { f32x2_t dp = (f32x2_t){0.f, 0.f};
#pragma unroll
            for (int j = 0; j < 4; ++j) { const f32x2_t lo = __builtin_amdgcn_cvt_pk_f32_fp8((int)ur[e][j], false), hi = __builtin_amdgcn_cvt_pk_f32_fp8((int)ur[e][j], true);
                dp = __builtin_elementwise_fma(xp2[2 * j], lo, dp); dp = __builtin_elementwise_fma(xp2[2 * j + 1], hi, dp); }
            d[e] = dp.x + dp.y; }
        float r8[8], r4[4], r2[2], r1;
#pragma unroll
        for (int k = 0; k < 8; ++k) { const float snd = b5 ? d[k] : d[k + 8]; r8[k] = (b5 ? d[k + 8] : d[k]) + __shfl_xor(snd, 32); }
#pragma unroll
        for (int k = 0; k < 4; ++k) { const float snd = b4 ? r8[k] : r8[k + 4]; r4[k] = (b4 ? r8[k + 4] : r8[k]) + __shfl_xor(snd, 16); }
#pragma unroll
        for (int k = 0; k < 2; ++k) { const float snd = b3 ? r4[k] : r4[k + 2]; r2[k] = (b3 ? r4[k + 2] : r4[k]) + __shfl_xor(snd, 8); }
        { const float snd = b2 ? r2[0] : r2[1]; r1 = (b2 ? r2[1] : r2[0]) + __shfl_xor(snd, 4); }
        r1 += __shfl_xor(r1, 1); r1 += __shfl_xor(r1, 2);
        const int eq = lane >> 2;
        const float act = r1 * __shfl(su_l, eq);
        const float wv = __shfl(gs_c, eq) * 0.5f * act * (1.f + erff(act * 0.7071067811865476f)) * __shfl(sv_l, eq);
#pragma unroll
        for (int e = 0; e < 16; ++e) { const float w = __int_as_float(__builtin_amdgcn_readlane(__float_as_int(wv), 4 * e));
#pragma unroll
            for (int j = 0; j < 4; ++j) { const f32x2_t lo = __builtin_amdgcn_cvt_pk_f32_fp8((int)vr[e][j], false), hi = __builtin_amdgcn_cvt_pk_f32_fp8((int)vr[e][j], true); const f32x2_t w2 = (f32x2_t){w, w};
                acc2[2 * j] = __builtin_elementwise_fma(w2, lo, acc2[2 * j]); acc2[2 * j + 1] = __builtin_elementwise_fma(w2, hi, acc2[2 * j + 1]); } }
        if (h == 7) {
            const GAS float* gp = mod + (size_t)cb_of_row(t) * 12288 + l * 6144 + 5 * 1024 + lane * 16; GAS float* xp = X + (size_t)t * 1024 + lane * 16;
            f32x4 xn[4]; float ss = 0.f;
#pragma unroll
            for (int j = 0; j < 4; ++j) { const f32x4 g = *(const GAS f32x4*)(gp + 4 * j); xn[j] = __builtin_nontemporal_load((const GAS f32x4*)(xp + 4 * j));
#pragma unroll
                for (int k = 0; k < 4; ++k) { xn[j][k] += g[k] * acc2[2 * j + (k >> 1)][k & 1]; ss += xn[j][k] * xn[j][k]; } }
            const float rstd = rsqrtf(wave_sum_u(ss) * (1.f / 1024.f) + EPSN);
            if (l == 1) { const GAS float* fw = (const GAS float*)p.in[29] + lane * 16;
#pragma unroll
                for (int j = 0; j < 4; ++j) { const f32x4 w = *(const GAS f32x4*)(fw + 4 * j); xn[j] = xn[j] * rstd * w; } }
            else if (!DRY) {
                const GAS float* nw = (const GAS float*)p.in[9] + 1024 + lane * 16; const GAS float* mp = mod + (size_t)cb_of_row(t) * 12288 + 6144 + lane * 16; u32x4 ho[2];
#pragma unroll
                for (int j = 0; j < 4; ++j) { const f32x4 w = *(const GAS f32x4*)(nw + 4 * j), sh = *(const GAS f32x4*)(mp + 4 * j), sc = *(const GAS f32x4*)(mp + 1024 + 4 * j); const f32x4 o = xn[j] * rstd * w * (sc + 1.f) + sh;
                    ho[j >> 1][(j & 1) * 2] = cvt_pk_bf16(o[0], o[1]); ho[j >> 1][(j & 1) * 2 + 1] = cvt_pk_bf16(o[2], o[3]); }
                *(GAS u32x4*)((GAS bf16_t*)(p.ws + WS_H) + (size_t)t * 1024 + lane * 16) = ho[0]; *(GAS u32x4*)((GAS bf16_t*)(p.ws + WS_H) + (size_t)t * 1024 + lane * 16 + 8) = ho[1]; }
#pragma unroll
            for (int j = 0; j < 4; ++j) { if (!DRY) __builtin_nontemporal_store(xn[j], (GAS f32x4*)(xp + 4 * j)); else asm volatile("" :: "v"(xn[j][0]), "v"(xn[j][1]), "v"(xn[j][2]), "v"(xn[j][3])); }
        }
    }
#undef PEER_SC
#undef PEER_ROUTE
}

__device__ __forceinline__ void load_params(Params& q, const LAS unsigned* tab) {
#pragma unroll
    for (int k = 0; k < 32; ++k) {
        const unsigned lo = __builtin_amdgcn_readfirstlane(tab[2 * k]), hi = __builtin_amdgcn_readfirstlane(tab[2 * k + 1]);
        const unsigned long long a = ((unsigned long long)hi << 32) | lo;
        if (k < 30) q.in[k] = (const float*)a; else if (k == 30) q.out = (float*)a; else q.ws = (unsigned char*)a;
    }
}
#define PHASE_PARAMS Params p; load_params(p, tab)

#ifdef DBG
__device__ __forceinline__ void dbg_flag(const Params& p, int code) { atomicMax((unsigned*)(p.ws + WS_BAR) + 4000, (unsigned)(1000 - code)); }
__device__ __forceinline__ void dbg_bf16(const Params& p, const bf16_t* base, int rows, int ld, int ncols, int code) {
    const int tid = otid(); bool bad = false;
    for (size_t i = (size_t)blockIdx.x * 512 + tid; i < (size_t)rows * ncols; i += (size_t)gridDim.x * 512) { const size_t r = i / ncols, c = i % ncols; const unsigned v = base[r * ld + c]; if ((v & 0x7F80u) == 0x7F80u) bad = true; }
    if (bad) dbg_flag(p, code);
}
__device__ __forceinline__ void dbg_f32(const Params& p, const float* base, int rows, int ld, int ncols, int code) {
    const int tid = otid(); bool bad = false;
    for (size_t i = (size_t)blockIdx.x * 512 + tid; i < (size_t)rows * ncols; i += (size_t)gridDim.x * 512) { const size_t r = i / ncols, c = i % ncols; const unsigned v = __float_as_uint(base[r * ld + c]); if ((v & 0x7F800000u) == 0x7F800000u) bad = true; }
    if (bad) dbg_flag(p, code);
}
#define DBG_DO(x) { { PHASE_PARAMS; x; } xcd_barrier(xb); }
#else
#define DBG_DO(x)
#endif
__global__ void __launch_bounds__(512, 2) mega_fwd(Params p0) {
    __shared__ __attribute__((aligned(16))) unsigned char smem[LDS_BYTES];
    LAS unsigned char* lds = (LAS unsigned char*)smem;
    LAS unsigned* tab = (LAS unsigned*)(lds + LDS_TAB);
    if (threadIdx.x == 0) {
        volatile LAS unsigned* st0 = (volatile LAS unsigned*)(lds + LDS_ST); st0[0] = 0u; st0[1] = 0u;
#pragma unroll
        for (int k = 0; k < 32; ++k) { const unsigned long long a = k < 30 ? (unsigned long long)p0.in[k] : (k == 30 ? (unsigned long long)p0.out : (unsigned long long)p0.ws); tab[2 * k] = (unsigned)a; tab[2 * k + 1] = (unsigned)(a >> 32); }
    }
    __syncthreads();
    const XcdBarrier xb = xcd_barrier_post((unsigned*)(p0.ws + WS_BAR), (volatile LAS unsigned*)(lds + LDS_ST));
#pragma unroll 1
    for (int l = 0; l < 2; ++l) {
        if (l == 0) {
            { PHASE_PARAMS; phase_convert(p, 0, smem, (int)blockIdx.x, (int)gridDim.x, 1); mod_gemv(p, smem, (int)blockIdx.x, (int)gridDim.x); }
            xcd_barrier(xb);
        }
        if (l == 0) {
            { PHASE_PARAMS; phase_norm(p, p.in[0], p.in[1], p.in[9], 0, 1024); }
            xcd_barrier(xb);
        }
        DBG_DO(dbg_bf16(p, (const bf16_t*)(p.ws + WS_H), T_TOK, 1024, 1024, l * 10 + 2))
        { PHASE_PARAMS; EpiInProj e; e.P = (bf16_t*)(p.ws + WS_PROJ); e.aux = (float*)(p.ws + WS_AUX);
          run_gemm<1>(lds, (const bf16_t*)(p.ws + WS_H), 1024, (const bf16_t*)(p.ws + ws_win(l)), T_TOK, NP, 1024, e);
#ifdef DUP_INPROJ
          run_gemm<1>(lds, (const bf16_t*)(p.ws + WS_H), 1024, (const bf16_t*)(p.ws + ws_win(l)), T_TOK, NP, 1024, e);
#endif
        }
        xcd_barrier(xb);
        DBG_DO(dbg_bf16(p, (const bf16_t*)(p.ws + WS_PROJ), T_TOK, NP, 10240, l * 10 + 3); dbg_f32(p, (const float*)(p.ws + WS_AUX), T_TOK, 64, 48, l * 10 + 3))
#ifndef NO_MIXER
        { PHASE_PARAMS; phase_gla_pre(p, l, lds); }
        { PHASE_PARAMS; phase_ssd_pre(p, l, lds); }
        xcd_barrier(xb);
#ifdef DUP_MIXER
        { PHASE_PARAMS; phase_mixer<true>(p, l, lds); }
#endif
        { PHASE_PARAMS; phase_mixer<false>(p, l, lds); }
#endif
        xcd_barrier(xb);
        DBG_DO(dbg_bf16(p, (const bf16_t*)(p.ws + WS_PROJ) + PC_V, T_TOK, NP, 1024, l * 10 + 4); dbg_bf16(p, (const bf16_t*)(p.ws + WS_PROJ) + PC_Z, T_TOK, NP, 2048, l * 10 + 5))
#ifndef NO_NG
        { PHASE_PARAMS; phase_normgate(p, l); }
#endif
        xcd_barrier(xb);
        DBG_DO(dbg_bf16(p, (const bf16_t*)(p.ws + WS_PROJ) + PC_V, T_TOK, NP, 1024, l * 10 + 6); dbg_bf16(p, (const bf16_t*)(p.ws + WS_PROJ) + PC_Z, T_TOK, NP, 2048, l * 10 + 6))
#ifdef STOP1
        continue;
#endif
        { PHASE_PARAMS; bf16_t* proj = (bf16_t*)(p.ws + WS_PROJ); EpiGlaProj e; e.P = proj; run_gemm<2>(lds, proj + PC_V, NP, (const bf16_t*)(p.ws + ws_wgla(l)), T_TOK, 1024, 1024, e); }
        { PHASE_PARAMS; bf16_t* proj = (bf16_t*)(p.ws + WS_PROJ); EpiSsdProj e; e.P = proj; e.H = (bf16_t*)(p.ws + WS_H); run_gemm<3>(lds, proj + PC_Z, NP, (const bf16_t*)(p.ws + ws_wssd(l)), T_TOK, 1024, 2048, e); }
        {
            const int skip = gridDim.x > 64 ? 32 : 0;
            if ((int)blockIdx.x >= skip) { PHASE_PARAMS; phase_convert(p, 1, smem, (int)blockIdx.x - skip, (int)gridDim.x - skip, l == 0 ? 1 : 12); }
        }
#ifdef DUP_GS
        { PHASE_PARAMS; bf16_t* proj = (bf16_t*)(p.ws + WS_PROJ); EpiGlaProj e; e.P = proj; run_gemm<2>(lds, proj + PC_V, NP, (const bf16_t*)(p.ws + ws_wgla(l)), T_TOK, 1024, 1024, e); }
        { PHASE_PARAMS; bf16_t* proj = (bf16_t*)(p.ws + WS_PROJ); EpiSsdProj e; e.P = proj; e.H = (bf16_t*)(p.ws + WS_H); run_gemm<3>(lds, proj + PC_Z, NP, (const bf16_t*)(p.ws + ws_wssd(l)), T_TOK, 1024, 2048, e); }
#endif
        xcd_barrier(xb);
        DBG_DO(dbg_bf16(p, (const bf16_t*)(p.ws + WS_H), T_TOK, 1024, 1024, l * 10 + 7))
        { PHASE_PARAMS; EpiWout e; e.X = p.out; e.Xa = l == 0 ? p.in[0] : p.out; e.Xb = l == 0 ? p.in[1] : p.out + (size_t)T_PROMPT * 1024; e.modg = (const float*)(p.ws + WS_MOD) + l * 6144 + 2 * 1024; run_gemm<4>(lds, (const bf16_t*)(p.ws + WS_H), 1024, (const bf16_t*)(p.ws + ws_wout(l)), T_TOK, 1024, 1024, e); }
        if (l == 0) { const int skip = gridDim.x > 64 ? 32 : 0;
            if ((int)blockIdx.x >= skip) { PHASE_PARAMS; phase_convert(p, 0, smem, (int)blockIdx.x - skip, (int)gridDim.x - skip, 4); } }
        xcd_barrier(xb);
        DBG_DO(dbg_f32(p, p.out, T_TOK, 1024, 1024, l * 10 + 8))
        { PHASE_PARAMS; phase_norm(p, p.out, p.out + (size_t)T_PROMPT * 1024, p.in[23] + l * 1024, l * 6144 + 3 * 1024, l * 6144 + 4 * 1024); }
        xcd_barrier(xb);
        DBG_DO(dbg_bf16(p, (const bf16_t*)(p.ws + WS_H), T_TOK, 1024, 1024, l * 10 + 9))
        { PHASE_PARAMS; EpiF32NT e; e.C = (float*)(p.ws + WS_PROJ); e.ldc = 2048; e.bias = nullptr; run_gemm<5>(lds, (const bf16_t*)(p.ws + WS_H), 1024, (const bf16_t*)(p.ws + ws_wpeer(l)), T_TOK, 2048, 1024, e); }
        if (l == 0) { const int skip = gridDim.x > 128 ? 64 : 0;
            if ((int)blockIdx.x >= skip) { PHASE_PARAMS; phase_convert(p, 0, smem, (int)blockIdx.x - skip, (int)gridDim.x - skip, 8); } }
#ifdef DUP_SCORES
        { PHASE_PARAMS; EpiF32NT e; e.C = (float*)(p.ws + WS_PROJ); e.ldc = 2048; e.bias = nullptr; run_gemm<5>(lds, (const bf16_t*)(p.ws + WS_H), 1024, (const bf16_t*)(p.ws + ws_wpeer(l)), T_TOK, 2048, 1024, e); }
#endif
        xcd_barrier(xb);
        DBG_DO(dbg_f32(p, (const float*)(p.ws + WS_PROJ), T_TOK, 2048, 2048, l * 10 + 10))
#ifndef NO_PEER
#ifdef DUP_PEER
        { PHASE_PARAMS; phase_peer<true>(p, l); }
#endif
        { PHASE_PARAMS; phase_peer<false>(p, l); }
#endif
        if (l == 0) xcd_barrier(xb);
    }
#ifdef DBG
    xcd_barrier(xb);
    { PHASE_PARAMS; const unsigned f = __hip_atomic_load((unsigned*)(p.ws + WS_BAR) + 4000, __ATOMIC_RELAXED, __HIP_MEMORY_SCOPE_AGENT); if (f) { const float K = 10.f * (float)(1000 - (int)f); const int tid = otid(); for (size_t i = (size_t)blockIdx.x * 512 + tid; i < (size_t)T_TOK * 1024; i += (size_t)gridDim.x * 512) p.out[i] = K; } }
#endif
#ifdef DBG2
    xcd_barrier(xb);
    { PHASE_PARAMS; const unsigned f = __hip_atomic_load((unsigned*)(p.ws + WS_BAR) + 4000, __ATOMIC_RELAXED, __HIP_MEMORY_SCOPE_AGENT); if (f) { const float K = 10.f * (float)(1 << (100 - (int)f)); const int tid = otid(); for (size_t i = (size_t)blockIdx.x * 512 + tid; i < (size_t)T_TOK * 1024; i += (size_t)gridDim.x * 512) p.out[i] = K; } }
#endif
#ifdef SANITIZE
    xcd_barrier(xb);
    { PHASE_PARAMS; const int tid = otid(); for (size_t i = (size_t)blockIdx.x * 512 + tid; i < (size_t)51068928; i += (size_t)gridDim.x * 512) { const float v = p.out[i]; if (!(fabsf(v) < 3.0e38f)) p.out[i] = 0.f; } }
#endif
}

extern "C" void kernel_launch(void* const* d_in, const int* in_sizes, int n_in, void* d_out, int out_size, void* d_ws, size_t ws_size, hipStream_t stream) {
    static int grid = 0;
    if (grid == 0) {
        if (n_in != 30 || ws_size < WS_END) { fprintf(stderr, "kernel_launch: need 30 inputs and >= %zu bytes of workspace; got %d, %zu\n", (size_t)WS_END, n_in, ws_size); grid = -1; return; }
        int dev = 0, cus = 0, per_cu = 0;
        (void)hipGetDevice(&dev); (void)hipDeviceGetAttribute(&cus, hipDeviceAttributeMultiprocessorCount, dev);
        if (hipOccupancyMaxActiveBlocksPerMultiprocessor(&per_cu, (const void*)mega_fwd, 512, 0) != hipSuccess || per_cu < 1) { fprintf(stderr, "kernel_launch: occupancy query failed (%d)\n", per_cu); (void)hipGetLastError(); per_cu = 1; }
        grid = cus * (per_cu > 1 ? 1 : per_cu);
        if (grid > 256) grid = 256;
    }
    if (grid < 0) return;
    if (hipMemsetAsync((char*)d_ws + WS_BAR, 0, 16384, stream) != hipSuccess) { fprintf(stderr, "kernel_launch: memset of the barrier words failed\n"); return; }
    Params p{};
    for (int i = 0; i < 30; ++i) p.in[i] = (const float*)d_in[i];
    p.out = (float*)d_out; p.ws = (unsigned char*)d_ws;
    void* args[] = {&p};
    hipError_t e = hipLaunchCooperativeKernel((const void*)mega_fwd, dim3(grid), dim3(512), args, 0, stream);
    if (e != hipSuccess) fprintf(stderr, "kernel_launch: cooperative launch failed: %s (grid %d)\n", hipGetErrorString(e), grid);
}
```

```cpp
#include <hip/hip_runtime.h>
#include <cstdio>
#define LAS __attribute__((address_space(3)))
namespace pg8 {
#define PG8_LAS __attribute__((address_space(3)))
typedef unsigned short bf16_t;
typedef short bf16x8 __attribute__((ext_vector_type(8)));
typedef float f32x4 __attribute__((ext_vector_type(4)));
typedef unsigned u32x4 __attribute__((ext_vector_type(4)));
constexpr int BM = 256, BK = 64, HALF = 128, HTB = HALF * BK * 2  , STAGE_BYTES = 8 * HTB, NXCD = 8, WGM = 8;

__host__ __device__ __forceinline__ int lds_byte(int r, int c) { const int st = (r >> 4) * 2 + (c >> 5), rr = r & 15, cc = c & 31, ob = rr * 64 + cc * 2; return st * 1024 + (ob ^ (((ob >> 9) & 1) << 5)); }
__host__ __device__ __forceinline__ void stage_rc(int b, int& R, int& C) { const int st = b / 1024, sb = b % 1024, swz = sb ^ (((sb >> 9) & 1) << 5); R = (st >> 1) * 16 + swz / 64; C = (st & 1) * 32 + (swz % 64) / 2; }
__host__ __device__ __forceinline__ int perm32(int rho) { const int n = rho >> 4, i = rho & 15; return 8 * (i >> 2) + 4 * n + (i & 3); }

struct Unit { int pm, pn; };
struct Gemm { const bf16_t* A; const bf16_t* Bt; int M, N, K, lda; };

struct StaticOrder {
    int nM, nN, nwg, G, c;
    __host__ __device__ void init(int M, int N, int G_, int c_) { nM = M / BM; nN = N / BM; nwg = nM * nN; G = G_; c = c_; }
    __host__ __device__ bool next(int i, Unit& u) const {
        const long L = (long)i * G + c; if (L >= nwg) return false;
        int wgid = (int)L; { const int q = nwg / NXCD, r = nwg % NXCD, xcd = wgid % NXCD, off = wgid / NXCD; wgid = (xcd < r ? xcd * (q + 1) : r * (q + 1) + (xcd - r) * q) + off; }
        const int nig = WGM * nN, gid = wgid / nig, fm = gid * WGM, gsz = (nM - fm) < WGM ? (nM - fm) : WGM;
        u.pm = fm + ((wgid % nig) % gsz); u.pn = (wgid % nig) / gsz; return true;
    }
    __device__ __forceinline__ void a_ready(const Unit&) const {}
    __device__ __forceinline__ void done(const Unit&) const {}
};
typedef float f32x2 __attribute__((ext_vector_type(2)));
typedef __bf16 bf16v2_t __attribute__((ext_vector_type(2)));
__device__ __forceinline__ unsigned cvt_pk_bf16(float lo, float hi) { const f32x2 v = {lo, hi}; return __builtin_bit_cast(unsigned, __builtin_convertvector(v, bf16v2_t)); }
template <class Epi, class Sched, bool STAMP = false>
__device__ __forceinline__ void gemm_phase(PG8_LAS unsigned char* lds, const Gemm g, const Sched& S, const Epi& E, unsigned long long* stamps) {
    int tid_ = threadIdx.x; asm volatile("" : "+v"(tid_)); const int tid = tid_, wid = __builtin_amdgcn_readfirstlane(tid >> 6), lane = tid & 63, wr = wid >> 2, wc = wid & 3, fr = lane & 15, fq = lane >> 4;
    const int K = g.K, nt = K / BK;
    int ts_lo = 0, ts_hi = 0, nts = 0; const unsigned long long rt_entry = STAMP ? (unsigned long long)wall_clock64() : 0ull;
#define PG8_STAMP() do { if (STAMP && wid == 0 && nts < 64) { const unsigned long long _c = (unsigned long long)clock64(); \
        ts_lo = (lane == nts) ? (int)(unsigned)_c : ts_lo; ts_hi = (lane == nts) ? (int)(unsigned)(_c >> 32) : ts_hi; ++nts; } } while (0)
    PG8_STAMP();
    unsigned voffA[2], voffB[2];
#pragma unroll
    for (int i = 0; i < 2; ++i) { int R, C; stage_rc(tid * 16 + i * 8192, R, C); const int Rb = Epi::PERM ? ((R & ~31) + perm32(R & 31)) : R;
        voffA[i] = (unsigned)(R * g.lda + C) * 2u; voffB[i] = (unsigned)(Rb * K + C) * 2u; }
    const size_t kstep = (size_t)(BK * 2);
    const size_t hstepB = (size_t)HALF * K * 2, hstepA = (size_t)HALF * g.lda * 2;
    const size_t tstepA = 2 * hstepA, tstepB = 2 * hstepB;
    const unsigned ldsw = (unsigned)wid * 1024u;
    const int aoff = lds_byte(wr * 64 + fr, fq * 8), boff = lds_byte(wc * 32 + fr, fq * 8);
#define PG8_SA(b, h) (((b) * 2 + (h)) * HTB)
#define PG8_SB(b, h) ((4 + (b) * 2 + (h)) * HTB)
#define PG8_STAGE(bufoff, gbase, voff) do { _Pragma("unroll") for (int _i = 0; _i < 2; ++_i) \
        __builtin_amdgcn_global_load_lds((const unsigned*)((const char*)(gbase) + (voff)[_i]), (PG8_LAS unsigned*)(lds + (bufoff) + ldsw + _i * 8192), 16, 0, 0); } while (0)
#define PG8_LDA(dst, b, h) do { _Pragma("unroll") for (int m = 0; m < 4; ++m) _Pragma("unroll") for (int k = 0; k < 2; ++k) dst[m][k] = *(const PG8_LAS bf16x8*)(lds + PG8_SA(b, h) + aoff + m * 2048 + k * 1024); } while (0)
#define PG8_LDB(dst, b, h) do { _Pragma("unroll") for (int n = 0; n < 2; ++n) _Pragma("unroll") for (int k = 0; k < 2; ++k) dst[n][k] = *(const PG8_LAS bf16x8*)(lds + PG8_SB(b, h) + boff + n * 2048 + k * 1024); } while (0)
#define PG8_MMA(ai, bj, At, Bt) do { __builtin_amdgcn_s_setprio(1); _Pragma("unroll") for (int m = 0; m < 4; ++m) _Pragma("unroll") for (int n = 0; n < 2; ++n) _Pragma("unroll") for (int k = 0; k < 2; ++k) \
        acc[ai][bj][m][n] = __builtin_amdgcn_mfma_f32_16x16x32_bf16(Bt[n][k], At[m][k], acc[ai][bj][m][n], 0, 0, 0); __builtin_amdgcn_s_setprio(0); } while (0)
#define PG8_WAIT_V(n) asm volatile("s_waitcnt vmcnt(" #n ")" ::: "memory")
#define PG8_WAIT_L(n) asm volatile("s_waitcnt lgkmcnt(" #n ")" ::: "memory")
#define PG8_BAR __builtin_amdgcn_s_barrier()
#define PG8_SCHED __builtin_amdgcn_sched_barrier(0)
    Unit cur, nxt; int ui = 0;
    if (!S.next(0, cur)) return;
    f32x4 acc[2][2][4][2];
#pragma unroll
    for (int a = 0; a < 2; ++a)
#pragma unroll
        for (int b = 0; b < 2; ++b)
#pragma unroll
            for (int m = 0; m < 4; ++m)
#pragma unroll
                for (int n = 0; n < 2; ++n) acc[a][b][m][n] = (f32x4){0.f, 0.f, 0.f, 0.f};
    bf16x8 At[4][2], B0[2][2], B1[2][2];
    const char* cA = (const char*)g.A + (size_t)cur.pm * tstepA; const char* cB = (const char*)g.Bt + (size_t)cur.pn * tstepB;
    S.a_ready(cur);
    PG8_STAGE(PG8_SB(0, 0), cB, voffB); PG8_STAGE(PG8_SA(0, 0), cA, voffA); PG8_STAGE(PG8_SB(0, 1), cB + hstepB, voffB); PG8_STAGE(PG8_SA(0, 1), cA + hstepA, voffA);
    if (wr == 1) PG8_BAR;
    PG8_WAIT_V(4); PG8_BAR;
    PG8_STAGE(PG8_SB(1, 0), cB + kstep, voffB); PG8_STAGE(PG8_SA(1, 0), cA + kstep, voffA); PG8_STAGE(PG8_SB(1, 1), cB + hstepB + kstep, voffB);
    PG8_WAIT_V(6); PG8_BAR;
    PG8_STAMP();
    for (;;) {
        const bool has_next = S.next(ui + 1, nxt);
        const char* nA = has_next ? (const char*)g.A + (size_t)nxt.pm * tstepA : cA; const char* nB = has_next ? (const char*)g.Bt + (size_t)nxt.pn * tstepB : cB;
        for (int t = 0; t < nt; t += 2) {
            const bool last = (t == nt - 2);
            const char* a1 = cA + (size_t)(t + 1) * kstep;
            const char* a2 = last ? nA : cA + (size_t)(t + 2) * kstep; const char* b2 = last ? nB : cB + (size_t)(t + 2) * kstep;
            const char* a3 = a2 + kstep; const char* b3 = b2 + kstep;
            if (last && has_next) S.a_ready(nxt);
            PG8_LDB(B0, 0, 0); PG8_SCHED; PG8_LDA(At, 0, 0); PG8_STAGE(PG8_SA(1, 1), a1 + hstepA, voffA);
            PG8_WAIT_L(8); PG8_BAR; PG8_WAIT_L(0); PG8_MMA(0, 0, At, B0); PG8_BAR; PG8_SCHED;
            PG8_LDB(B1, 0, 1); PG8_STAGE(PG8_SB(0, 0), b2, voffB);
            PG8_BAR; PG8_WAIT_L(0); PG8_MMA(0, 1, At, B1); PG8_BAR;
            PG8_LDA(At, 0, 1); PG8_STAGE(PG8_SA(0, 0), a2, voffA);
            PG8_BAR; PG8_WAIT_L(0); PG8_MMA(1, 0, At, B0); PG8_BAR; PG8_SCHED;
            PG8_STAGE(PG8_SB(0, 1), b2 + hstepB, voffB);
            PG8_WAIT_V(6); PG8_BAR; PG8_MMA(1, 1, At, B1); PG8_BAR;
            PG8_LDB(B0, 1, 0); PG8_SCHED; PG8_LDA(At, 1, 0); PG8_STAGE(PG8_SA(0, 1), a2 + hstepA, voffA);
            PG8_WAIT_L(8); PG8_BAR; PG8_WAIT_L(0); PG8_MMA(0, 0, At, B0); PG8_BAR; PG8_SCHED;
            PG8_LDB(B1, 1, 1); PG8_STAGE(PG8_SB(1, 0), b3, voffB);
            PG8_BAR; PG8_WAIT_L(0); PG8_MMA(0, 1, At, B1); PG8_BAR;
            PG8_LDA(At, 1, 1); PG8_STAGE(PG8_SA(1, 0), a3, voffA);
            PG8_BAR; PG8_WAIT_L(0); PG8_MMA(1, 0, At, B0); PG8_BAR; PG8_SCHED;
            PG8_STAGE(PG8_SB(1, 1), b3 + hstepB, voffB);
            PG8_WAIT_V(6); PG8_BAR; PG8_MMA(1, 1, At, B1); PG8_BAR;
        }
        PG8_STAMP();
        if constexpr (!Epi::AFTER_DRAIN) { E(acc, cur, wr, wc, fr, fq); S.done(cur); }
        PG8_STAMP();
        if (!has_next) break;
#pragma unroll
        for (int a = 0; a < 2; ++a)
#pragma unroll
            for (int b = 0; b < 2; ++b)
#pragma unroll
                for (int m = 0; m < 4; ++m)
#pragma unroll
                    for (int n = 0; n < 2; ++n) acc[a][b][m][n] = (f32x4){0.f, 0.f, 0.f, 0.f};
        cur = nxt; cA = nA; cB = nB; ++ui;
    }
    PG8_WAIT_V(0);
    if (wr == 0) PG8_BAR;
    PG8_BAR;
    if constexpr (Epi::AFTER_DRAIN) { E.fused(acc, cur, wr, wc, fr, fq, lds, wid, lane); S.done(cur); }
    PG8_STAMP();
    if (STAMP && wid == 0) { stamps[lane] = lane < nts ? (((unsigned long long)(unsigned)ts_hi << 32) | (unsigned)ts_lo) : 0ull;
        if (lane == 62) stamps[62] = rt_entry; if (lane == 63) stamps[63] = (unsigned long long)wall_clock64(); }
#undef PG8_STAMP
#undef PG8_SA
#undef PG8_SB
#undef PG8_STAGE
#undef PG8_LDA
#undef PG8_LDB
#undef PG8_MMA
#undef PG8_WAIT_V
#undef PG8_WAIT_L
#undef PG8_BAR
#undef PG8_SCHED
}
}
#define XB_TMO      128
#define XB_XCNT(j)  (256  + 64 * (j))
#define XB_XSUB(j)  (1280 + 64 * (j))
#define XB_XGEN(j)  (2304 + 64 * (j))
#define XB_TOP      3328
#define XB_TOPGEN   3392
#define XCD_BAR_WORDS 3456
#define XB_SPIN_CAP (1u << 18)

__device__ __forceinline__ unsigned xb_ld(unsigned* p)              { return __hip_atomic_load(p, __ATOMIC_RELAXED, __HIP_MEMORY_SCOPE_AGENT); }
__device__ __forceinline__ unsigned xb_add(unsigned* p, unsigned v) { return __hip_atomic_fetch_add(p, v, __ATOMIC_RELAXED, __HIP_MEMORY_SCOPE_AGENT); }
__device__ __forceinline__ unsigned xb_xcc_id() { return (unsigned)__builtin_amdgcn_s_getreg((3 << 11) | 20) & 0xFu; }
#define XB_SPIN(cond, bar) do { unsigned _sp = 0; while (cond) { __builtin_amdgcn_s_sleep(1); \
    if ((++_sp & 255u) == 0u) { if (xb_ld(&(bar)[XB_TMO])) break; if (_sp > XB_SPIN_CAP) { atomicAdd(&(bar)[XB_TMO], 1u); break; } } } } while (0)

struct XcdBarrier {
    unsigned* bar; unsigned x;
    volatile LAS unsigned* st;
};

__device__ __forceinline__ XcdBarrier xcd_barrier_post(unsigned* bar, volatile LAS unsigned* st) {
    XcdBarrier b; b.bar = bar; b.x = xb_xcc_id(); b.st = st;
    if (threadIdx.x == 0) (void)xb_add(&bar[XB_XCNT(b.x)], 1u);
    return b;
}
__device__ __forceinline__ void xcd_barrier_complete(unsigned* bar, unsigned x, unsigned& nloc, unsigned& nx) {
    const unsigned G = gridDim.x * gridDim.y * gridDim.z;
    unsigned sum, cnt, mine, sp = 0u;
    for (;;) {
        sum = 0u; cnt = 0u; mine = 0u;
#pragma unroll
        for (unsigned j = 0; j < 16; ++j) { const unsigned c = xb_ld(&bar[XB_XCNT(j)]); sum += c; cnt += (c > 0u) ? 1u : 0u; mine = (j == x) ? c : mine; }
        if (sum == G) break;
        __builtin_amdgcn_s_sleep(1);
        if ((++sp & 255u) == 0u) { if (xb_ld(&bar[XB_TMO])) break; if (sp > XB_SPIN_CAP) { atomicAdd(&bar[XB_TMO], 1u); break; } }
    }
    nloc = mine > 0u ? mine : 1u; nx = cnt > 0u ? cnt : 1u;
}

__device__ __forceinline__ void xcd_barrier(const XcdBarrier& b) {
    asm volatile("s_waitcnt vmcnt(0)" ::: "memory");
    __syncthreads();
    int xb_tid = threadIdx.x; asm volatile("" : "+v"(xb_tid));
    if (xb_tid == 0) {
        unsigned* bar = b.bar; asm volatile("" : "+v"(bar));
        unsigned bx = b.x; asm volatile("" : "+v"(bx));
        __builtin_amdgcn_s_waitcnt(0);
        unsigned nloc = b.st[0], nx = b.st[1];
        if (nloc == 0u) { xcd_barrier_complete(bar, bx, nloc, nx); b.st[0] = nloc; b.st[1] = nx; }
        const unsigned old = xb_add(&bar[XB_XSUB(bx)], 1u);
        const unsigned gen = old / nloc;
        if (old + 1u == (gen + 1u) * nloc) {
            __builtin_amdgcn_fence(__ATOMIC_RELEASE, "agent");
            asm volatile("s_waitcnt vmcnt(0)" ::: "memory");
            const unsigned og = xb_add(&bar[XB_TOP], 1u);
            const unsigned tg = og / nx;
            if (og + 1u == (tg + 1u) * nx) xb_add(&bar[XB_TOPGEN], 1u);
            else XB_SPIN(xb_ld(&bar[XB_TOPGEN]) == tg, bar);
            __builtin_amdgcn_fence(__ATOMIC_ACQUIRE, "agent");
            xb_add(&bar[XB_XGEN(bx)], 1u);
            asm volatile("s_waitcnt vmcnt(0)" ::: "memory");
        } else {
            XB_SPIN(xb_ld(&bar[XB_XGEN(bx)]) == gen, bar);
            __builtin_amdgcn_fence(__ATOMIC_ACQUIRE, "agent");
            asm volatile("s_waitcnt vmcnt(0)" ::: "memory");
        }
    }
    __syncthreads();
}


using pg8::bf16_t; using pg8::bf16x8; using pg8::f32x4; using pg8::u32x4; using pg8::Unit; using pg8::cvt_pk_bf16;
typedef unsigned u32x2 __attribute__((ext_vector_type(2)));
constexpr int T_TOK = 18432, T_PROMPT = 16384, DM = 1024, NP = 10496, NIN = 10288;
constexpr float EPSN = 1e-6f;
constexpr int LDS_BYTES = 163840, LDS_ST = 163328, LDS_TAB = 163344;
constexpr size_t WS_BAR = 0;
constexpr size_t WS_WADA = 16384;
constexpr size_t WS_WIN = WS_WADA + (size_t)12288 * 1024 * 2;
constexpr size_t WS_WGLA = WS_WIN + (size_t)NP * 1024 * 2;
constexpr size_t WS_WSSD = WS_WGLA + (size_t)1024 * 1024 * 2;
constexpr size_t WS_WOUT = WS_WSSD + (size_t)1024 * 2048 * 2;
constexpr size_t WS_WPEER = WS_WOUT + (size_t)1024 * 1024 * 2;
constexpr size_t WS_U = WS_WPEER + (size_t)2048 * 1024 * 2;
constexpr size_t WS_V = WS_U + (size_t)16384 * 1024 * 2;
constexpr size_t WS_SILUC = WS_V + (size_t)16384 * 1024 * 2;
constexpr size_t WS_MOD = WS_SILUC + (size_t)256 * 1024 * 2;
constexpr size_t WS_H = WS_MOD + (size_t)256 * 12288 * 4;
constexpr size_t WS_AUX = WS_H + (size_t)T_TOK * 1024 * 2;
constexpr size_t WS_PROJ = WS_AUX + (size_t)T_TOK * 64 * 4;
constexpr size_t WS_KET = WS_PROJ + (size_t)T_TOK * NP * 2;
constexpr size_t WS_ATT = WS_KET + (size_t)1152 * 8192 * 2;
constexpr size_t WS_DEC = WS_ATT + (size_t)1152 * 4096 * 2;
constexpr size_t WS_CBG = WS_DEC + (size_t)1152 * 128 * 4;
constexpr size_t WS_SM1 = WS_CBG + (size_t)1152 * 4096 * 2;
constexpr size_t WS_SCL = WS_SM1 + (size_t)12 * 1024 * 1024;
constexpr size_t WS_END = WS_SCL + (size_t)4 * 16384 * 4;
__host__ __device__ constexpr size_t ws_win(int l) { return l ? WS_WADA : WS_WIN; }
__host__ __device__ constexpr size_t ws_wgla(int l) { return l ? WS_SM1 : WS_WGLA; }
__host__ __device__ constexpr size_t ws_wssd(int l) { return l ? WS_SM1 + (size_t)2 * 1024 * 1024 : WS_WSSD; }
__host__ __device__ constexpr size_t ws_wout(int l) { return l ? WS_SM1 + (size_t)6 * 1024 * 1024 : WS_WOUT; }
__host__ __device__ constexpr size_t ws_wpeer(int l) { return l ? WS_SM1 + (size_t)8 * 1024 * 1024 : WS_WPEER; }
__host__ __device__ constexpr size_t ws_uv(int l) { return l ? WS_V : WS_U; }
__host__ __device__ constexpr size_t ws_su(int l) { return WS_SCL + (size_t)l * 131072; }
__host__ __device__ constexpr size_t ws_sv(int l) { return WS_SCL + (size_t)l * 131072 + 65536; }
constexpr int PC_Q = 0, PC_K = 512, PC_V = 1024, PC_GO = 2048, PC_Z = 3072, PC_XBC = 5120, PC_GATE = 8192;
constexpr size_t O_GLAP = 18874368, O_SSDP = 20971520, O_CONVP = 25165824, O_GLAS = 25313280, O_SSDS = 33701888, O_CONVS = 50479104;

#ifndef GEMM_MASK
#define GEMM_MASK 63
#endif
#define GAS __attribute__((address_space(1)))
struct Params { const float* in[30]; float* out; unsigned char* ws; };

__device__ __forceinline__ float bf2f(bf16_t b) { return __uint_as_float(((unsigned)b) << 16); }
__device__ __forceinline__ bf16_t f2bf(float f) { return (bf16_t)(cvt_pk_bf16(f, 0.f) & 0xffffu); }
__device__ __forceinline__ float lo_bf(unsigned w) { return __uint_as_float(w << 16); }
__device__ __forceinline__ float hi_bf(unsigned w) { return __uint_as_float(w & 0xffff0000u); }
__device__ __forceinline__ float sigmoidf_(float x) { return 1.f / (1.f + __expf(-x)); }
__device__ __forceinline__ float siluf_(float x) { return x / (1.f + __expf(-x)); }
__device__ __forceinline__ int otid() { int t = threadIdx.x; asm volatile("" : "+v"(t)); return t; }
__device__ __forceinline__ int cb_of_row(int r) { return r < T_PROMPT ? (r >> 11) : 8 + ((r - T_PROMPT) >> 6); }
__device__ __forceinline__ float wave_sum(float v) {
#pragma unroll
    for (int o = 32; o >= 1; o >>= 1) v += __shfl_xor(v, o);
    return v;
}
__device__ __forceinline__ float wave_max(float v) {
#pragma unroll
    for (int o = 32; o >= 1; o >>= 1) v = fmaxf(v, __shfl_xor(v, o));
    return v;
}

struct EpiF32 {
    static constexpr bool PERM = false, AFTER_DRAIN = false;
    float* C; int ldc; const float* bias;
    __device__ __forceinline__ void operator()(const f32x4 (&acc)[2][2][4][2], const Unit& u, int wr, int wc, int fr, int fq) const {
        const int row0 = u.pm * 256 + wr * 64 + fr, col0 = u.pn * 256 + wc * 32 + 4 * fq;
        f32x4 bv[2][2];
#pragma unroll
        for (int bj = 0; bj < 2; ++bj)
#pragma unroll
            for (int n = 0; n < 2; ++n) bv[bj][n] = bias ? *(const f32x4*)(bias + col0 + bj * 128 + n * 16) : (f32x4){0.f, 0.f, 0.f, 0.f};
#pragma unroll
        for (int ai = 0; ai < 2; ++ai)
#pragma unroll
            for (int m = 0; m < 4; ++m) { float* rowp = C + (size_t)(row0 + ai * 128 + m * 16) * ldc + col0;
#pragma unroll
                for (int bj = 0; bj < 2; ++bj)
#pragma unroll
                    for (int n = 0; n < 2; ++n) *(f32x4*)(rowp + bj * 128 + n * 16) = acc[ai][bj][m][n] + bv[bj][n]; }
    }
};
struct EpiF32NT {
    static constexpr bool PERM = false, AFTER_DRAIN = false;
    float* C; int ldc; const float* bias;
    __device__ __forceinline__ void operator()(const f32x4 (&acc)[2][2][4][2], const Unit& u, int wr, int wc, int fr, int fq) const {
        const int row0 = u.pm * 256 + wr * 64 + fr, col0 = u.pn * 256 + wc * 32 + 4 * fq;
        f32x4 bv[2][2];
#pragma unroll
        for (int bj = 0; bj < 2; ++bj)
#pragma unroll
            for (int n = 0; n < 2; ++n) bv[bj][n] = bias ? *(const f32x4*)(bias + col0 + bj * 128 + n * 16) : (f32x4){0.f, 0.f, 0.f, 0.f};
#pragma unroll
        for (int ai = 0; ai < 2; ++ai)
#pragma unroll
            for (int m = 0; m < 4; ++m) { float* rowp = C + (size_t)(row0 + ai * 128 + m * 16) * ldc + col0;
#pragma unroll
                for (int bj = 0; bj < 2; ++bj)
#pragma unroll
                    for (int n = 0; n < 2; ++n) __builtin_nontemporal_store(acc[ai][bj][m][n] + bv[bj][n], (GAS f32x4*)(rowp + bj * 128 + n * 16)); }
    }
};
struct EpiInProj {
    static constexpr bool PERM = true, AFTER_DRAIN = false;
    bf16_t* P; float* aux;
    __device__ __forceinline__ void operator()(const f32x4 (&acc)[2][2][4][2], const Unit& u, int wr, int wc, int fr, int fq) const {
        const int row0 = u.pm * 256 + wr * 64 + fr;
        if (u.pn == 40) {
            if (wc < 2) {
#pragma unroll
                for (int ai = 0; ai < 2; ++ai)
#pragma unroll
                    for (int m = 0; m < 4; ++m) { GAS float* rowp = (GAS float*)aux + (size_t)(row0 + ai * 128 + m * 16) * 64 + wc * 32 + 8 * fq;
                        *(GAS f32x4*)rowp = acc[ai][0][m][0]; *(GAS f32x4*)(rowp + 4) = acc[ai][0][m][1]; }
            }
        } else {
            const int col0 = u.pn * 256 + wc * 32 + 8 * fq;
#pragma unroll
            for (int ai = 0; ai < 2; ++ai)
#pragma unroll
                for (int m = 0; m < 4; ++m) { GAS bf16_t* rowp = (GAS bf16_t*)P + (size_t)(row0 + ai * 128 + m * 16) * NP + col0;
#pragma unroll
                    for (int bj = 0; bj < 2; ++bj) { const f32x4 v0 = acc[ai][bj][m][0], v1 = acc[ai][bj][m][1];
                        u32x4 w; w.x = cvt_pk_bf16(v0[0], v0[1]); w.y = cvt_pk_bf16(v0[2], v0[3]); w.z = cvt_pk_bf16(v1[0], v1[1]); w.w = cvt_pk_bf16(v1[2], v1[3]);
                        *(GAS u32x4*)(rowp + bj * 128) = w; } }
        }
    }
};
struct EpiGlaProj {
    static constexpr bool PERM = false, AFTER_DRAIN = false;
    bf16_t* P;
    __device__ __forceinline__ void operator()(const f32x4 (&acc)[2][2][4][2], const Unit& u, int wr, int wc, int fr, int fq) const {
        const int row0 = u.pm * 256 + wr * 64 + fr, col0 = u.pn * 256 + wc * 32 + 4 * fq;
#pragma unroll
        for (int ai = 0; ai < 2; ++ai)
#pragma unroll
            for (int m = 0; m < 4; ++m) { bf16_t* rowp = P + (size_t)(row0 + ai * 128 + m * 16) * NP + col0;
#pragma unroll
                for (int bj = 0; bj < 2; ++bj)
#pragma unroll
                    for (int n = 0; n < 2; ++n) { const f32x4 v = acc[ai][bj][m][n]; const u32x2 g = *(const u32x2*)(rowp + PC_GATE + bj * 128 + n * 16);
                        u32x2 w; w.x = cvt_pk_bf16(v[0] * sigmoidf_(lo_bf(g.x)), v[1] * sigmoidf_(hi_bf(g.x))); w.y = cvt_pk_bf16(v[2] * sigmoidf_(lo_bf(g.y)), v[3] * sigmoidf_(hi_bf(g.y)));
                        *(u32x2*)(rowp + bj * 128 + n * 16) = w; } }
    }
};
struct EpiSsdProj {
    static constexpr bool PERM = false, AFTER_DRAIN = false;
    const bf16_t* P; bf16_t* H;
    __device__ __forceinline__ void operator()(const f32x4 (&acc)[2][2][4][2], const Unit& u, int wr, int wc, int fr, int fq) const {
        const int row0 = u.pm * 256 + wr * 64 + fr, col0 = u.pn * 256 + wc * 32 + 4 * fq;
#pragma unroll
        for (int ai = 0; ai < 2; ++ai)
#pragma unroll
            for (int m = 0; m < 4; ++m) { const int row = row0 + ai * 128 + m * 16; const bf16_t* rowp = P + (size_t)row * NP + col0; bf16_t* hp = H + (size_t)row * 1024 + col0;
#pragma unroll
                for (int bj = 0; bj < 2; ++bj)
#pragma unroll
                    for (int n = 0; n < 2; ++n) { const f32x4 v = acc[ai][bj][m][n]; const u32x2 g = *(const u32x2*)(rowp + PC_GATE + 1024 + bj * 128 + n * 16); const u32x2 t = *(const u32x2*)(rowp + bj * 128 + n * 16);
                        u32x2 w; w.x = cvt_pk_bf16(lo_bf(t.x) + v[0] * sigmoidf_(lo_bf(g.x)), hi_bf(t.x) + v[1] * sigmoidf_(hi_bf(g.x)));
                        w.y = cvt_pk_bf16(lo_bf(t.y) + v[2] * sigmoidf_(lo_bf(g.y)), hi_bf(t.y) + v[3] * sigmoidf_(hi_bf(g.y)));
                        *(u32x2*)(hp + bj * 128 + n * 16) = w; } }
    }
};
struct EpiWout {
    static constexpr bool PERM = false, AFTER_DRAIN = false;
    float* X; const float* Xa; const float* Xb; const float* modg;
    __device__ __forceinline__ void operator()(const f32x4 (&acc)[2][2][4][2], const Unit& u, int wr, int wc, int fr, int fq) const {
        const int row0 = u.pm * 256 + wr * 64 + fr, col0 = u.pn * 256 + wc * 32 + 4 * fq;
#pragma unroll
        for (int ai = 0; ai < 2; ++ai)
#pragma unroll
            for (int m = 0; m < 4; ++m) { const int row = row0 + ai * 128 + m * 16; float* xp = X + (size_t)row * 1024 + col0; const float* xi = (row < T_PROMPT ? Xa + (size_t)row * 1024 : Xb + (size_t)(row - T_PROMPT) * 1024) + col0; const float* gp = modg + (size_t)cb_of_row(row) * 12288 + col0;
#pragma unroll
                for (int bj = 0; bj < 2; ++bj)
#pragma unroll
                    for (int n = 0; n < 2; ++n) { const f32x4 g = *(const f32x4*)(gp + bj * 128 + n * 16); f32x4 xv = *(const f32x4*)(xi + bj * 128 + n * 16); xv = xv + g * acc[ai][bj][m][n]; *(f32x4*)(xp + bj * 128 + n * 16) = xv; } }
    }
};

template <int ID, class Epi>
__device__ __forceinline__ void run_gemm(LAS unsigned char* lds, const bf16_t* A, int lda, const bf16_t* Bt, int M, int N, int K, const Epi& E) {
    pg8::Gemm g; g.A = A; g.Bt = Bt; g.M = M; g.N = N; g.K = K; g.lda = lda;
    pg8::StaticOrder S; S.init(M, N, (int)gridDim.x, (int)blockIdx.x);
#ifndef NO_GEMM
    if (!((GEMM_MASK >> ID) & 1)) return;
    pg8::gemm_phase<Epi, pg8::StaticOrder, false>(lds, g, S, E, nullptr);
#endif
    __syncthreads();
}

__device__ __forceinline__ int win_src_col(int n) {
    if (n < 3072) return n;
    if (n < 8192) return n + 16;
    if (n < 10240) return n + 48;
    if (n < 10256) return n - 10240 + 3072;
    if (n < 10288) return n - 10256 + 8208;
    return -1;
}
template <bool MAP>
__device__ __forceinline__ void tconv_tile(const float* W, int Nsrc, bf16_t* Wt, int ldt, int k0, int n0, float* tile, int tid) {
    {
        const int nn = tid & 63, n = n0 + nn; const int sc = MAP ? win_src_col(n) : n;
#pragma unroll
        for (int i = 0; i < 8; ++i) { const int kk = i * 8 + (tid >> 6); tile[kk * 65 + nn] = sc >= 0 ? __builtin_nontemporal_load(W + (size_t)(k0 + kk) * Nsrc + sc) : 0.f; }
    }
    __syncthreads();
    {
        const int nn = tid >> 3, ks = (tid & 7) * 8; const float* s = tile + ks * 65 + nn;
        u32x4 o; o.x = cvt_pk_bf16(s[0], s[65]); o.y = cvt_pk_bf16(s[2 * 65], s[3 * 65]); o.z = cvt_pk_bf16(s[4 * 65], s[5 * 65]); o.w = cvt_pk_bf16(s[6 * 65], s[7 * 65]);
        *(u32x4*)(Wt + (size_t)(n0 + nn) * ldt + k0 + ks) = o;
    }
    __syncthreads();
}
__device__ __forceinline__ void conv_rows_bf16(const float* src, bf16_t* dst, size_t n8, int bid, int nb, int tid) {
    for (size_t i = (size_t)bid * 512 + tid; i < n8; i += (size_t)nb * 512) {
        const f32x4 a = *(const f32x4*)(src + i * 8), b = *(const f32x4*)(src + i * 8 + 4);
        u32x4 o; o.x = cvt_pk_bf16(a[0], a[1]); o.y = cvt_pk_bf16(a[2], a[3]); o.z = cvt_pk_bf16(b[0], b[1]); o.w = cvt_pk_bf16(b[2], b[3]);
        *(u32x4*)(dst + i * 8) = o;
    }
}
#define DPPF(old, src, ctrl, rm, bm) __int_as_float(__builtin_amdgcn_update_dpp(__float_as_int(old), __float_as_int(src), ctrl, rm, bm, false))
__device__ __forceinline__ float wave_max_u(float v) {
    const float ninf = -3.4e38f;
    v = fmaxf(v, DPPF(ninf, v, 0x111, 0xf, 0xf)); v = fmaxf(v, DPPF(ninf, v, 0x112, 0xf, 0xf)); v = fmaxf(v, DPPF(ninf, v, 0x114, 0xf, 0xf)); v = fmaxf(v, DPPF(ninf, v, 0x118, 0xf, 0xf));
    v = fmaxf(v, DPPF(ninf, v, 0x142, 0xa, 0xf)); v = fmaxf(v, DPPF(ninf, v, 0x143, 0xc, 0xf));
    return __int_as_float(__builtin_amdgcn_readlane(__float_as_int(v), 63));
}
__device__ __forceinline__ float wave_sum_u(float v) {
    v += DPPF(0.f, v, 0x111, 0xf, 0xf); v += DPPF(0.f, v, 0x112, 0xf, 0xf); v += DPPF(0.f, v, 0x114, 0xf, 0xf); v += DPPF(0.f, v, 0x118, 0xf, 0xf);
    v += DPPF(0.f, v, 0x142, 0xa, 0xf); v += DPPF(0.f, v, 0x143, 0xc, 0xf);
    return __int_as_float(__builtin_amdgcn_readlane(__float_as_int(v), 63));
}
__device__ __forceinline__ void conv_rows_fp8(const float* src, unsigned char* dst, float* scl, int bid, int nb, int tid, int row_lo, int row_hi) {
    const int lane = tid & 63;
    for (int row = row_lo + bid * 8 + (tid >> 6); row < row_hi; row += nb * 8) {
        const GAS f32x4* sp = (const GAS f32x4*)((const GAS float*)src + (size_t)row * 1024) + lane; f32x4 v[4]; float am = 0.f;
#pragma unroll
        for (int j = 0; j < 4; ++j) { v[j] = __builtin_nontemporal_load(sp + 64 * j); am = fmaxf(am, fmaxf(fmaxf(fabsf(v[j][0]), fabsf(v[j][1])), fmaxf(fabsf(v[j][2]), fabsf(v[j][3])))); }
        am = wave_max_u(am); const float q = am > 0.f ? 448.f / am : 1.f;
        GAS unsigned* dp = (GAS unsigned*)((GAS unsigned char*)dst + (size_t)row * 2048) + lane;
#pragma unroll
        for (int j = 0; j < 4; ++j) { int w = 0; w = __builtin_amdgcn_cvt_pk_fp8_f32(v[j][0] * q, v[j][1] * q, w, false); w = __builtin_amdgcn_cvt_pk_fp8_f32(v[j][2] * q, v[j][3] * q, w, true); dp[64 * j] = (unsigned)w; }
        if (lane == 0) scl[row] = am > 0.f ? am * (1.f / 448.f) : 1.f;
    }
}
__device__ __forceinline__ void mod_gemv(const Params& p, unsigned char* smem, int bid, int nb) {
    typedef __bf16 bf16v2_l __attribute__((ext_vector_type(2)));
    const int tid = otid(), wid = tid >> 6, lane = tid & 63;
    unsigned* sc2 = (unsigned*)smem;
    float* part = (float*)(smem + 81920);
    GAS float* mod = (GAS float*)(p.ws + WS_MOD); const GAS float* bias = (const GAS float*)p.in[8];
    for (int idx = tid; idx < 40 * 512; idx += 512) { const int cb = idx >> 9, kp = idx & 511; const GAS float* cp = cb < 8 ? (const GAS float*)p.in[5] + cb * 1024 : (const GAS float*)p.in[6] + (cb - 8) * 1024;
        sc2[kp * 40 + cb] = cvt_pk_bf16(siluf_(cp[2 * kp]), siluf_(cp[2 * kp + 1])); }
    __syncthreads();
    for (int cg = bid; cg < 192; cg += nb) {
        const int n = cg * 64 + lane, la = n / 6144, nn = n - la * 6144;
        const GAS float* W = (const GAS float*)p.in[7] + (size_t)la * 1024 * 6144 + nn + (size_t)(wid * 128) * 6144;
        float acc[40];
#pragma unroll
        for (int r = 0; r < 40; ++r) acc[r] = 0.f;
#pragma unroll 1
        for (int kb = 0; kb < 64; kb += 16) {
            float wv[32];
#pragma unroll
            for (int j = 0; j < 32; ++j) wv[j] = __builtin_nontemporal_load(W + (size_t)(2 * kb + j) * 6144);
#pragma unroll
            for (int j = 0; j < 16; ++j) { const bf16v2_l wp = __builtin_bit_cast(bf16v2_l, cvt_pk_bf16(wv[2 * j], wv[2 * j + 1])); const unsigned* sr = sc2 + (wid * 64 + kb + j) * 40;
#pragma unroll
                for (int r = 0; r < 40; ++r) acc[r] = __builtin_amdgcn_fdot2_f32_bf16(wp, __builtin_bit_cast(bf16v2_l, sr[r]), acc[r], false); }
        }
#pragma unroll
        for (int half = 0; half < 2; ++half) {
#pragma unroll
            for (int r = 0; r < 20; ++r) part[(wid * 20 + r) * 64 + lane] = acc[half * 20 + r];
            __syncthreads();
            for (int o = tid; o < 20 * 64; o += 512) { const int r = o >> 6, c = o & 63; float sum = 0.f;
#pragma unroll
                for (int w = 0; w < 8; ++w) sum += part[(w * 20 + r) * 64 + c];
                const int n2 = cg * 64 + c; mod[(size_t)(half * 20 + r) * 12288 + n2] = sum + bias[n2]; }
            __syncthreads();
        }
    }
}
__device__ __forceinline__ void phase_convert(const Params& p, int l, unsigned char* smem, int bid, int nb, int parts) {
    const int tid = otid();
    float* tile = (float*)smem;
    if (parts & 1) {
    for (int it = bid; it < 164 * 16; it += nb) { const int nt = it / 16, kt = it % 16;
        tconv_tile<true>(p.in[10] + (size_t)l * 1024 * NIN, NIN, (bf16_t*)(p.ws + ws_win(l)), 1024, kt * 64, nt * 64, tile, tid); }
    for (int it = bid; it < 256; it += nb) { const int nt = it / 16, kt = it % 16;
        tconv_tile<false>(p.in[14] + (size_t)l * 1024 * 1024, 1024, (bf16_t*)(p.ws + ws_wgla(l)), 1024, kt * 64, nt * 64, tile, tid); }
    for (int it = bid; it < 512; it += nb) { const int nt = it / 32, kt = it % 32;
        tconv_tile<false>(p.in[21] + (size_t)l * 2048 * 1024, 1024, (bf16_t*)(p.ws + ws_wssd(l)), 2048, kt * 64, nt * 64, tile, tid); }
    for (int it = bid; it < 256; it += nb) { const int nt = it / 16, kt = it % 16;
        tconv_tile<false>(p.in[22] + (size_t)l * 1024 * 1024, 1024, (bf16_t*)(p.ws + ws_wout(l)), 1024, kt * 64, nt * 64, tile, tid); }
    }
    if (parts & 12) {
        const int rlo = (parts & 4) ? 0 : 8192, rhi = (parts & 8) ? 16384 : 8192;
        conv_rows_fp8(p.in[27] + (size_t)l * 16384 * 1024, p.ws + ws_uv(l), (float*)(p.ws + ws_su(l)), bid, nb, tid, rlo, rhi);
        conv_rows_fp8(p.in[28] + (size_t)l * 16384 * 1024, p.ws + ws_uv(l) + 1024, (float*)(p.ws + ws_sv(l)), bid, nb, tid, rlo, rhi);
    }
    if (parts & 1)
    {
        float* keysL = (float*)smem; float* wqL = keysL + 64 * 129;
        bf16_t* WpT = (bf16_t*)(p.ws + ws_wpeer(l));
        for (int it = bid; it < 512; it += nb) {
            const int nt = it >> 4, mt = it & 15, n0 = nt * 64, m0 = mt * 64, h = n0 >> 8, half = (n0 >> 7) & 1, k0 = n0 & 127;
            const float* kp = (half ? p.in[26] : p.in[25]) + ((size_t)(l * 8 + h) * 128 + k0) * 128;
            const float* wp = p.in[24] + (size_t)l * 1024 * 2048 + (size_t)m0 * 2048 + h * 256 + half * 128;
#pragma unroll
            for (int i = 0; i < 16; ++i) { const int idx = tid + 512 * i, r = idx >> 7, d = idx & 127; keysL[r * 129 + d] = kp[r * 128 + d]; wqL[r * 129 + d] = wp[(size_t)r * 2048 + d]; }
            __syncthreads();
            const int nn = tid >> 3, ms = (tid & 7) * 8; float a[8] = {0.f, 0.f, 0.f, 0.f, 0.f, 0.f, 0.f, 0.f};
            for (int d = 0; d < 128; ++d) { const float kv = keysL[nn * 129 + d];
#pragma unroll
                for (int j = 0; j < 8; ++j) a[j] += kv * wqL[(ms + j) * 129 + d]; }
            u32x4 o; o.x = cvt_pk_bf16(a[0], a[1]); o.y = cvt_pk_bf16(a[2], a[3]); o.z = cvt_pk_bf16(a[4], a[5]); o.w = cvt_pk_bf16(a[6], a[7]);
            *(u32x4*)(WpT + (size_t)(n0 + nn) * 1024 + m0 + ms) = o;
            __syncthreads();
        }
    }
}

__device__ __forceinline__ void phase_norm(const Params& p, const float* Xa, const float* Xb, const float* nw, int off_sh, int off_sc) {
    const int tid = otid(), lane = tid & 63, gw = blockIdx.x * 8 + (tid >> 6), nw_ = gridDim.x * 8;
    const GAS float* mod = (const GAS float*)(p.ws + WS_MOD); GAS bf16_t* H = (GAS bf16_t*)(p.ws + WS_H);
    f32x4 wv[4];
#pragma unroll
    for (int j = 0; j < 4; ++j) wv[j] = *(const GAS f32x4*)((const GAS float*)nw + lane * 4 + 256 * j);
    constexpr int RB = 3;
    for (int row0 = gw; row0 < T_TOK; row0 += nw_ * RB) {
        f32x4 v[RB][4];
#pragma unroll
        for (int r = 0; r < RB; ++r) { const int row = row0 + r * nw_; if (row < T_TOK) { const GAS f32x4* xr = (const GAS f32x4*)(row < T_PROMPT ? Xa + (size_t)row * 1024 : Xb + (size_t)(row - T_PROMPT) * 1024) + lane;
#pragma unroll
                for (int j = 0; j < 4; ++j) v[r][j] = xr[64 * j]; } }
#pragma unroll
        for (int r = 0; r < RB; ++r) { const int row = row0 + r * nw_; if (row < T_TOK) { float ss = 0.f;
#pragma unroll
                for (int j = 0; j < 4; ++j) ss += v[r][j][0] * v[r][j][0] + v[r][j][1] * v[r][j][1] + v[r][j][2] * v[r][j][2] + v[r][j][3] * v[r][j][3];
                const float rstd = rsqrtf(wave_sum_u(ss) * (1.f / 1024.f) + EPSN);
                const GAS float* mp = mod + (size_t)cb_of_row(row) * 12288;
#pragma unroll
                for (int j = 0; j < 4; ++j) { const int col = lane * 4 + 256 * j;
                    const f32x4 sc = *(const GAS f32x4*)(mp + off_sc + col), sh = *(const GAS f32x4*)(mp + off_sh + col);
                    const f32x4 o = v[r][j] * rstd * wv[j] * (sc + 1.f) + sh;
                    u32x2 pk; pk.x = cvt_pk_bf16(o[0], o[1]); pk.y = cvt_pk_bf16(o[2], o[3]);
                    *(GAS u32x2*)(H + (size_t)row * 1024 + col) = pk; } } }
    }
}

__device__ __forceinline__ bf16x8 ldfrag(const LAS bf16_t* base, int stride, int r0, int k0, int lane) {
    return *(const LAS bf16x8*)(base + (r0 + (lane & 15)) * stride + k0 + (lane >> 4) * 8);
}
__device__ __forceinline__ f32x4 mfma16(bf16x8 a, bf16x8 b, f32x4 c) { return __builtin_amdgcn_mfma_f32_16x16x32_bf16(a, b, c, 0, 0, 0); }


#ifdef DBG2
__device__ __forceinline__ void dbg2(const Params& p, bool bad, int e) { if (bad) atomicMax((unsigned*)(p.ws + WS_BAR) + 4000, (unsigned)(100 - e)); }
__device__ __forceinline__ bool nonfin(float v) { return (__float_as_uint(v) & 0x7F800000u) == 0x7F800000u; }
#define DBG2(bad, e) dbg2(p, bad, e)
#else
#define DBG2(bad, e)
#endif
__device__ __forceinline__ void gla_pre_item(const Params& p, int l, LAS unsigned char* lds, int item) {
    const int tid = otid(), wid = tid >> 6, lane = tid & 63, quad = lane >> 4, l15 = lane & 15;
    LAS bf16_t* Q = (LAS bf16_t*)(lds + 0); LAS bf16_t* Kt = (LAS bf16_t*)(lds + 17408); LAS bf16_t* KeT = (LAS bf16_t*)(lds + 34816);
    LAS bf16_t* Att = (LAS bf16_t*)(lds + 57856);
    LAS float* bsum = (LAS float*)(lds + 75776); LAS float* ptot = (LAS float*)(lds + 108544); LAS float* gl = (LAS float*)(lds + 110592); LAS float* dec = (LAS float*)(lds + 114688);
    GAS bf16_t* proj = (GAS bf16_t*)(p.ws + WS_PROJ); const GAS float* aux = (const GAS float*)(p.ws + WS_AUX);
    const int gc = item >> 2, h = item & 3, r0 = gc * 64;
    const int d = tid & 127, part = tid >> 7;
    float w2c[16];
#pragma unroll
    for (int r = 0; r < 16; ++r) w2c[r] = ((const GAS float*)p.in[11])[(size_t)(l * 16 + r) * 512 + h * 128 + d];
    const float gb = ((const GAS float*)p.in[12])[l * 512 + h * 128 + d];
    const int gi = (tid >> 2) & 63, gq4 = (tid & 3) * 4, qr = tid >> 4, qc8 = (tid & 15) * 8;
    {
        const f32x4 n_gl = *(const GAS f32x4*)(aux + (size_t)(r0 + gi) * 64 + gq4); u32x4 n_q[2], n_k[2];
#pragma unroll
        for (int q_ = 0; q_ < 2; ++q_) { const GAS bf16_t* rp_ = proj + (size_t)(r0 + qr + 32 * q_) * NP + h * 128 + qc8; n_q[q_] = *(const GAS u32x4*)(rp_ + PC_Q); n_k[q_] = *(const GAS u32x4*)(rp_ + PC_K); }
        __syncthreads();
        if (tid < 256) *(LAS f32x4*)(gl + gi * 16 + gq4) = n_gl;
#pragma unroll
        for (int q_ = 0; q_ < 2; ++q_) { *(LAS u32x4*)(Q + (qr + 32 * q_) * 136 + qc8) = n_q[q_]; *(LAS u32x4*)(Kt + (qr + 32 * q_) * 136 + qc8) = n_k[q_]; }
    }
    __syncthreads();
    { float run = 0.f;
#pragma unroll 4
        for (int ii = 0; ii < 16; ++ii) { const int i = part * 16 + ii; float z = gb;
#pragma unroll
            for (int r = 0; r < 16; ++r) z += gl[i * 16 + r] * w2c[r];
            const float g = (fminf(z, 0.f) - __logf(1.f + __expf(-fabsf(z)))) * (1.f / 16.f);
            run += g; bsum[i * 128 + d] = run; }
        ptot[part * 128 + d] = run; }
    __syncthreads();
    { float off = 0.f, tot = 0.f;
#pragma unroll
        for (int pp = 0; pp < 4; ++pp) { const float t = ptot[pp * 128 + d]; if (pp < part) off += t; tot += t; }
        const float etot = __expf(tot);
        if (part == 0) dec[d] = etot;
#pragma unroll
        for (int i8 = 0; i8 < 2; ++i8) { float ke[8];
#pragma unroll
            for (int ii = 0; ii < 8; ++ii) { const int i = part * 16 + i8 * 8 + ii; const float b = bsum[i * 128 + d] + off;
                const float qv = bf2f(Q[i * 136 + d]), kv = bf2f(Kt[i * 136 + d]); const float enb = __expf(-b);
                Q[i * 136 + d] = f2bf(qv * 0.08838834764831845f * __expf(b)); Kt[i * 136 + d] = f2bf(kv * enb); ke[ii] = kv * (etot * enb); }
            u32x4 o; o.x = cvt_pk_bf16(ke[0], ke[1]); o.y = cvt_pk_bf16(ke[2], ke[3]); o.z = cvt_pk_bf16(ke[4], ke[5]); o.w = cvt_pk_bf16(ke[6], ke[7]);
            *(LAS u32x4*)(KeT + d * 72 + part * 16 + i8 * 8) = o; } }
    __syncthreads();
    { const int ti = wid >> 1;
#pragma unroll
        for (int t2 = 0; t2 < 2; ++t2) { const int tj = (wid & 1) * 2 + t2; f32x4 a = (f32x4){0.f, 0.f, 0.f, 0.f};
            if (tj <= ti) {
#pragma unroll
                for (int kk = 0; kk < 4; ++kk) a = mfma16(ldfrag(Q, 136, ti * 16, kk * 32, lane), ldfrag(Kt, 136, tj * 16, kk * 32, lane), a); }
#pragma unroll
            for (int jj = 0; jj < 4; ++jj) { const int i = ti * 16 + quad * 4 + jj, j = tj * 16 + l15; Att[i * 72 + j] = f2bf(j <= i ? a[jj] : 0.f); } } }
    __syncthreads();
    {
#pragma unroll
        for (int q_ = 0; q_ < 2; ++q_) *(GAS u32x4*)(proj + (size_t)(r0 + qr + 32 * q_) * NP + h * 128 + qc8 + PC_Q) = *(const LAS u32x4*)(Q + (qr + 32 * q_) * 136 + qc8);
        GAS bf16_t* ket = (GAS bf16_t*)(p.ws + WS_KET) + (size_t)item * 8192;
#pragma unroll
        for (int q_ = 0; q_ < 2; ++q_) { const int idx = tid + 512 * q_, dd = idx >> 3, c8 = (idx & 7) * 8; *(GAS u32x4*)(ket + dd * 64 + c8) = *(const LAS u32x4*)(KeT + dd * 72 + c8); }
        GAS bf16_t* att = (GAS bf16_t*)(p.ws + WS_ATT) + (size_t)item * 4096;
        { const int ii = tid >> 3, c8 = (tid & 7) * 8; *(GAS u32x4*)(att + ii * 64 + c8) = *(const LAS u32x4*)(Att + ii * 72 + c8); }
        if (tid < 32) *(GAS f32x4*)((GAS float*)(p.ws + WS_DEC) + (size_t)item * 128 + tid * 4) = *(const LAS f32x4*)(dec + tid * 4);
    }
}
__device__ __forceinline__ void phase_gla_pre(const Params& p, int l, LAS unsigned char* lds) {
    for (int it = blockIdx.x; it < 1152; it += gridDim.x) gla_pre_item(p, l, lds, it);
}

template <bool DRY>
__device__ __forceinline__ void gla_chain(const Params& p, int l, LAS unsigned char* lds, int seq, int h, int sl) {
    const int tid = otid(), wid = tid >> 6, lane = tid & 63, quad = lane >> 4, l15 = lane & 15;
    GAS bf16_t* proj = (GAS bf16_t*)(p.ws + WS_PROJ);
    const GAS bf16_t* ketg = (const GAS bf16_t*)(p.ws + WS_KET); const GAS bf16_t* attg = (const GAS bf16_t*)(p.ws + WS_ATT); const GAS float* decg = (const GAS float*)(p.ws + WS_DEC);
    const bool samp = seq >= 8; const int nch = samp ? 1 : 32; const int gc0 = samp ? 256 + (seq - 8) : seq * 32;
    const int d0 = wid * 16 + quad * 4;
    f32x4 S[2];
    if (samp) { const GAS float* sp = (const GAS float*)p.in[2] + (size_t)((l * 32 + (seq - 8)) * 4 + h) * 32768;
#pragma unroll
        for (int te = 0; te < 2; ++te)
#pragma unroll
            for (int jj = 0; jj < 4; ++jj) S[te][jj] = sp[(d0 + jj) * 256 + sl * 32 + te * 16 + l15];
    } else { S[0] = (f32x4){0.f, 0.f, 0.f, 0.f}; S[1] = S[0]; }
    const int vj = tid >> 3, ve4 = (tid & 7) * 4, qr = tid >> 4, qc8 = (tid & 15) * 8, kd = tid >> 3, kc8 = (tid & 7) * 8;
    u32x2 n_v; u32x4 n_q[2], n_ke[2], n_att; f32x4 n_dec;
#define GLA_ISSUE(c_) do { const int gc_ = gc0 + (c_), r0_ = gc_ * 64, it_ = gc_ * 4 + h; \
        n_v = *(const GAS u32x2*)(proj + (size_t)(r0_ + vj) * NP + PC_V + h * 256 + sl * 32 + ve4); \
        _Pragma("unroll") for (int q_ = 0; q_ < 2; ++q_) { n_q[q_] = *(const GAS u32x4*)(proj + (size_t)(r0_ + qr + 32 * q_) * NP + h * 128 + qc8 + PC_Q); \
            n_ke[q_] = *(const GAS u32x4*)(ketg + (size_t)it_ * 8192 + (kd + 64 * q_) * 64 + kc8); } \
        n_att = *(const GAS u32x4*)(attg + (size_t)it_ * 4096 + kd * 64 + kc8); \
        if (tid < 32) n_dec = *(const GAS f32x4*)(decg + (size_t)it_ * 128 + tid * 4); } while (0)
    GLA_ISSUE(0);
    __syncthreads();
    { LAS bf16_t* ST = (LAS bf16_t*)(lds + 67072);
#pragma unroll
        for (int te = 0; te < 2; ++te) { u32x2 w; w.x = cvt_pk_bf16(S[te][0], S[te][1]); w.y = cvt_pk_bf16(S[te][2], S[te][3]); *(LAS u32x2*)(ST + (te * 16 + l15) * 136 + d0) = w; } }
    for (int c = 0; c < nch; ++c) {
        const int r0 = (gc0 + c) * 64;
        int lz = 0; asm volatile("" : "+v"(lz));
        LAS unsigned char* L = lds + lz;
        LAS bf16_t* Q = (LAS bf16_t*)(L + 0); LAS bf16_t* KeT = (LAS bf16_t*)(L + 34816);
        LAS bf16_t* vT = (LAS bf16_t*)(L + 53248); LAS bf16_t* Att = (LAS bf16_t*)(L + 57856); LAS bf16_t* ST = (LAS bf16_t*)(L + 67072); LAS float* dec = (LAS float*)(L + 114688);
        vT[(ve4 + 0) * 72 + vj] = (bf16_t)(n_v.x & 0xffffu); vT[(ve4 + 1) * 72 + vj] = (bf16_t)(n_v.x >> 16); vT[(ve4 + 2) * 72 + vj] = (bf16_t)(n_v.y & 0xffffu); vT[(ve4 + 3) * 72 + vj] = (bf16_t)(n_v.y >> 16);
#pragma unroll
        for (int q_ = 0; q_ < 2; ++q_) { *(LAS u32x4*)(Q + (qr + 32 * q_) * 136 + qc8) = n_q[q_]; *(LAS u32x4*)(KeT + (kd + 64 * q_) * 72 + kc8) = n_ke[q_]; }
        *(LAS u32x4*)(Att + kd * 72 + kc8) = n_att;
        if (tid < 32) *(LAS f32x4*)(dec + tid * 4) = n_dec;
        if (c + 1 < nch) GLA_ISSUE(c + 1);
        __syncthreads();
        { const int ti = wid >> 1, te = wid & 1; f32x4 a = (f32x4){0.f, 0.f, 0.f, 0.f};
#pragma unroll
            for (int kk = 0; kk < 2; ++kk) a = mfma16(ldfrag(Att, 72, ti * 16, kk * 32, lane), ldfrag(vT, 72, te * 16, kk * 32, lane), a);
#pragma unroll
            for (int kk = 0; kk < 4; ++kk) a = mfma16(ldfrag(Q, 136, ti * 16, kk * 32, lane), ldfrag(ST, 136, te * 16, kk * 32, lane), a);
#pragma unroll
            for (int jj = 0; jj < 4; ++jj) { const int i = ti * 16 + quad * 4 + jj; if (!DRY) proj[(size_t)(r0 + i) * NP + PC_V + h * 256 + sl * 32 + te * 16 + l15] = f2bf(a[jj]); else asm volatile("" :: "v"(a[jj])); } }
        { f32x4 dcv = *(const LAS f32x4*)(dec + d0);
#pragma unroll
            for (int te = 0; te < 2; ++te) { f32x4 a = (f32x4){0.f, 0.f, 0.f, 0.f};
#pragma unroll
                for (int kk = 0; kk < 2; ++kk) a = mfma16(ldfrag(KeT, 72, wid * 16, kk * 32, lane), ldfrag(vT, 72, te * 16, kk * 32, lane), a);
                S[te] = S[te] * dcv + a; } }
        __syncthreads();
#pragma unroll
        for (int te = 0; te < 2; ++te) { u32x2 w; w.x = cvt_pk_bf16(S[te][0], S[te][1]); w.y = cvt_pk_bf16(S[te][2], S[te][3]); *(LAS u32x2*)(ST + (te * 16 + l15) * 136 + d0) = w; }
    }
#undef GLA_ISSUE
    GAS float* so = (GAS float*)p.out + (samp ? O_GLAS + (size_t)((l * 32 + (seq - 8)) * 4 + h) * 32768 : O_GLAP + (size_t)((l * 8 + seq) * 4 + h) * 32768);
#pragma unroll
    for (int te = 0; te < 2; ++te)
#pragma unroll
        for (int jj = 0; jj < 4; ++jj) { if (!DRY) so[(d0 + jj) * 256 + sl * 32 + te * 16 + l15] = S[te][jj]; else asm volatile("" :: "v"(S[te][jj])); }
}

__device__ __forceinline__ void ssd_pre_item(const Params& p, int l, LAS unsigned char* lds, int item) {
    const int tid = otid(), wid = tid >> 6, lane = tid & 63, quad = lane >> 4, l15 = lane & 15;
    LAS bf16_t* rawT = (LAS bf16_t*)(lds + 0);
    LAS bf16_t* Bm = (LAS bf16_t*)(lds + 36864); LAS bf16_t* BT = (LAS bf16_t*)(lds + 54272); LAS bf16_t* Cm = (LAS bf16_t*)(lds + 72704); LAS bf16_t* CBl = (LAS bf16_t*)(lds + 90112);
    const GAS bf16_t* proj = (const GAS bf16_t*)(p.ws + WS_PROJ);
    const int gc = item >> 2, g = item & 3, r0 = gc * 64;
    const bool first = gc >= 256 || (gc & 31) == 0, samp = gc >= 256;
    u32x4 n_p[5];
#pragma unroll
    for (int j = 0; j < 5; ++j) { const int q_ = tid + 512 * j, rr = q_ >> 5, pc = q_ & 31; const int gcol = pc < 16 ? 2048 + g * 128 + pc * 8 : 2560 + g * 128 + (pc - 16) * 8;
        if (rr < 67 && (rr >= 3 || !first)) n_p[j] = *(const GAS u32x4*)(proj + (size_t)(r0 - 3 + rr) * NP + PC_XBC + gcol); }
    const int ch = tid & 255, half = tid >> 8; const int chan = ch < 128 ? 2048 + g * 128 + ch : 2560 + g * 128 + (ch - 128);
    const GAS float* cw = (const GAS float*)p.in[15] + (size_t)l * 4 * 3072; const float w0 = cw[chan], w1 = cw[3072 + chan], w2 = cw[2 * 3072 + chan], w3 = cw[3 * 3072 + chan], bb = ((const GAS float*)p.in[16])[(size_t)l * 3072 + chan];
    __syncthreads();
#pragma unroll
    for (int j = 0; j < 5; ++j) { const int q_ = tid + 512 * j, rr = q_ >> 5, pc = q_ & 31; if (rr < 67 && (rr >= 3 || !first)) *(LAS u32x4*)(rawT + rr * 264 + pc * 8) = n_p[j]; }
    if (first) { const GAS float* cprev = (const GAS float*)p.in[4] + (size_t)(l * 32 + (samp ? gc - 256 : 0)) * 3 * 3072;
        for (int idx = tid; idx < 768; idx += 512) { const int k = idx >> 8, c2 = idx & 255; const int chan2 = c2 < 128 ? 2048 + g * 128 + c2 : 2560 + g * 128 + (c2 - 128);
            rawT[k * 264 + c2] = samp ? f2bf(cprev[(size_t)k * 3072 + chan2]) : (bf16_t)0; } }
    __syncthreads();
    { const int i0 = half * 32; float x0 = bf2f(rawT[(i0 + 0) * 264 + ch]), x1 = bf2f(rawT[(i0 + 1) * 264 + ch]), x2 = bf2f(rawT[(i0 + 2) * 264 + ch]);
#pragma unroll
        for (int i8 = 0; i8 < 4; ++i8) { float a8[8];
#pragma unroll
            for (int ii = 0; ii < 8; ++ii) { const int i = i0 + i8 * 8 + ii; const float x3 = bf2f(rawT[(i + 3) * 264 + ch]); const float cv = bb + w0 * x0 + w1 * x1 + w2 * x2 + w3 * x3; a8[ii] = siluf_(cv);
                const bf16_t av = f2bf(a8[ii]);
                if (ch < 128) Bm[i * 136 + ch] = av; else Cm[i * 136 + (ch - 128)] = av;
                x0 = x1; x1 = x2; x2 = x3; }
            if (ch < 128) { u32x4 o; o.x = cvt_pk_bf16(a8[0], a8[1]); o.y = cvt_pk_bf16(a8[2], a8[3]); o.z = cvt_pk_bf16(a8[4], a8[5]); o.w = cvt_pk_bf16(a8[6], a8[7]); *(LAS u32x4*)(BT + ch * 72 + i0 + i8 * 8) = o; } } }
    __syncthreads();
    { const int ti = wid >> 1;
#pragma unroll
        for (int t2 = 0; t2 < 2; ++t2) { const int tj = (wid & 1) * 2 + t2; f32x4 a = (f32x4){0.f, 0.f, 0.f, 0.f};
            if (tj <= ti) {
#pragma unroll
                for (int kk = 0; kk < 4; ++kk) a = mfma16(ldfrag(Cm, 136, ti * 16, kk * 32, lane), ldfrag(Bm, 136, tj * 16, kk * 32, lane), a); }
#pragma unroll
            for (int jj = 0; jj < 4; ++jj) CBl[(ti * 16 + quad * 4 + jj) * 72 + tj * 16 + l15] = f2bf(a[jj]); } }
    __syncthreads();
    { GAS bf16_t* cact = (GAS bf16_t*)(p.ws + WS_H) + (size_t)item * 8192; GAS bf16_t* btg = (GAS bf16_t*)(p.ws + WS_H) + (size_t)1152 * 8192 + (size_t)item * 8192; GAS bf16_t* cbg = (GAS bf16_t*)(p.ws + WS_CBG) + (size_t)item * 4096;
#pragma unroll
        for (int q_ = 0; q_ < 2; ++q_) { const int idx = tid + 512 * q_;
            { const int rr = idx >> 4, c8 = (idx & 15) * 8; *(GAS u32x4*)(cact + rr * 128 + c8) = *(const LAS u32x4*)(Cm + rr * 136 + c8); }
            { const int ss = idx >> 3, c8 = (idx & 7) * 8; *(GAS u32x4*)(btg + ss * 64 + c8) = *(const LAS u32x4*)(BT + ss * 72 + c8); } }
        { const int ii = tid >> 3, c8 = (tid & 7) * 8; *(GAS u32x4*)(cbg + ii * 64 + c8) = *(const LAS u32x4*)(CBl + ii * 72 + c8); } }
}
__device__ __forceinline__ void phase_ssd_pre(const Params& p, int l, LAS unsigned char* lds) {
    for (int it = (int)((blockIdx.x + gridDim.x / 2) % gridDim.x); it < 1152; it += gridDim.x) ssd_pre_item(p, l, lds, it);
}

template <bool DRY>
__device__ __forceinline__ void ssd_chain(const Params& p, int l, LAS unsigned char* lds, int seq, int hd) {
    const int tid = otid(), wid = tid >> 6, lane = tid & 63, quad = lane >> 4, l15 = lane & 15;
    GAS bf16_t* proj = (GAS bf16_t*)(p.ws + WS_PROJ); const GAS float* aux = (const GAS float*)(p.ws + WS_AUX);
    const GAS bf16_t* cactg = (const GAS bf16_t*)(p.ws + WS_H); const GAS bf16_t* btgg = (const GAS bf16_t*)(p.ws + WS_H) + (size_t)1152 * 8192; const GAS bf16_t* cbgg = (const GAS bf16_t*)(p.ws + WS_CBG);
    const bool samp = seq >= 8; const int nch = samp ? 1 : 32; const int gc0 = samp ? 256 + (seq - 8) : seq * 32;
    const int g = hd >> 3, s0 = wid * 16 + quad * 4;
    const float Ah = -__expf(p.in[18][l * 32 + hd]), Dh = p.in[19][l * 32 + hd], dtb = p.in[17][l * 32 + hd];
    f32x4 S[4];
    if (samp) { const GAS float* sp = (const GAS float*)p.in[3] + (size_t)((l * 32 + (seq - 8)) * 32 + hd) * 8192;
#pragma unroll
        for (int tp = 0; tp < 4; ++tp) S[tp] = *(const GAS f32x4*)(sp + (tp * 16 + l15) * 128 + s0);
    } else {
#pragma unroll
        for (int tp = 0; tp < 4; ++tp) S[tp] = (f32x4){0.f, 0.f, 0.f, 0.f}; }
    const int xch = tid & 63, xpart = tid >> 6; const int xchan = hd * 64 + xch;
    const GAS float* cw = (const GAS float*)p.in[15] + (size_t)l * 4 * 3072; const float w0 = cw[xchan], w1 = cw[3072 + xchan], w2 = cw[2 * 3072 + xchan], w3 = cw[3 * 3072 + xchan], bb = ((const GAS float*)p.in[16])[(size_t)l * 3072 + xchan];
    const int pr = tid >> 4, pc8 = (tid & 15) * 8, kd = tid >> 3, kc8 = (tid & 7) * 8;
    u32x4 n_c[2], n_bt[2], n_cb, n_x[2]; float n_dt = 0.f;
#define SSD_ISSUE(c_) do { const int gc_ = gc0 + (c_), r0_ = gc_ * 64, it_ = gc_ * 4 + g; \
        if (wid == 0) n_dt = aux[(size_t)(r0_ + lane) * 64 + 16 + hd]; \
        _Pragma("unroll") for (int q_ = 0; q_ < 2; ++q_) { n_c[q_] = *(const GAS u32x4*)(cactg + (size_t)it_ * 8192 + (pr + 32 * q_) * 128 + pc8); n_bt[q_] = *(const GAS u32x4*)(btgg + (size_t)it_ * 8192 + (kd + 64 * q_) * 64 + kc8); \
            const int rr = kd + 64 * q_; if (rr < 67 && (rr >= 3 || (c_) > 0)) n_x[q_] = *(const GAS u32x4*)(proj + (size_t)(r0_ - 3 + rr) * NP + PC_XBC + hd * 64 + kc8); } \
        n_cb = *(const GAS u32x4*)(cbgg + (size_t)it_ * 4096 + kd * 64 + kc8); } while (0)
    SSD_ISSUE(0);
    __syncthreads();
    { LAS bf16_t* Sl = (LAS bf16_t*)(lds + 72704);
#pragma unroll
        for (int tp = 0; tp < 4; ++tp) { u32x2 w; w.x = cvt_pk_bf16(S[tp][0], S[tp][1]); w.y = cvt_pk_bf16(S[tp][2], S[tp][3]); *(LAS u32x2*)(Sl + (tp * 16 + l15) * 136 + s0) = w; } }
    for (int c = 0; c < nch; ++c) {
        const int r0 = (gc0 + c) * 64;
        int lz = 0; asm volatile("" : "+v"(lz));
        LAS unsigned char* L = lds + lz;
        LAS bf16_t* xT = (LAS bf16_t*)(L + 0); LAS bf16_t* xwT = (LAS bf16_t*)(L + 9216); LAS bf16_t* Cm = (LAS bf16_t*)(L + 18432); LAS bf16_t* BT = (LAS bf16_t*)(L + 35840);
        LAS bf16_t* CBl = (LAS bf16_t*)(L + 54272); LAS bf16_t* Wm = (LAS bf16_t*)(L + 63488); LAS bf16_t* Sl = (LAS bf16_t*)(L + 72704);
        LAS float* a_arr = (LAS float*)(L + 90112); LAS float* dt_arr = (LAS float*)(L + 90368); LAS bf16_t* rawT = (LAS bf16_t*)(L + 90624);
#pragma unroll
        for (int q_ = 0; q_ < 2; ++q_) { *(LAS u32x4*)(Cm + (pr + 32 * q_) * 136 + pc8) = n_c[q_]; *(LAS u32x4*)(BT + (kd + 64 * q_) * 72 + kc8) = n_bt[q_];
            const int rr = kd + 64 * q_; if (rr < 67 && (rr >= 3 || c > 0)) *(LAS u32x4*)(rawT + rr * 72 + kc8) = n_x[q_]; }
        *(LAS u32x4*)(CBl + kd * 72 + kc8) = n_cb;
        if (c == 0 && tid < 192) { const int k = tid >> 6, c2 = tid & 63; const GAS float* cprev = (const GAS float*)p.in[4] + (size_t)(l * 32 + (samp ? seq - 8 : 0)) * 3 * 3072;
            rawT[k * 72 + c2] = samp ? f2bf(cprev[(size_t)k * 3072 + hd * 64 + c2]) : (bf16_t)0; }
        unsigned short zc[8];
#pragma unroll
        for (int t2 = 0; t2 < 2; ++t2)
#pragma unroll
            for (int jj = 0; jj < 4; ++jj) zc[t2 * 4 + jj] = proj[(size_t)(r0 + (wid >> 1) * 16 + quad * 4 + jj) * NP + PC_Z + hd * 64 + ((wid & 1) * 2 + t2) * 16 + l15];
        if (wid == 0) { const float dtr = n_dt + dtb; const float dtv = fmaxf(dtr, 0.f) + log1pf(__expf(-fabsf(dtr)));
            float da = dtv * Ah;
#pragma unroll
            for (int o = 1; o < 64; o <<= 1) { const float t = __shfl_up(da, o); if (lane >= o) da += t; }
            a_arr[lane] = da; dt_arr[lane] = dtv; }
        if (c + 1 < nch) SSD_ISSUE(c + 1);
        __syncthreads();
        { const float a_last = a_arr[63]; const int i0 = xpart * 8;
            float x0 = bf2f(rawT[(i0 + 0) * 72 + xch]), x1 = bf2f(rawT[(i0 + 1) * 72 + xch]), x2 = bf2f(rawT[(i0 + 2) * 72 + xch]);
            float av[8], aw[8];
#pragma unroll
            for (int ii = 0; ii < 8; ++ii) { const int i = i0 + ii; const float x3 = bf2f(rawT[(i + 3) * 72 + xch]); const float cv = bb + w0 * x0 + w1 * x1 + w2 * x2 + w3 * x3; const float act = siluf_(cv);
                av[ii] = act; aw[ii] = act * dt_arr[i] * __expf(a_last - a_arr[i]);
                x0 = x1; x1 = x2; x2 = x3; }
            { u32x4 o1, o2;
#pragma unroll
                for (int k = 0; k < 4; ++k) { o1[k] = cvt_pk_bf16(av[2 * k], av[2 * k + 1]); o2[k] = cvt_pk_bf16(aw[2 * k], aw[2 * k + 1]); }
                *(LAS u32x4*)(xT + xch * 72 + i0) = o1; *(LAS u32x4*)(xwT + xch * 72 + i0) = o2; }
            const int wi = tid >> 3, wj0 = (tid & 7) * 8; const u32x4 cbv = *(const LAS u32x4*)(CBl + wi * 72 + wj0); const float ai = a_arr[wi]; float wv[8];
#pragma unroll
            for (int k = 0; k < 4; ++k) { const int j = wj0 + 2 * k; wv[2 * k] = j <= wi ? lo_bf(cbv[k]) * __expf(ai - a_arr[j]) * dt_arr[j] : 0.f; wv[2 * k + 1] = (j + 1) <= wi ? hi_bf(cbv[k]) * __expf(ai - a_arr[j + 1]) * dt_arr[j + 1] : 0.f; }
            u32x4 wo; wo.x = cvt_pk_bf16(wv[0], wv[1]); wo.y = cvt_pk_bf16(wv[2], wv[3]); wo.z = cvt_pk_bf16(wv[4], wv[5]); wo.w = cvt_pk_bf16(wv[6], wv[7]);
            *(LAS u32x4*)(Wm + wi * 72 + wj0) = wo; }
        __syncthreads();
        { const int ti = wid >> 1;
#pragma unroll
            for (int t2 = 0; t2 < 2; ++t2) { const int tp = (wid & 1) * 2 + t2; f32x4 yi = (f32x4){0.f, 0.f, 0.f, 0.f}, yo = yi;
#pragma unroll
                for (int kk = 0; kk < 2; ++kk) yi = mfma16(ldfrag(Wm, 72, ti * 16, kk * 32, lane), ldfrag(xT, 72, tp * 16, kk * 32, lane), yi);
#pragma unroll
                for (int kk = 0; kk < 4; ++kk) yo = mfma16(ldfrag(Cm, 136, ti * 16, kk * 32, lane), ldfrag(Sl, 136, tp * 16, kk * 32, lane), yo);
                const int pcol = tp * 16 + l15;
#pragma unroll
                for (int jj = 0; jj < 4; ++jj) { const int i = ti * 16 + quad * 4 + jj; const float xv = bf2f(xT[pcol * 72 + i]);
                    float y = yi[jj] + __expf(a_arr[i]) * yo[jj] + Dh * xv;
                    y *= siluf_(bf2f(zc[t2 * 4 + jj])); if (!DRY) proj[(size_t)(r0 + i) * NP + PC_Z + hd * 64 + pcol] = f2bf(y); else asm volatile("" :: "v"(y)); } } }
        { const float el = __expf(a_arr[63]);
#pragma unroll
            for (int tp = 0; tp < 4; ++tp) { f32x4 a = (f32x4){0.f, 0.f, 0.f, 0.f};
#pragma unroll
                for (int kk = 0; kk < 2; ++kk) a = mfma16(ldfrag(BT, 72, wid * 16, kk * 32, lane), ldfrag(xwT, 72, tp * 16, kk * 32, lane), a);
                S[tp] = S[tp] * el + a; } }
        __syncthreads();
#pragma unroll
        for (int tp = 0; tp < 4; ++tp) { u32x2 w; w.x = cvt_pk_bf16(S[tp][0], S[tp][1]); w.y = cvt_pk_bf16(S[tp][2], S[tp][3]); *(LAS u32x2*)(Sl + (tp * 16 + l15) * 136 + s0) = w; }
    }
#undef SSD_ISSUE
    GAS float* so = (GAS float*)p.out + (samp ? O_SSDS + (size_t)((l * 32 + (seq - 8)) * 32 + hd) * 8192 : O_SSDP + (size_t)((l * 8 + seq) * 32 + hd) * 8192);
#pragma unroll
    for (int tp = 0; tp < 4; ++tp) { if (!DRY) *(GAS f32x4*)(so + (tp * 16 + l15) * 128 + s0) = S[tp]; else asm volatile("" :: "v"(S[tp][0]), "v"(S[tp][1]), "v"(S[tp][2]), "v"(S[tp][3])); }
}

template <bool DRY>
__device__ __forceinline__ void phase_mixer(const Params& p, int l, LAS unsigned char* lds) {
    for (int it = blockIdx.x; it < 2560; it += gridDim.x) {
#ifdef DRY_GLA_ONLY
        if (DRY && ((it >= 256 && it < 512) || it >= 1536)) continue;
#endif
#ifdef DRY_PROMPT_ONLY
        if (DRY && it >= 512) continue;
#endif
#ifndef NO_GLA
        if (it < 256) gla_chain<DRY>(p, l, lds, it >> 5, (it >> 3) & 3, it & 7);
#else
        if (it < 256) {}
#endif
#ifndef NO_SSD
        else if (it < 512) { const int i = it - 256; ssd_chain<DRY>(p, l, lds, i >> 5, i & 31); }
#endif
#ifndef NO_GLA
        else if (it < 1536) { const int i = it - 512; gla_chain<DRY>(p, l, lds, 8 + (i >> 5), (i >> 3) & 3, i & 7); }
#endif
#ifndef NO_SSD
        else { const int i = it - 1536; ssd_chain<DRY>(p, l, lds, 8 + (i >> 5), i & 31); }
#endif
    }
}

__device__ __forceinline__ void phase_normgate(const Params& p, int l) {
    const int tid = otid(), lane = tid & 63, gw = blockIdx.x * 8 + (tid >> 6), nwv = gridDim.x * 8;
    GAS bf16_t* proj = (GAS bf16_t*)(p.ws + WS_PROJ);
    const GAS float* gnw = (const GAS float*)p.in[13] + l * 256; const GAS float* snw = (const GAS float*)p.in[20] + l * 2048;
    for (int row = gw; row < T_TOK; row += nwv) {
        GAS bf16_t* rp = proj + (size_t)row * NP;
        u32x4 q[4];
#pragma unroll
        for (int k = 0; k < 4; ++k) q[k] = *(const GAS u32x4*)(rp + PC_Z + lane * 32 + k * 8);
        {
            u32x4 a = *(const GAS u32x4*)(rp + PC_V + lane * 16), b = *(const GAS u32x4*)(rp + PC_V + lane * 16 + 8);
            const u32x4 ga = *(const GAS u32x4*)(rp + PC_GO + lane * 16), gb2 = *(const GAS u32x4*)(rp + PC_GO + lane * 16 + 8);
            float v[16], gg[16];
#pragma unroll
            for (int j = 0; j < 4; ++j) { v[2 * j] = lo_bf(a[j]); v[2 * j + 1] = hi_bf(a[j]); v[8 + 2 * j] = lo_bf(b[j]); v[8 + 2 * j + 1] = hi_bf(b[j]);
                gg[2 * j] = lo_bf(ga[j]); gg[2 * j + 1] = hi_bf(ga[j]); gg[8 + 2 * j] = lo_bf(gb2[j]); gg[8 + 2 * j + 1] = hi_bf(gb2[j]); }
            float ss = 0.f;
#pragma unroll
            for (int j = 0; j < 16; ++j) ss += v[j] * v[j];
            ss += __shfl_xor(ss, 1); ss += __shfl_xor(ss, 2); ss += __shfl_xor(ss, 4); ss += __shfl_xor(ss, 8);
            const float rstd = rsqrtf(ss * (1.f / 256.f) + EPSN); const int e0 = (lane * 16) & 255;
#pragma unroll
            for (int j = 0; j < 16; ++j) v[j] = v[j] * rstd * gnw[e0 + j] * siluf_(gg[j]);
#pragma unroll
            for (int j = 0; j < 4; ++j) { a[j] = cvt_pk_bf16(v[2 * j], v[2 * j + 1]); b[j] = cvt_pk_bf16(v[8 + 2 * j], v[8 + 2 * j + 1]); }
            *(GAS u32x4*)(rp + PC_V + lane * 16) = a; *(GAS u32x4*)(rp + PC_V + lane * 16 + 8) = b;
        }
        {
            float ss = 0.f;
#pragma unroll
            for (int k = 0; k < 4; ++k) {
#pragma unroll
                for (int j = 0; j < 4; ++j) { const float x0 = lo_bf(q[k][j]), x1 = hi_bf(q[k][j]); ss += x0 * x0 + x1 * x1; } }
            ss += __shfl_xor(ss, 1); ss += __shfl_xor(ss, 2); ss += __shfl_xor(ss, 4); ss += __shfl_xor(ss, 8);
            const float rstd = rsqrtf(ss * (1.f / 512.f) + EPSN);
#pragma unroll
            for (int k = 0; k < 4; ++k) {
#pragma unroll
                for (int j = 0; j < 4; ++j) { const int cc = lane * 32 + k * 8 + 2 * j; q[k][j] = cvt_pk_bf16(lo_bf(q[k][j]) * rstd * snw[cc], hi_bf(q[k][j]) * rstd * snw[cc + 1]); }
                *(GAS u32x4*)(rp + PC_Z + lane * 32 + k * 8) = q[k]; }
        }
    }
    for (int idx = blockIdx.x * 512 + tid; idx < 40 * 9216; idx += gridDim.x * 512) {
        const int seq = idx / 9216, rem = idx % 9216, k = rem / 3072, ch = rem % 3072;
        const int row = seq < 8 ? seq * 2048 + 2045 + k : T_PROMPT + (seq - 8) * 64 + 61 + k;
        const float v = bf2f(proj[(size_t)row * NP + PC_XBC + ch]);
        if (seq < 8) p.out[O_CONVP + (size_t)(l * 8 + seq) * 9216 + rem] = v; else p.out[O_CONVS + (size_t)(l * 32 + (seq - 8)) * 9216 + rem] = v;
    }
}

__device__ __forceinline__ unsigned fkey(float f) { const unsigned u = __float_as_uint(f); return u ^ ((unsigned)((int)u >> 31) | 0x80000000u); }
__device__ __forceinline__ int popc64(unsigned long long m) { return __builtin_popcountll(m); }
__device__ __forceinline__ int mbcnt64(unsigned long long m) { return (int)__builtin_amdgcn_mbcnt_hi((unsigned)(m >> 32), __builtin_amdgcn_mbcnt_lo((unsigned)m, 0u)); }
template <int NV>
__device__ __forceinline__ unsigned kth16(const unsigned (&k)[NV]) {
    unsigned prefix = 0u; bool exact = false;
#pragma unroll 1
    for (int bit = 31; bit >= 0 && !exact; --bit) { const unsigned trial = prefix | (1u << bit); int cnt = 0;
#pragma unroll
        for (int c = 0; c < NV; ++c) cnt += popc64(__ballot(k[c] >= trial));
        prefix = cnt >= 16 ? trial : prefix; exact = cnt == 16; }
    return prefix;
}
__device__ __forceinline__ void kth16x2(const unsigned (&ka)[2], const unsigned (&kb)[2], unsigned& Ta, unsigned& Tb) {
    unsigned pa = 0u, pb = 0u; bool ea = false, eb = false;
#pragma unroll 1
    for (int bit = 31; bit >= 0 && !(ea && eb); --bit) { const unsigned ta = pa | (1u << bit), tb = pb | (1u << bit);
        const int ca_ = popc64(__ballot(ka[0] >= ta)) + popc64(__ballot(ka[1] >= ta)), cb_ = popc64(__ballot(kb[0] >= tb)) + popc64(__ballot(kb[1] >= tb));
        pa = ca_ >= 16 ? ta : pa; pb = cb_ >= 16 ? tb : pb; ea = ea || ca_ == 16; eb = eb || cb_ == 16; }
    Ta = pa; Tb = pb;
}
template <int NV>
__device__ __forceinline__ void compact16(const unsigned (&k)[NV], unsigned T, const int (&pa)[NV], const int (&pb)[NV], int& oa, int& ob) {
    unsigned long long bg[NV], be[NV]; int ngt = 0;
#pragma unroll
    for (int c = 0; c < NV; ++c) { bg[c] = __ballot(k[c] > T); be[c] = __ballot(k[c] == T); ngt += popc64(bg[c]); }
    const int need = 16 - ngt; int baseg = 0, basee = 0; oa = 0; ob = 0;
#pragma unroll
    for (int c = 0; c < NV; ++c) { const bool g = k[c] > T, e = k[c] == T; const int rg = baseg + mbcnt64(bg[c]), re = basee + mbcnt64(be[c]);
        const bool sel = g || (e && re < need); const int pos = g ? rg : ngt + re; const int addr = (sel ? pos : 63) << 2;
        oa |= __builtin_amdgcn_ds_permute(addr, pa[c]); ob |= __builtin_amdgcn_ds_permute(addr, pb[c]);
        baseg += popc64(bg[c]); basee += popc64(be[c]); }
}
__device__ __forceinline__ void wave_top16x2(float (&va)[2], float (&vb)[2], int lane, float& oa, int& ia, float& ob, int& ib) {
    oa = -3.0e38f; ob = -3.0e38f; ia = 0; ib = 0;
#pragma unroll 1
    for (int it = 0; it < 16; ++it) {
        const float ma = fmaxf(va[0], va[1]), mb = fmaxf(vb[0], vb[1]);
        const float Ma = wave_max_u(ma), Mb = wave_max_u(mb);
        const int sa = __builtin_amdgcn_readfirstlane(__ffsll((long long)__ballot(ma == Ma)) - 1), sb = __builtin_amdgcn_readfirstlane(__ffsll((long long)__ballot(mb == Mb)) - 1);
        const bool ha0 = va[0] == Ma, hb0 = vb[0] == Mb;
        const int ida = ha0 ? lane : lane + 64, idb = hb0 ? lane : lane + 64;
        if (lane == sa) { if (ha0) va[0] = -3.0e38f; else va[1] = -3.0e38f; }
        if (lane == sb) { if (hb0) vb[0] = -3.0e38f; else vb[1] = -3.0e38f; }
        const int xa = __builtin_amdgcn_readlane(ida, sa), xb = __builtin_amdgcn_readlane(idb, sb);
        if (lane == it) { oa = Ma; ia = xa; ob = Mb; ib = xb; }
    }
}
__device__ __forceinline__ void wave_top16x1(float v, int id, int lane, float& outv, int& outi) {
    outv = -3.0e38f; outi = 0;
#pragma unroll 1
    for (int it = 0; it < 16; ++it) {
        const float M = wave_max_u(v);
        const int src = __builtin_amdgcn_readfirstlane(__ffsll((long long)__ballot(v == M)) - 1);
        const int sel = __builtin_amdgcn_readlane(id, src);
        if (lane == src) v = -3.0e38f;
        if (lane == it) { outv = M; outi = sel; }
    }
}
template <bool DRY>
__device__ __forceinline__ void phase_peer(const Params& p, int l) {
    const int tid = otid(), lane = tid & 63, gw = blockIdx.x * 8 + (tid >> 6), nwv = gridDim.x * 8;
    typedef float f32x2_t __attribute__((ext_vector_type(2)));
    const GAS float* scores = (const GAS float*)(p.ws + WS_PROJ); const GAS bf16_t* H = (const GAS bf16_t*)(p.ws + WS_H);
    const GAS unsigned char* UV = (const GAS unsigned char*)(p.ws + ws_uv(l));
    const GAS float* SU = (const GAS float*)(p.ws + ws_su(l)); const GAS float* SV = (const GAS float*)(p.ws + ws_sv(l));
    const GAS float* mod = (const GAS float*)(p.ws + WS_MOD); GAS float* X = (GAS float*)p.out;
    int ca, cb;
    { const int L = lane; const int thr[15] = {16, 24, 29, 33, 36, 38, 40, 42, 43, 44, 45, 46, 47, 48, 49}; const int cnt[15] = {16, 8, 5, 4, 3, 2, 2, 2, 1, 1, 1, 1, 1, 1, 1};
        int a_ = 0, pre = 0;
#pragma unroll
        for (int k = 0; k < 15; ++k) { const bool ge = L >= thr[k]; a_ += ge ? 1 : 0; pre += ge ? cnt[k] : 0; }
        ca = a_; cb = L - pre; if (L >= 50) { ca = 0; cb = 0; } }
    const bool b5 = (lane & 32) != 0, b4 = (lane & 16) != 0, b3 = (lane & 8) != 0, b2 = (lane & 4) != 0;
    const int ntok = gw < T_TOK ? (T_TOK - 1 - gw) / nwv + 1 : 0, nitems = ntok * 8;
    if (nitems == 0) return;
#define PEER_SC(q_, dst) do { const GAS float* sc_ = scores + (size_t)(gw + ((q_) >> 3) * nwv) * 2048 + ((q_) & 7) * 256; dst[0] = __builtin_nontemporal_load(sc_ + lane); dst[1] = __builtin_nontemporal_load(sc_ + 64 + lane); dst[2] = __builtin_nontemporal_load(sc_ + 128 + lane); dst[3] = __builtin_nontemporal_load(sc_ + 192 + lane); } while (0)
#define PEER_ROUTE(scv, eidx_o, gs_o) do { \
        const unsigned ka_[2] = {fkey(scv[0]), fkey(scv[1])}, kb_[2] = {fkey(scv[2]), fkey(scv[3])}; unsigned Ta_, Tb_; kth16x2(ka_, kb_, Ta_, Tb_); \
        const int pva_[2] = {__float_as_int(scv[0]), __float_as_int(scv[1])}, pvb_[2] = {__float_as_int(scv[2]), __float_as_int(scv[3])}, pid_[2] = {lane, lane + 64}; \
        int v1b_, i1_, v2b_, i2_; compact16<2>(ka_, Ta_, pva_, pid_, v1b_, i1_); compact16<2>(kb_, Tb_, pvb_, pid_, v2b_, i2_); \
          \
        const float v1a_ = __int_as_float(__shfl(v1b_, lane >> 2)); const int i1a_ = __shfl(i1_, lane >> 2) * 128; \
        unsigned kc_[4]; int pc_[4], pi_[4]; \
        _Pragma("unroll") for (int c = 0; c < 4; ++c) { const int bb_ = (lane & 3) * 4 + c; const float cv_ = v1a_ + __int_as_float(__shfl(v2b_, bb_)); kc_[c] = fkey(cv_); pc_[c] = __float_as_int(cv_); pi_[c] = i1a_ + __shfl(i2_, bb_); } \
        const unsigned Tc_ = kth16<4>(kc_); int svb_, ei_; compact16<4>(kc_, Tc_, pc_, pi_, svb_, ei_); \
        const float sv_ = lane < 16 ? __int_as_float(svb_) : -3.0e38f; const float mx_ = wave_max_u(sv_); const float ex_ = lane < 16 ? __expf(sv_ - mx_) : 0.f; \
        eidx_o = lane < 16 ? ei_ : 0; gs_o = ex_ / wave_sum_u(ex_); } while (0)
    float scn[4]; int eidx; float gs;
    PEER_SC(0, scn);
    PEER_ROUTE(scn, eidx, gs);
    if (nitems > 1) PEER_SC(1, scn);
    float xf[16]; f32x2_t acc2[8];
#pragma unroll 1
    for (int q = 0; q < nitems; ++q) {
        const int t = gw + (q >> 3) * nwv, h = q & 7;
#ifdef DRY_ROUTE_ONLY
        if (DRY) { asm volatile("" :: "v"(eidx), "v"(gs)); if (q + 1 < nitems) { float sc1[4] = {scn[0], scn[1], scn[2], scn[3]}; if (q + 2 < nitems) PEER_SC(q + 2, scn); PEER_ROUTE(sc1, eidx, gs); } continue; }
#endif
        const float su_l = lane < 16 ? SU[eidx] : 0.f, sv_l = lane < 16 ? SV[eidx] : 0.f;
        u32x4 ur[16], vr[16];
#pragma unroll
        for (int e = 0; e < 16; ++e) { const int eid = __builtin_amdgcn_readlane(eidx, e);
            const GAS unsigned char* rp_ = UV + (size_t)eid * 2048 + lane * 16; ur[e] = *(const GAS u32x4*)rp_; vr[e] = *(const GAS u32x4*)(rp_ + 1024); }
        const float gs_c = gs;
        if (h == 0) { const u32x4 a = __builtin_nontemporal_load((const GAS u32x4*)(H + (size_t)t * 1024 + lane * 16)), b = __builtin_nontemporal_load((const GAS u32x4*)(H + (size_t)t * 1024 + lane * 16 + 8));
#pragma unroll
            for (int j = 0; j < 4; ++j) { xf[2 * j] = lo_bf(a[j]); xf[2 * j + 1] = hi_bf(a[j]); xf[8 + 2 * j] = lo_bf(b[j]); xf[8 + 2 * j + 1] = hi_bf(b[j]); }
#pragma unroll
            for (int j = 0; j < 8; ++j) acc2[j] = (f32x2_t){0.f, 0.f}; }
        if (q + 1 < nitems) { float sc1[4] = {scn[0], scn[1], scn[2], scn[3]}; if (q + 2 < nitems) PEER_SC(q + 2, scn); PEER_ROUTE(sc1, eidx, gs); }
        float d[16];
        f32x2_t xp2[8];
#pragma unroll
        for (int j = 0; j < 8; ++j) xp2[j] = (f32x2_t){xf[2 * j], xf[2 * j + 1]};
#pragma unroll
        for (int e = 0; e < 16; ++e) { f32x2_t dp = (f32x2_t){0.f, 0.f};
#pragma unroll
            for (int j = 0; j < 4; ++j) { const f32x2_t lo = __builtin_amdgcn_cvt_pk_f32_fp8((int)ur[e][j], false), hi = __builtin_amdgcn_cvt_pk_f32_fp8((int)ur[e][j], true);
                dp = __builtin_elementwise_fma(xp2[2 * j], lo, dp); dp = __builtin_elementwise_fma(xp2[2 * j + 1], hi, dp); }
            d[e] = dp.x + dp.y; }
        float r8[8], r4[4], r2[2], r1;
#pragma unroll
        for (int k = 0; k < 8; ++k) { const float snd = b5 ? d[k] : d[k + 8]; r8[k] = (b5 ? d[k + 8] : d[k]) + __shfl_xor(snd, 32); }
#pragma unroll
        for (int k = 0; k < 4; ++k) { const float snd = b4 ? r8[k] : r8[k + 4]; r4[k] = (b4 ? r8[k + 4] : r8[k]) + __shfl_xor(snd, 16); }
#pragma unroll
        for (int k = 0; k < 2; ++k) { const float snd = b3 ? r4[k] : r4[k + 2]; r2[k] = (b3 ? r4[k + 2] : r4[k]) + __shfl_xor(snd, 8); }
        { const float snd = b2 ? r2[0] : r2[1]; r1 = (b2 ? r2[1] : r2[0]) + __shfl_xor(snd, 4); }
        r1 += __shfl_xor(r1, 1); r1 += __shfl_xor(r1, 2);
        const int eq = lane >> 2;
        const float act = r1 * __shfl(su_l, eq);
        const float wv = __shfl(gs_c, eq) * 0.5f * act * (1.f + erff(act * 0.7071067811865476f)) * __shfl(sv_l, eq);
#pragma unroll
        for (int e = 0; e < 16; ++e) { const float w = __int_as_float(__builtin_amdgcn_readlane(__float_as_int(wv), 4 * e));
#pragma unroll
            for (int j = 0; j < 4; ++j) { const f32x2_t lo = __builtin_amdgcn_cvt_pk_f32_fp8((int)vr[e][j], false), hi = __builtin_amdgcn_cvt_pk_f32_fp8((int)vr[e][j], true); const f32x2_t w2 = (f32x2_t){w, w};
                acc2[2 * j] = __builtin_elementwise_fma(w2, lo, acc2[2 * j]); acc2[2 * j + 1] = __builtin_elementwise_fma(w2, hi, acc2[2 * j + 1]); } }
        if (h == 7) {
            const GAS float* gp = mod + (size_t)cb_of_row(t) * 12288 + l * 6144 + 5 * 1024 + lane * 16; GAS float* xp = X + (size_t)t * 1024 + lane * 16;
            f32x4 xn[4]; float ss = 0.f;
#pragma unroll
            for (int j = 0; j < 4; ++j) { const f32x4 g = *(const GAS f32x4*)(gp + 4 * j); xn[j] = __builtin_nontemporal_load((const GAS f32x4*)(xp + 4 * j));
#pragma unroll
                for (int k = 0; k < 4; ++k) { xn[j][k] += g[k] * acc2[2 * j + (k >> 1)][k & 1]; ss += xn[j][k] * xn[j][k]; } }
            const float rstd = rsqrtf(wave_sum_u(ss) * (1.f / 1024.f) + EPSN);
            if (l == 1) { const GAS float* fw = (const GAS float*)p.in[29] + lane * 16;
#pragma unroll
                for (int j = 0; j < 4; ++j) { const f32x4 w = *(const GAS f32x4*)(fw + 4 * j); xn[j] = xn[j] * rstd * w; } }
            else if (!DRY) {
                const GAS float* nw = (const GAS float*)p.in[9] + 1024 + lane * 16; const GAS float* mp = mod + (size_t)cb_of_row(t) * 12288 + 6144 + lane * 16; u32x4 ho[2];
#pragma unroll
                for (int j = 0; j < 4; ++j) { const f32x4 w = *(const GAS f32x4*)(nw + 4 * j), sh = *(const GAS f32x4*)(mp + 4 * j), sc = *(const GAS f32x4*)(mp + 1024 + 4 * j); const f32x4 o = xn[j] * rstd * w * (sc + 1.f) + sh;
                    ho[j >> 1][(j & 1) * 2] = cvt_pk_bf16(o[0], o[1]); ho[j >> 1][(j & 1) * 2 + 1] = cvt_pk_bf16(o[2], o[3]); }
                *(GAS u32x4*)((GAS bf16_t*)(p.ws + WS_H) + (size_t)t * 1024 + lane * 16) = ho[0]; *(GAS u32x4*)((GAS bf16_t*)(p.ws + WS_H) + (size_t)t * 1024 + lane * 16 + 8) = ho[1]; }
#pragma unroll
            for (int j = 0; j < 4; ++j) { if (!DRY) __builtin_nontemporal_store(xn[j], (GAS f32x4*)(xp + 4 * j)); else asm volatile("" :: "v"(xn[j][0]), "v"(xn[j][1]), "v"(xn[j][2]), "v"(xn[j][3])); }
        }
    }
#undef PEER_SC
#undef PEER_ROUTE
}

__device__ __forceinline__ void load_params(Params& q, const LAS unsigned* tab) {
#pragma unroll
    for (int k = 0; k < 32; ++k) {
        const unsigned lo = __builtin_amdgcn_readfirstlane(tab[2 * k]), hi = __builtin_amdgcn_readfirstlane(tab[2 * k + 1]);
        const unsigned long long a = ((unsigned long long)hi << 32) | lo;
        if (k < 30) q.in[k] = (const float*)a; else if (k == 30) q.out = (float*)a; else q.ws = (unsigned char*)a;
    }
}
#define PHASE_PARAMS Params p; load_params(p, tab)

#ifdef DBG
__device__ __forceinline__ void dbg_flag(const Params& p, int code) { atomicMax((unsigned*)(p.ws + WS_BAR) + 4000, (unsigned)(1000 - code)); }
__device__ __forceinline__ void dbg_bf16(const Params& p, const bf16_t* base, int rows, int ld, int ncols, int code) {
    const int tid = otid(); bool bad = false;
    for (size_t i = (size_t)blockIdx.x * 512 + tid; i < (size_t)rows * ncols; i += (size_t)gridDim.x * 512) { const size_t r = i / ncols, c = i % ncols; const unsigned v = base[r * ld + c]; if ((v & 0x7F80u) == 0x7F80u) bad = true; }
    if (bad) dbg_flag(p, code);
}
__device__ __forceinline__ void dbg_f32(const Params& p, const float* base, int rows, int ld, int ncols, int code) {
    const int tid = otid(); bool bad = false;
    for (size_t i = (size_t)blockIdx.x * 512 + tid; i < (size_t)rows * ncols; i += (size_t)gridDim.x * 512) { const size_t r = i / ncols, c = i % ncols; const unsigned v = __float_as_uint(base[r * ld + c]); if ((v & 0x7F800000u) == 0x7F800000u) bad = true; }
    if (bad) dbg_flag(p, code);
}
#define DBG_DO(x) { { PHASE_PARAMS; x; } xcd_barrier(xb); }
#else
#define DBG_DO(x)
#endif
__global__ void __launch_bounds__(512, 2) mega_fwd(Params p0) {
    __shared__ __attribute__((aligned(16))) unsigned char smem[LDS_BYTES];
    LAS unsigned char* lds = (LAS unsigned char*)smem;
    LAS unsigned* tab = (LAS unsigned*)(lds + LDS_TAB);
    if (threadIdx.x == 0) {
        volatile LAS unsigned* st0 = (volatile LAS unsigned*)(lds + LDS_ST); st0[0] = 0u; st0[1] = 0u;
#pragma unroll
        for (int k = 0; k < 32; ++k) { const unsigned long long a = k < 30 ? (unsigned long long)p0.in[k] : (k == 30 ? (unsigned long long)p0.out : (unsigned long long)p0.ws); tab[2 * k] = (unsigned)a; tab[2 * k + 1] = (unsigned)(a >> 32); }
    }
    __syncthreads();
    const XcdBarrier xb = xcd_barrier_post((unsigned*)(p0.ws + WS_BAR), (volatile LAS unsigned*)(lds + LDS_ST));
#pragma unroll 1
    for (int l = 0; l < 2; ++l) {
        if (l == 0) {
            { PHASE_PARAMS; phase_convert(p, 0, smem, (int)blockIdx.x, (int)gridDim.x, 1); mod_gemv(p, smem, (int)blockIdx.x, (int)gridDim.x); }
            xcd_barrier(xb);
        }
        if (l == 0) {
            { PHASE_PARAMS; phase_norm(p, p.in[0], p.in[1], p.in[9], 0, 1024); }
            xcd_barrier(xb);
        }
        DBG_DO(dbg_bf16(p, (const bf16_t*)(p.ws + WS_H), T_TOK, 1024, 1024, l * 10 + 2))
        { PHASE_PARAMS; EpiInProj e; e.P = (bf16_t*)(p.ws + WS_PROJ); e.aux = (float*)(p.ws + WS_AUX);
          run_gemm<1>(lds, (const bf16_t*)(p.ws + WS_H), 1024, (const bf16_t*)(p.ws + ws_win(l)), T_TOK, NP, 1024, e);
#ifdef DUP_INPROJ
          run_gemm<1>(lds, (const bf16_t*)(p.ws + WS_H), 1024, (const bf16_t*)(p.ws + ws_win(l)), T_TOK, NP, 1024, e);
#endif
        }
        xcd_barrier(xb);
        DBG_DO(dbg_bf16(p, (const bf16_t*)(p.ws + WS_PROJ), T_TOK, NP, 10240, l * 10 + 3); dbg_f32(p, (const float*)(p.ws + WS_AUX), T_TOK, 64, 48, l * 10 + 3))
#ifndef NO_MIXER
        { PHASE_PARAMS; phase_gla_pre(p, l, lds); }
        { PHASE_PARAMS; phase_ssd_pre(p, l, lds); }
        xcd_barrier(xb);
#ifdef DUP_MIXER
        { PHASE_PARAMS; phase_mixer<true>(p, l, lds); }
#endif
        { PHASE_PARAMS; phase_mixer<false>(p, l, lds); }
#endif
        xcd_barrier(xb);
        DBG_DO(dbg_bf16(p, (const bf16_t*)(p.ws + WS_PROJ) + PC_V, T_TOK, NP, 1024, l * 10 + 4); dbg_bf16(p, (const bf16_t*)(p.ws + WS_PROJ) + PC_Z, T_TOK, NP, 2048, l * 10 + 5))
#ifndef NO_NG
        { PHASE_PARAMS; phase_normgate(p, l); }
#endif
        xcd_barrier(xb);
        DBG_DO(dbg_bf16(p, (const bf16_t*)(p.ws + WS_PROJ) + PC_V, T_TOK, NP, 1024, l * 10 + 6); dbg_bf16(p, (const bf16_t*)(p.ws + WS_PROJ) + PC_Z, T_TOK, NP, 2048, l * 10 + 6))
#ifdef STOP1
        continue;
#endif
        { PHASE_PARAMS; bf16_t* proj = (bf16_t*)(p.ws + WS_PROJ); EpiGlaProj e; e.P = proj; run_gemm<2>(lds, proj + PC_V, NP, (const bf16_t*)(p.ws + ws_wgla(l)), T_TOK, 1024, 1024, e); }
        { PHASE_PARAMS; bf16_t* proj = (bf16_t*)(p.ws + WS_PROJ); EpiSsdProj e; e.P = proj; e.H = (bf16_t*)(p.ws + WS_H); run_gemm<3>(lds, proj + PC_Z, NP, (const bf16_t*)(p.ws + ws_wssd(l)), T_TOK, 1024, 2048, e); }
        {
            const int skip = gridDim.x > 64 ? 32 : 0;
            if ((int)blockIdx.x >= skip) { PHASE_PARAMS; phase_convert(p, 1, smem, (int)blockIdx.x - skip, (int)gridDim.x - skip, l == 0 ? 1 : 12); }
        }
#ifdef DUP_GS
        { PHASE_PARAMS; bf16_t* proj = (bf16_t*)(p.ws + WS_PROJ); EpiGlaProj e; e.P = proj; run_gemm<2>(lds, proj + PC_V, NP, (const bf16_t*)(p.ws + ws_wgla(l)), T_TOK, 1024, 1024, e); }
        { PHASE_PARAMS; bf16_t* proj = (bf16_t*)(p.ws + WS_PROJ); EpiSsdProj e; e.P = proj; e.H = (bf16_t*)(p.ws + WS_H); run_gemm<3>(lds, proj + PC_Z, NP, (const bf16_t*)(p.ws + ws_wssd(l)), T_TOK, 1024, 2048, e); }
#endif
        xcd_barrier(xb);
        DBG_DO(dbg_bf16(p, (const bf16_t*)(p.ws + WS_H), T_TOK, 1024, 1024, l * 10 + 7))
        { PHASE_PARAMS; EpiWout e; e.X = p.out; e.Xa = l == 0 ? p.in[0] : p.out; e.Xb = l == 0 ? p.in[1] : p.out + (size_t)T_PROMPT * 1024; e.modg = (const float*)(p.ws + WS_MOD) + l * 6144 + 2 * 1024; run_gemm<4>(lds, (const bf16_t*)(p.ws + WS_H), 1024, (const bf16_t*)(p.ws + ws_wout(l)), T_TOK, 1024, 1024, e); }
        if (l == 0) { const int skip = gridDim.x > 64 ? 32 : 0;
            if ((int)blockIdx.x >= skip) { PHASE_PARAMS; phase_convert(p, 0, smem, (int)blockIdx.x - skip, (int)gridDim.x - skip, 4); } }
        xcd_barrier(xb);
        DBG_DO(dbg_f32(p, p.out, T_TOK, 1024, 1024, l * 10 + 8))
        { PHASE_PARAMS; phase_norm(p, p.out, p.out + (size_t)T_PROMPT * 1024, p.in[23] + l * 1024, l * 6144 + 3 * 1024, l * 6144 + 4 * 1024); }
        xcd_barrier(xb);
        DBG_DO(dbg_bf16(p, (const bf16_t*)(p.ws + WS_H), T_TOK, 1024, 1024, l * 10 + 9))
        { PHASE_PARAMS; EpiF32NT e; e.C = (float*)(p.ws + WS_PROJ); e.ldc = 2048; e.bias = nullptr; run_gemm<5>(lds, (const bf16_t*)(p.ws + WS_H), 1024, (const bf16_t*)(p.ws + ws_wpeer(l)), T_TOK, 2048, 1024, e); }
        if (l == 0) { const int skip = gridDim.x > 128 ? 64 : 0;
            if ((int)blockIdx.x >= skip) { PHASE_PARAMS; phase_convert(p, 0, smem, (int)blockIdx.x - skip, (int)gridDim.x - skip, 8); } }
#ifdef DUP_SCORES
        { PHASE_PARAMS; EpiF32NT e; e.C = (float*)(p.ws + WS_PROJ); e.ldc = 2048; e.bias = nullptr; run_gemm<5>(lds, (const bf16_t*)(p.ws + WS_H), 1024, (const bf16_t*)(p.ws + ws_wpeer(l)), T_TOK, 2048, 1024, e); }
#endif
        xcd_barrier(xb);
        DBG_DO(dbg_f32(p, (const float*)(p.ws + WS_PROJ), T_TOK, 2048, 2048, l * 10 + 10))
#ifndef NO_PEER
#ifdef DUP_PEER
        { PHASE_PARAMS; phase_peer<true>(p, l); }
#endif
        { PHASE_PARAMS; phase_peer<false>(p, l); }
#endif
        if (l == 0) xcd_barrier(xb);
    }
#ifdef DBG
    xcd_barrier(xb);
    { PHASE_PARAMS; const unsigned f = __hip_atomic_load((unsigned*)(p.ws + WS_BAR) + 4000, __ATOMIC_RELAXED, __HIP_MEMORY_SCOPE_AGENT); if (f) { const float K = 10.f * (float)(1000 - (int)f); const int tid = otid(); for (size_t i = (size_t)blockIdx.x * 512 + tid; i < (size_t)T_TOK * 1024; i += (size_t)gridDim.x * 512) p.out[i] = K; } }
#endif
#ifdef DBG2
    xcd_barrier(xb);
    { PHASE_PARAMS; const unsigned f = __hip_atomic_load((unsigned*)(p.ws + WS_BAR) + 4000, __ATOMIC_RELAXED, __HIP_MEMORY_SCOPE_AGENT); if (f) { const float K = 10.f * (float)(1 << (100 - (int)f)); const int tid = otid(); for (size_t i = (size_t)blockIdx.x * 512 + tid; i < (size_t)T_TOK * 1024; i += (size_t)gridDim.x * 512) p.out[i] = K; } }
#endif
#ifdef SANITIZE
    xcd_barrier(xb);
    { PHASE_PARAMS; const int tid = otid(); for (size_t i = (size_t)blockIdx.x * 512 + tid; i < (size_t)51068928; i += (size_t)gridDim.x * 512) { const float v = p.out[i]; if (!(fabsf(v) < 3.0e38f)) p.out[i] = 0.f; } }
#endif
}

extern "C" void kernel_launch(void* const* d_in, const int* in_sizes, int n_in, void* d_out, int out_size, void* d_ws, size_t ws_size, hipStream_t stream) {
    static int grid = 0;
    if (grid == 0) {
        if (n_in != 30 || ws_size < WS_END) { fprintf(stderr, "kernel_launch: need 30 inputs and >= %zu bytes of workspace; got %d, %zu\n", (size_t)WS_END, n_in, ws_size); grid = -1; return; }
        int dev = 0, cus = 0, per_cu = 0;
        (void)hipGetDevice(&dev); (void)hipDeviceGetAttribute(&cus, hipDeviceAttributeMultiprocessorCount, dev);
        if (hipOccupancyMaxActiveBlocksPerMultiprocessor(&per_cu, (const void*)mega_fwd, 512, 0) != hipSuccess || per_cu < 1) { fprintf(stderr, "kernel_launch: occupancy query failed (%d)\n", per_cu); (void)hipGetLastError(); per_cu = 1; }
        grid = cus * (per_cu > 1 ? 1 : per_cu);
        if (grid > 256) grid = 256;
    }
    if (grid < 0) return;
    if (hipMemsetAsync((char*)d_ws + WS_BAR, 0, 16384, stream) != hipSuccess) { fprintf(stderr, "kernel_launch: memset of the barrier words failed\n"); return; }
    Params p{};
    for (int i = 0; i < 30; ++i) p.in[i] = (const float*)d_in[i];
    p.out = (float*)d_out; p.ws = (unsigned char*)d_ws;
    void* args[] = {&p};
    hipError_t e = hipLaunchCooperativeKernel((const void*)mega_fwd, dim3(grid), dim3(512), args, 0, stream);
    if (e != hipSuccess) fprintf(stderr, "kernel_launch: cooperative launch failed: %s (grid %d)\n", hipGetErrorString(e), grid);
}
```

```cpp
#include <hip/hip_runtime.h>
#include <cstdio>
#define LAS __attribute__((address_space(3)))
namespace pg8 {
#define PG8_LAS __attribute__((address_space(3)))
typedef unsigned short bf16_t;
typedef short bf16x8 __attribute__((ext_vector_type(8)));
typedef float f32x4 __attribute__((ext_vector_type(4)));
typedef unsigned u32x4 __attribute__((ext_vector_type(4)));
constexpr int BM = 256, BK = 64, HALF = 128, HTB = HALF * BK * 2  , STAGE_BYTES = 8 * HTB, NXCD = 8, WGM = 8;

__host__ __device__ __forceinline__ int lds_byte(int r, int c) { const int st = (r >> 4) * 2 + (c >> 5), rr = r & 15, cc = c & 31, ob = rr * 64 + cc * 2; return st * 1024 + (ob ^ (((ob >> 9) & 1) << 5)); }
__host__ __device__ __forceinline__ void stage_rc(int b, int& R, int& C) { const int st = b / 1024, sb = b % 1024, swz = sb ^ (((sb >> 9) & 1) << 5); R = (st >> 1) * 16 + swz / 64; C = (st & 1) * 32 + (swz % 64) / 2; }
__host__ __device__ __forceinline__ int perm32(int rho) { const int n = rho >> 4, i = rho & 15; return 8 * (i >> 2) + 4 * n + (i & 3); }

struct Unit { int pm, pn; };
struct Gemm { const bf16_t* A; const bf16_t* Bt; int M, N, K, lda; };

struct StaticOrder {
    int nM, nN, nwg, G, c;
    __host__ __device__ void init(int M, int N, int G_, int c_) { nM = M / BM; nN = N / BM; nwg = nM * nN; G = G_; c = c_; }
    __host__ __device__ bool next(int i, Unit& u) const {
        const long L = (long)i * G + c; if (L >= nwg) return false;
        int wgid = (int)L; { const int q = nwg / NXCD, r = nwg % NXCD, xcd = wgid % NXCD, off = wgid / NXCD; wgid = (xcd < r ? xcd * (q + 1) : r * (q + 1) + (xcd - r) * q) + off; }
        const int nig = WGM * nN, gid = wgid / nig, fm = gid * WGM, gsz = (nM - fm) < WGM ? (nM - fm) : WGM;
        u.pm = fm + ((wgid % nig) % gsz); u.pn = (wgid % nig) / gsz; return true;
    }
    __device__ __forceinline__ void a_ready(const Unit&) const {}
    __device__ __forceinline__ void done(const Unit&) const {}
};
typedef float f32x2 __attribute__((ext_vector_type(2)));
typedef __bf16 bf16v2_t __attribute__((ext_vector_type(2)));
__device__ __forceinline__ unsigned cvt_pk_bf16(float lo, float hi) { const f32x2 v = {lo, hi}; return __builtin_bit_cast(unsigned, __builtin_convertvector(v, bf16v2_t)); }
template <class Epi, class Sched, bool STAMP = false>
__device__ __forceinline__ void gemm_phase(PG8_LAS unsigned char* lds, const Gemm g, const Sched& S, const Epi& E, unsigned long long* stamps) {
    int tid_ = threadIdx.x; asm volatile("" : "+v"(tid_)); const int tid = tid_, wid = __builtin_amdgcn_readfirstlane(tid >> 6), lane = tid & 63, wr = wid >> 2, wc = wid & 3, fr = lane & 15, fq = lane >> 4;
    const int K = g.K, nt = K / BK;
    int ts_lo = 0, ts_hi = 0, nts = 0; const unsigned long long rt_entry = STAMP ? (unsigned long long)wall_clock64() : 0ull;
#define PG8_STAMP() do { if (STAMP && wid == 0 && nts < 64) { const unsigned long long _c = (unsigned long long)clock64(); \
        ts_lo = (lane == nts) ? (int)(unsigned)_c : ts_lo; ts_hi = (lane == nts) ? (int)(unsigned)(_c >> 32) : ts_hi; ++nts; } } while (0)
    PG8_STAMP();
    unsigned voffA[2], voffB[2];
#pragma unroll
    for (int i = 0; i < 2; ++i) { int R, C; stage_rc(tid * 16 + i * 8192, R, C); const int Rb = Epi::PERM ? ((R & ~31) + perm32(R & 31)) : R;
        voffA[i] = (unsigned)(R * g.lda + C) * 2u; voffB[i] = (unsigned)(Rb * K + C) * 2u; }
    const size_t kstep = (size_t)(BK * 2);
    const size_t hstepB = (size_t)HALF * K * 2, hstepA = (size_t)HALF * g.lda * 2;
    const size_t tstepA = 2 * hstepA, tstepB = 2 * hstepB;
    const unsigned ldsw = (unsigned)wid * 1024u;
    const int aoff = lds_byte(wr * 64 + fr, fq * 8), boff = lds_byte(wc * 32 + fr, fq * 8);
#define PG8_SA(b, h) (((b) * 2 + (h)) * HTB)
#define PG8_SB(b, h) ((4 + (b) * 2 + (h)) * HTB)
#define PG8_STAGE(bufoff, gbase, voff) do { _Pragma("unroll") for (int _i = 0; _i < 2; ++_i) \
        __builtin_amdgcn_global_load_lds((const unsigned*)((const char*)(gbase) + (voff)[_i]), (PG8_LAS unsigned*)(lds + (bufoff) + ldsw + _i * 8192), 16, 0, 0); } while (0)
#define PG8_LDA(dst, b, h) do { _Pragma("unroll") for (int m = 0; m < 4; ++m) _Pragma("unroll") for (int k = 0; k < 2; ++k) dst[m][k] = *(const PG8_LAS bf16x8*)(lds + PG8_SA(b, h) + aoff + m * 2048 + k * 1024); } while (0)
#define PG8_LDB(dst, b, h) do { _Pragma("unroll") for (int n = 0; n < 2; ++n) _Pragma("unroll") for (int k = 0; k < 2; ++k) dst[n][k] = *(const PG8_LAS bf16x8*)(lds + PG8_SB(b, h) + boff + n * 2048 + k * 1024); } while (0)
#define PG8_MMA(ai, bj, At, Bt) do { __builtin_amdgcn_s_setprio(1); _Pragma("unroll") for (int m = 0; m < 4; ++m) _Pragma("unroll") for (int n = 0; n < 2; ++n) _Pragma("unroll") for (int k = 0; k < 2; ++k) \
        acc[ai][bj][m][n] = __builtin_amdgcn_mfma_f32_16x16x32_bf16(Bt[n][k], At[m][k], acc[ai][bj][m][n], 0, 0, 0); __builtin_amdgcn_s_setprio(0); } while (0)
#define PG8_WAIT_V(n) asm volatile("s_waitcnt vmcnt(" #n ")" ::: "memory")
#define PG8_WAIT_L(n) asm volatile("s_waitcnt lgkmcnt(" #n ")" ::: "memory")
#define PG8_BAR __builtin_amdgcn_s_barrier()
#define PG8_SCHED __builtin_amdgcn_sched_barrier(0)
    Unit cur, nxt; int ui = 0;
    if (!S.next(0, cur)) return;
    f32x4 acc[2][2][4][2];
#pragma unroll
    for (int a = 0; a < 2; ++a)
#pragma unroll
        for (int b = 0; b < 2; ++b)
#pragma unroll
            for (int m = 0; m < 4; ++m)
#pragma unroll
                for (int n = 0; n < 2; ++n) acc[a][b][m][n] = (f32x4){0.f, 0.f, 0.f, 0.f};
    bf16x8 At[4][2], B0[2][2], B1[2][2];
    const char* cA = (const char*)g.A + (size_t)cur.pm * tstepA; const char* cB = (const char*)g.Bt + (size_t)cur.pn * tstepB;
    S.a_ready(cur);
    PG8_STAGE(PG8_SB(0, 0), cB, voffB); PG8_STAGE(PG8_SA(0, 0), cA, voffA); PG8_STAGE(PG8_SB(0, 1), cB + hstepB, voffB); PG8_STAGE(PG8_SA(0, 1), cA + hstepA, voffA);
    if (wr == 1) PG8_BAR;
    PG8_WAIT_V(4); PG8_BAR;
    PG8_STAGE(PG8_SB(1, 0), cB + kstep, voffB); PG8_STAGE(PG8_SA(1, 0), cA + kstep, voffA); PG8_STAGE(PG8_SB(1, 1), cB + hstepB + kstep, voffB);
    PG8_WAIT_V(6); PG8_BAR;
    PG8_STAMP();
    for (;;) {
        const bool has_next = S.next(ui + 1, nxt);
        const char* nA = has_next ? (const char*)g.A + (size_t)nxt.pm * tstepA : cA; const char* nB = has_next ? (const char*)g.Bt + (size_t)nxt.pn * tstepB : cB;
        for (int t = 0; t < nt; t += 2) {
            const bool last = (t == nt - 2);
            const char* a1 = cA + (size_t)(t + 1) * kstep;
            const char* a2 = last ? nA : cA + (size_t)(t + 2) * kstep; const char* b2 = last ? nB : cB + (size_t)(t + 2) * kstep;
            const char* a3 = a2 + kstep; const char* b3 = b2 + kstep;
            if (last && has_next) S.a_ready(nxt);
            PG8_LDB(B0, 0, 0); PG8_SCHED; PG8_LDA(At, 0, 0); PG8_STAGE(PG8_SA(1, 1), a1 + hstepA, voffA);
            PG8_WAIT_L(8); PG8_BAR; PG8_WAIT_L(0); PG8_MMA(0, 0, At, B0); PG8_BAR; PG8_SCHED;
            PG8_LDB(B1, 0, 1); PG8_STAGE(PG8_SB(0, 0), b2, voffB);
            PG8_BAR; PG8_WAIT_L(0); PG8_MMA(0, 1, At, B1); PG8_BAR;
            PG8_LDA(At, 0, 1); PG8_STAGE(PG8_SA(0, 0), a2, voffA);
            PG8_BAR; PG8_WAIT_L(0); PG8_MMA(1, 0, At, B0); PG8_BAR; PG8_SCHED;
            PG8_STAGE(PG8_SB(0, 1), b2 + hstepB, voffB);
            PG8_WAIT_V(6); PG8_BAR; PG8_MMA(1, 1, At, B1); PG8_BAR;
            PG8_LDB(B0, 1, 0); PG8_SCHED; PG8_LDA(At, 1, 0); PG8_STAGE(PG8_SA(0, 1), a2 + hstepA, voffA);
            PG8_WAIT_L(8); PG8_BAR; PG8_WAIT_L(0); PG8_MMA(0, 0, At, B0); PG8_BAR; PG8_SCHED;
            PG8_LDB(B1, 1, 1); PG8_STAGE(PG8_SB(1, 0), b3, voffB);
            PG8_BAR; PG8_WAIT_L(0); PG8_MMA(0, 1, At, B1); PG8_BAR;
            PG8_LDA(At, 1, 1); PG8_STAGE(PG8_SA(1, 0), a3, voffA);
            PG8_BAR; PG8_WAIT_L(0); PG8_MMA(1, 0, At, B0); PG8_BAR; PG8_SCHED;
            PG8_STAGE(PG8_SB(1, 1), b3 + hstepB, voffB);
            PG8_WAIT_V(6); PG8_BAR; PG8_MMA(1, 1, At, B1); PG8_BAR;
        }
        PG8_STAMP();
        if constexpr (!Epi::AFTER_DRAIN) { E(acc, cur, wr, wc, fr, fq); S.done(cur); }
        PG8_STAMP();
        if (!has_next) break;
#pragma unroll
        for (int a = 0; a < 2; ++a)
#pragma unroll
            for (int b = 0; b < 2; ++b)
#pragma unroll
                for (int m = 0; m < 4; ++m)
#pragma unroll
                    for (int n = 0; n < 2; ++n) acc[a][b][m][n] = (f32x4){0.f, 0.f, 0.f, 0.f};
        cur = nxt; cA = nA; cB = nB; ++ui;
    }
    PG8_WAIT_V(0);
    if (wr == 0) PG8_BAR;
    PG8_BAR;
    if constexpr (Epi::AFTER_DRAIN) { E.fused(acc, cur, wr, wc, fr, fq, lds, wid, lane); S.done(cur); }
    PG8_STAMP();
    if (STAMP && wid == 0) { stamps[lane] = lane < nts ? (((unsigned long long)(unsigned)ts_hi << 32) | (unsigned)ts_lo) : 0ull;
        if (lane == 62) stamps[62] = rt_entry; if (lane == 63) stamps[63] = (unsigned long long)wall_clock64(); }
#undef PG8_STAMP
#undef PG8_SA
#undef PG8_SB
#undef PG8_STAGE
#undef PG8_LDA
#undef PG8_LDB
#undef PG8_MMA
#undef PG8_WAIT_V
#undef PG8_WAIT_L
#undef PG8_BAR
#undef PG8_SCHED
}
}
#define XB_TMO      128
#define XB_XCNT(j)  (256  + 64 * (j))
#define XB_XSUB(j)  (1280 + 64 * (j))
#define XB_XGEN(j)  (2304 + 64 * (j))
#define XB_TOP      3328
#define XB_TOPGEN   3392
#define XCD_BAR_WORDS 3456
#define XB_SPIN_CAP (1u << 18)

__device__ __forceinline__ unsigned xb_ld(unsigned* p)              { return __hip_atomic_load(p, __ATOMIC_RELAXED, __HIP_MEMORY_SCOPE_AGENT); }
__device__ __forceinline__ unsigned xb_add(unsigned* p, unsigned v) { return __hip_atomic_fetch_add(p, v, __ATOMIC_RELAXED, __HIP_MEMORY_SCOPE_AGENT); }
__device__ __forceinline__ unsigned xb_xcc_id() { return (unsigned)__builtin_amdgcn_s_getreg((3 << 11) | 20) & 0xFu; }
#define XB_SPIN(cond, bar) do { unsigned _sp = 0; while (cond) { __builtin_amdgcn_s_sleep(1); \
    if ((++_sp & 255u) == 0u) { if (xb_ld(&(bar)[XB_TMO])) break; if (_sp > XB_SPIN_CAP) { atomicAdd(&(bar)[XB_TMO], 1u); break; } } } } while (0)

struct XcdBarrier {
    unsigned* bar; unsigned x;
    volatile LAS unsigned* st;
};

__device__ __forceinline__ XcdBarrier xcd_barrier_post(unsigned* bar, volatile LAS unsigned* st) {
    XcdBarrier b; b.bar = bar; b.x = xb_xcc_id(); b.st = st;
    if (threadIdx.x == 0) (void)xb_add(&bar[XB_XCNT(b.x)], 1u);
    return b;
}
__device__ __forceinline__ void xcd_barrier_complete(unsigned* bar, unsigned x, unsigned& nloc, unsigned& nx) {
    const unsigned G = gridDim.x * gridDim.y * gridDim.z;
    unsigned sum, cnt, mine, sp = 0u;
    for (;;) {
        sum = 0u; cnt = 0u; mine = 0u;
#pragma unroll
        for (unsigned j = 0; j < 16; ++j) { const unsigned c = xb_ld(&bar[XB_XCNT(j)]); sum += c; cnt += (c > 0u) ? 1u : 0u; mine = (j == x) ? c : mine; }
        if (sum == G) break;
        __builtin_amdgcn_s_sleep(1);
        if ((++sp & 255u) == 0u) { if (xb_ld(&bar[XB_TMO])) break; if (sp > XB_SPIN_CAP) { atomicAdd(&bar[XB_TMO], 1u); break; } }
    }
    nloc = mine > 0u ? mine : 1u; nx = cnt > 0u ? cnt : 1u;
}

__device__ __forceinline__ void xcd_barrier(const XcdBarrier& b) {
    asm volatile("s_waitcnt vmcnt(0)" ::: "memory");
    __syncthreads();
    int xb_tid = threadIdx.x; asm volatile("" : "+v"(xb_tid));
    if (xb_tid == 0) {
        unsigned* bar = b.bar; asm volatile("" : "+v"(bar));
        unsigned bx = b.x; asm volatile("" : "+v"(bx));
        __builtin_amdgcn_s_waitcnt(0);
        unsigned nloc = b.st[0], nx = b.st[1];
        if (nloc == 0u) { xcd_barrier_complete(bar, bx, nloc, nx); b.st[0] = nloc; b.st[1] = nx; }
        const unsigned old = xb_add(&bar[XB_XSUB(bx)], 1u);
        const unsigned gen = old / nloc;
        if (old + 1u == (gen + 1u) * nloc) {
            __builtin_amdgcn_fence(__ATOMIC_RELEASE, "agent");
            asm volatile("s_waitcnt vmcnt(0)" ::: "memory");
            const unsigned og = xb_add(&bar[XB_TOP], 1u);
            const unsigned tg = og / nx;
            if (og + 1u == (tg + 1u) * nx) xb_add(&bar[XB_TOPGEN], 1u);
            else XB_SPIN(xb_ld(&bar[XB_TOPGEN]) == tg, bar);
            __builtin_amdgcn_fence(__ATOMIC_ACQUIRE, "agent");
            xb_add(&bar[XB_XGEN(bx)], 1u);
            asm volatile("s_waitcnt vmcnt(0)" ::: "memory");
        } else {
            XB_SPIN(xb_ld(&bar[XB_XGEN(bx)]) == gen, bar);
            __builtin_amdgcn_fence(__ATOMIC_ACQUIRE, "agent");
            asm volatile("s_waitcnt vmcnt(0)" ::: "memory");
        }
    }
    __syncthreads();
}


using pg8::bf16_t; using pg8::bf16x8; using pg8::f32x4; using pg8::u32x4; using pg8::Unit; using pg8::cvt_pk_bf16;
typedef unsigned u32x2 __attribute__((ext_vector_type(2)));
constexpr int T_TOK = 18432, T_PROMPT = 16384, DM = 1024, NP = 10496, NIN = 10288;
constexpr float EPSN = 1e-6f;
constexpr int LDS_BYTES = 163840, LDS_ST = 163328, LDS_TAB = 163344;
constexpr size_t WS_BAR = 0;
constexpr size_t WS_WADA = 16384;
constexpr size_t WS_WIN = WS_WADA + (size_t)12288 * 1024 * 2;
constexpr size_t WS_WGLA = WS_WIN + (size_t)NP * 1024 * 2;
constexpr size_t WS_WSSD = WS_WGLA + (size_t)1024 * 1024 * 2;
constexpr size_t WS_WOUT = WS_WSSD + (size_t)1024 * 2048 * 2;
constexpr size_t WS_WPEER = WS_WOUT + (size_t)1024 * 1024 * 2;
constexpr size_t WS_U = WS_WPEER + (size_t)2048 * 1024 * 2;
constexpr size_t WS_V = WS_U + (size_t)16384 * 1024 * 2;
constexpr size_t WS_SILUC = WS_V + (size_t)16384 * 1024 * 2;
constexpr size_t WS_MOD = WS_SILUC + (size_t)256 * 1024 * 2;
constexpr size_t WS_H = WS_MOD + (size_t)256 * 12288 * 4;
constexpr size_t WS_AUX = WS_H + (size_t)T_TOK * 1024 * 2;
constexpr size_t WS_PROJ = WS_AUX + (size_t)T_TOK * 64 * 4;
constexpr size_t WS_KET = WS_PROJ + (size_t)T_TOK * NP * 2;
constexpr size_t WS_ATT = WS_KET + (size_t)1152 * 8192 * 2;
constexpr size_t WS_DEC = WS_ATT + (size_t)1152 * 4096 * 2;
constexpr size_t WS_CBG = WS_DEC + (size_t)1152 * 128 * 4;
constexpr size_t WS_SM1 = WS_CBG + (size_t)1152 * 4096 * 2;
constexpr size_t WS_SCL = WS_SM1 + (size_t)12 * 1024 * 1024;
constexpr size_t WS_END = WS_SCL + (size_t)4 * 16384 * 4;
__host__ __device__ constexpr size_t ws_win(int l) { return l ? WS_WADA : WS_WIN; }
__host__ __device__ constexpr size_t ws_wgla(int l) { return l ? WS_SM1 : WS_WGLA; }
__host__ __device__ constexpr size_t ws_wssd(int l) { return l ? WS_SM1 + (size_t)2 * 1024 * 1024 : WS_WSSD; }
__host__ __device__ constexpr size_t ws_wout(int l) { return l ? WS_SM1 + (size_t)6 * 1024 * 1024 : WS_WOUT; }
__host__ __device__ constexpr size_t ws_wpeer(int l) { return l ? WS_SM1 + (size_t)8 * 1024 * 1024 : WS_WPEER; }
__host__ __device__ constexpr size_t ws_uv(int l) { return l ? WS_V : WS_U; }
__host__ __device__ constexpr size_t ws_su(int l) { return WS_SCL + (size_t)l * 131072; }
__host__ __device__ constexpr size_t ws_sv(int l) { return WS_SCL + (size_t)l * 131072 + 65536; }
constexpr int PC_Q = 0, PC_K = 512, PC_V = 1024, PC_GO = 2048, PC_Z = 3072, PC_XBC = 5120, PC_GATE = 8192;
constexpr size_t O_GLAP = 18874368, O_SSDP = 20971520, O_CONVP = 25165824, O_GLAS = 25313280, O_SSDS = 33701888, O_CONVS = 50479104;

#ifndef GEMM_MASK
#define GEMM_MASK 63
#endif
#define GAS __attribute__((address_space(1)))
struct Params { const float* in[30]; float* out; unsigned char* ws; };

__device__ __forceinline__ float bf2f(bf16_t b) { return __uint_as_float(((unsigned)b) << 16); }
__device__ __forceinline__ bf16_t f2bf(float f) { return (bf16_t)(cvt_pk_bf16(f, 0.f) & 0xffffu); }
__device__ __forceinline__ float lo_bf(unsigned w) { return __uint_as_float(w << 16); }
__device__ __forceinline__ float hi_bf(unsigned w) { return __uint_as_float(w & 0xffff0000u); }
__device__ __forceinline__ float sigmoidf_(float x) { return 1.f / (1.f + __expf(-x)); }
__device__ __forceinline__ float siluf_(float x) { return x / (1.f + __expf(-x)); }
__device__ __forceinline__ int otid() { int t = threadIdx.x; asm volatile("" : "+v"(t)); return t; }
__device__ __forceinline__ int cb_of_row(int r) { return r < T_PROMPT ? (r >> 11) : 8 + ((r - T_PROMPT) >> 6); }
__device__ __forceinline__ float wave_sum(float v) {
#pragma unroll
    for (int o = 32; o >= 1; o >>= 1) v += __shfl_xor(v, o);
    return v;
}
__device__ __forceinline__ float wave_max(float v) {
#pragma unroll
    for (int o = 32; o >= 1; o >>= 1) v = fmaxf(v, __shfl_xor(v, o));
    return v;
}

struct EpiF32 {
    static constexpr bool PERM = false, AFTER_DRAIN = false;
    float* C; int ldc; const float* bias;
    __device__ __forceinline__ void operator()(const f32x4 (&acc)[2][2][4][2], const Unit& u, int wr, int wc, int fr, int fq) const {
        const int row0 = u.pm * 256 + wr * 64 + fr, col0 = u.pn * 256 + wc * 32 + 4 * fq;
        f32x4 bv[2][2];
#pragma unroll
        for (int bj = 0; bj < 2; ++bj)
#pragma unroll
            for (int n = 0; n < 2; ++n) bv[bj][n] = bias ? *(const f32x4*)(bias + col0 + bj * 128 + n * 16) : (f32x4){0.f, 0.f, 0.f, 0.f};
#pragma unroll
        for (int ai = 0; ai < 2; ++ai)
#pragma unroll
            for (int m = 0; m < 4; ++m) { float* rowp = C + (size_t)(row0 + ai * 128 + m * 16) * ldc + col0;
#pragma unroll
                for (int bj = 0; bj < 2; ++bj)
#pragma unroll
                    for (int n = 0; n < 2; ++n) *(f32x4*)(rowp + bj * 128 + n * 16) = acc[ai][bj][m][n] + bv[bj][n]; }
    }
};
struct EpiF32NT {
    static constexpr bool PERM = false, AFTER_DRAIN = false;
    float* C; int ldc; const float* bias;
    __device__ __forceinline__ void operator()(const f32x4 (&acc)[2][2][4][2], const Unit& u, int wr, int wc, int fr, int fq) const {
        const int row0 = u.pm * 256 + wr * 64 + fr, col0 = u.pn * 256 + wc * 32 + 4 * fq;
        f32x4 bv[2][2];
#pragma unroll
        for (int bj = 0; bj < 2; ++bj)
#pragma unroll
            for (int n = 0; n < 2; ++n) bv[bj][n] = bias ? *(const f32x4*)(bias + col0 + bj * 128 + n * 16) : (f32x4){0.f, 0.f, 0.f, 0.f};
#pragma unroll
        for (int ai = 0; ai < 2; ++ai)
#pragma unroll
            for (int m = 0; m < 4; ++m) { float* rowp = C + (size_t)(row0 + ai * 128 + m * 16) * ldc + col0;
#pragma unroll
                for (int bj = 0; bj < 2; ++bj)
#pragma unroll
                    for (int n = 0; n < 2; ++n) __builtin_nontemporal_store(acc[ai][bj][m][n] + bv[bj][n], (GAS f32x4*)(rowp + bj * 128 + n * 16)); }
    }
};
struct EpiInProj {
    static constexpr bool PERM = true, AFTER_DRAIN = false;
    bf16_t* P; float* aux;
    __device__ __forceinline__ void operator()(const f32x4 (&acc)[2][2][4][2], const Unit& u, int wr, int wc, int fr, int fq) const {
        const int row0 = u.pm * 256 + wr * 64 + fr;
        if (u.pn == 40) {
            if (wc < 2) {
#pragma unroll
                for (int ai = 0; ai < 2; ++ai)
#pragma unroll
                    for (int m = 0; m < 4; ++m) { GAS float* rowp = (GAS float*)aux + (size_t)(row0 + ai * 128 + m * 16) * 64 + wc * 32 + 8 * fq;
                        *(GAS f32x4*)rowp = acc[ai][0][m][0]; *(GAS f32x4*)(rowp + 4) = acc[ai][0][m][1]; }
            }
        } else {
            const int col0 = u.pn * 256 + wc * 32 + 8 * fq;
#pragma unroll
            for (int ai = 0; ai < 2; ++ai)
#pragma unroll
                for (int m = 0; m < 4; ++m) { GAS bf16_t* rowp = (GAS bf16_t*)P + (size_t)(row0 + ai * 128 + m * 16) * NP + col0;
#pragma unroll
                    for (int bj = 0; bj < 2; ++bj) { const f32x4 v0 = acc[ai][bj][m][0], v1 = acc[ai][bj][m][1];
                        u32x4 w; w.x = cvt_pk_bf16(v0[0], v0[1]); w.y = cvt_pk_bf16(v0[2], v0[3]); w.z = cvt_pk_bf16(v1[0], v1[1]); w.w = cvt_pk_bf16(v1[2], v1[3]);
                        *(GAS u32x4*)(rowp + bj * 128) = w; } }
        }
    }
};
struct EpiGlaProj {
    static constexpr bool PERM = false, AFTER_DRAIN = false;
    bf16_t* P;
    __device__ __forceinline__ void operator()(const f32x4 (&acc)[2][2][4][2], const Unit& u, int wr, int wc, int fr, int fq) const {
        const int row0 = u.pm * 256 + wr * 64 + fr, col0 = u.pn * 256 + wc * 32 + 4 * fq;
#pragma unroll
        for (int ai = 0; ai < 2; ++ai)
#pragma unroll
            for (int m = 0; m < 4; ++m) { bf16_t* rowp = P + (size_t)(row0 + ai * 128 + m * 16) * NP + col0;
#pragma unroll
                for (int bj = 0; bj < 2; ++bj)
#pragma unroll
                    for (int n = 0; n < 2; ++n) { const f32x4 v = acc[ai][bj][m][n]; const u32x2 g = *(const u32x2*)(rowp + PC_GATE + bj * 128 + n * 16);
                        u32x2 w; w.x = cvt_pk_bf16(v[0] * sigmoidf_(lo_bf(g.x)), v[1] * sigmoidf_(hi_bf(g.x))); w.y = cvt_pk_bf16(v[2] * sigmoidf_(lo_bf(g.y)), v[3] * sigmoidf_(hi_bf(g.y)));
                        *(u32x2*)(rowp + bj * 128 + n * 16) = w; } }
    }
};
struct EpiSsdProj {
    static constexpr bool PERM = false, AFTER_DRAIN = false;
    const bf16_t* P; bf16_t* H;
    __device__ __forceinline__ void operator()(const f32x4 (&acc)[2][2][4][2], const Unit& u, int wr, int wc, int fr, int fq) const {
        const int row0 = u.pm * 256 + wr * 64 + fr, col0 = u.pn * 256 + wc * 32 + 4 * fq;
#pragma unroll
        for (int ai = 0; ai < 2; ++ai)
#pragma unroll
            for (int m = 0; m < 4; ++m) { const int row = row0 + ai * 128 + m * 16; const bf16_t* rowp = P + (size_t)row * NP + col0; bf16_t* hp = H + (size_t)row * 1024 + col0;
#pragma unroll
                for (int bj = 0; bj < 2; ++bj)
#pragma unroll
                    for (int n = 0; n < 2; ++n) { const f32x4 v = acc[ai][bj][m][n]; const u32x2 g = *(const u32x2*)(rowp + PC_GATE + 1024 + bj * 128 + n * 16); const u32x2 t = *(const u32x2*)(rowp + bj * 128 + n * 16);
                        u32x2 w; w.x = cvt_pk_bf16(lo_bf(t.x) + v[0] * sigmoidf_(lo_bf(g.x)), hi_bf(t.x) + v[1] * sigmoidf_(hi_bf(g.x)));
                        w.y = cvt_pk_bf16(lo_bf(t.y) + v[2] * sigmoidf_(lo_bf(g.y)), hi_bf(t.y) + v[3] * sigmoidf_(hi_bf(g.y)));
                        *(u32x2*)(hp + bj * 128 + n * 16) = w; } }
    }
};
struct EpiWout {
    static constexpr bool PERM = false, AFTER_DRAIN = false;
    float* X; const float* Xa; const float* Xb; const float* modg;
    __device__ __forceinline__ void operator()(const f32x4 (&acc)[2][2][4][2], const Unit& u, int wr, int wc, int fr, int fq) const {
        const int row0 = u.pm * 256 + wr * 64 + fr, col0 = u.pn * 256 + wc * 32 + 4 * fq;
#pragma unroll
        for (int ai = 0; ai < 2; ++ai)
#pragma unroll
            for (int m = 0; m < 4; ++m) { const int row = row0 + ai * 128 + m * 16; float* xp = X + (size_t)row * 1024 + col0; const float* xi = (row < T_PROMPT ? Xa + (size_t)row * 1024 : Xb + (size_t)(row - T_PROMPT) * 1024) + col0; const float* gp = modg + (size_t)cb_of_row(row) * 12288 + col0;
#pragma unroll
                for (int bj = 0; bj < 2; ++bj)
#pragma unroll
                    for (int n = 0; n < 2; ++n) { const f32x4 g = *(const f32x4*)(gp + bj * 128 + n * 16); f32x4 xv = *(const f32x4*)(xi + bj * 128 + n * 16); xv = xv + g * acc[ai][bj][m][n]; *(f32x4*)(xp + bj * 128 + n * 16) = xv; } }
    }
};

template <int ID, class Epi>
__device__ __forceinline__ void run_gemm(LAS unsigned char* lds, const bf16_t* A, int lda, const bf16_t* Bt, int M, int N, int K, const Epi& E) {
    pg8::Gemm g; g.A = A; g.Bt = Bt; g.M = M; g.N = N; g.K = K; g.lda = lda;
    pg8::StaticOrder S; S.init(M, N, (int)gridDim.x, (int)blockIdx.x);
#ifndef NO_GEMM
    if (!((GEMM_MASK >> ID) & 1)) return;
    pg8::gemm_phase<Epi, pg8::StaticOrder, false>(lds, g, S, E, nullptr);
#endif
    __syncthreads();
}

__device__ __forceinline__ int win_src_col(int n) {
    if (n < 3072) return n;
    if (n < 8192) return n + 16;
    if (n < 10240) return n + 48;
    if (n < 10256) return n - 10240 + 3072;
    if (n < 10288) return n - 10256 + 8208;
    return -1;
}
template <bool MAP>
__device__ __forceinline__ void tconv_tile(const float* W, int Nsrc, bf16_t* Wt, int ldt, int k0, int n0, float* tile, int tid) {
    {
        const int nn = tid & 63, n = n0 + nn; const int sc = MAP ? win_src_col(n) : n;
#pragma unroll
        for (int i = 0; i < 8; ++i) { const int kk = i * 8 + (tid >> 6); tile[kk * 65 + nn] = sc >= 0 ? __builtin_nontemporal_load(W + (size_t)(k0 + kk) * Nsrc + sc) : 0.f; }
    }
    __syncthreads();
    {
        const int nn = tid >> 3, ks = (tid & 7) * 8; const float* s = tile + ks * 65 + nn;
        u32x4 o; o.x = cvt_pk_bf16(s[0], s[65]); o.y = cvt_pk_bf16(s[2 * 65], s[3 * 65]); o.z = cvt_pk_bf16(s[4 * 65], s[5 * 65]); o.w = cvt_pk_bf16(s[6 * 65], s[7 * 65]);
        *(u32x4*)(Wt + (size_t)(n0 + nn) * ldt + k0 + ks) = o;
    }
    __syncthreads();
}
__device__ __forceinline__ void conv_rows_bf16(const float* src, bf16_t* dst, size_t n8, int bid, int nb, int tid) {
    for (size_t i = (size_t)bid * 512 + tid; i < n8; i += (size_t)nb * 512) {
        const f32x4 a = *(const f32x4*)(src + i * 8), b = *(const f32x4*)(src + i * 8 + 4);
        u32x4 o; o.x = cvt_pk_bf16(a[0], a[1]); o.y = cvt_pk_bf16(a[2], a[3]); o.z = cvt_pk_bf16(b[0], b[1]); o.w = cvt_pk_bf16(b[2], b[3]);
        *(u32x4*)(dst + i * 8) = o;
    }
}
#define DPPF(old, src, ctrl, rm, bm) __int_as_float(__builtin_amdgcn_update_dpp(__float_as_int(old), __float_as_int(src), ctrl, rm, bm, false))
__device__ __forceinline__ float wave_max_u(float v) {
    const float ninf = -3.4e38f;
    v = fmaxf(v, DPPF(ninf, v, 0x111, 0xf, 0xf)); v = fmaxf(v, DPPF(ninf, v, 0x112, 0xf, 0xf)); v = fmaxf(v, DPPF(ninf, v, 0x114, 0xf, 0xf)); v = fmaxf(v, DPPF(ninf, v, 0x118, 0xf, 0xf));
    v = fmaxf(v, DPPF(ninf, v, 0x142, 0xa, 0xf)); v = fmaxf(v, DPPF(ninf, v, 0x143, 0xc, 0xf));
    return __int_as_float(__builtin_amdgcn_readlane(__float_as_int(v), 63));
}
__device__ __forceinline__ float wave_sum_u(float v) {
    v += DPPF(0.f, v, 0x111, 0xf, 0xf); v += DPPF(0.f, v, 0x112, 0xf, 0xf); v += DPPF(0.f, v, 0x114, 0xf, 0xf); v += DPPF(0.f, v, 0x118, 0xf, 0xf);
    v += DPPF(0.f, v, 0x142, 0xa, 0xf); v += DPPF(0.f, v, 0x143, 0xc, 0xf);
    return __int_as_float(__builtin_amdgcn_readlane(__float_as_int(v), 63));
}
__device__ __forceinline__ void conv_rows_fp8(const float* src, unsigned char* dst, float* scl, int bid, int nb, int tid, int row_lo, int row_hi) {
    const int lane = tid & 63;
    for (int row = row_lo + bid * 8 + (tid >> 6); row < row_hi; row += nb * 8) {
        const GAS f32x4* sp = (const GAS f32x4*)((const GAS float*)src + (size_t)row * 1024) + lane; f32x4 v[4]; float am = 0.f;
#pragma unroll
        for (int j = 0; j < 4; ++j) { v[j] = __builtin_nontemporal_load(sp + 64 * j); am = fmaxf(am, fmaxf(fmaxf(fabsf(v[j][0]), fabsf(v[j][1])), fmaxf(fabsf(v[j][2]), fabsf(v[j][3])))); }
        am = wave_max_u(am); const float q = am > 0.f ? 448.f / am : 1.f;
        GAS unsigned* dp = (GAS unsigned*)((GAS unsigned char*)dst + (size_t)row * 2048) + lane;
#pragma unroll
        for (int j = 0; j < 4; ++j) { int w = 0; w = __builtin_amdgcn_cvt_pk_fp8_f32(v[j][0] * q, v[j][1] * q, w, false); w = __builtin_amdgcn_cvt_pk_fp8_f32(v[j][2] * q, v[j][3] * q, w, true); dp[64 * j] = (unsigned)w; }
        if (lane == 0) scl[row] = am > 0.f ? am * (1.f / 448.f) : 1.f;
    }
}
__device__ __forceinline__ void mod_gemv(const Params& p, unsigned char* smem, int bid, int nb) {
    typedef __bf16 bf16v2_l __attribute__((ext_vector_type(2)));
    const int tid = otid(), wid = tid >> 6, lane = tid & 63;
    unsigned* sc2 = (unsigned*)smem;
    float* part = (float*)(smem + 81920);
    GAS float* mod = (GAS float*)(p.ws + WS_MOD); const GAS float* bias = (const GAS float*)p.in[8];
    for (int idx = tid; idx < 40 * 512; idx += 512) { const int cb = idx >> 9, kp = idx & 511; const GAS float* cp = cb < 8 ? (const GAS float*)p.in[5] + cb * 1024 : (const GAS float*)p.in[6] + (cb - 8) * 1024;
        sc2[kp * 40 + cb] = cvt_pk_bf16(siluf_(cp[2 * kp]), siluf_(cp[2 * kp + 1])); }
    __syncthreads();
    for (int cg = bid; cg < 192; cg += nb) {
        const int n = cg * 64 + lane, la = n / 6144, nn = n - la * 6144;
        const GAS float* W = (const GAS float*)p.in[7] + (size_t)la * 1024 * 6144 + nn + (size_t)(wid * 128) * 6144;
        float acc[40];
#pragma unroll
        for (int r = 0; r < 40; ++r) acc[r] = 0.f;
#pragma unroll 1
        for (int kb = 0; kb < 64; kb += 16) {
            float wv[32];
#pragma unroll
            for (int j = 0; j < 32; ++j) wv[j] = __builtin_nontemporal_load(W + (size_t)(2 * kb + j) * 6144);
#pragma unroll
            for (int j = 0; j < 16; ++j) { const bf16v2_l wp = __builtin_bit_cast(bf16v2_l, cvt_pk_bf16(wv[2 * j], wv[2 * j + 1])); const unsigned* sr = sc2 + (wid * 64 + kb + j) * 40;
#pragma unroll
                for (int r = 0; r < 40; ++r) acc[r] = __builtin_amdgcn_fdot2_f32_bf16(wp, __builtin_bit_cast(bf16v2_l, sr[r]), acc[r], false); }
        }
#pragma unroll
        for (int half = 0; half < 2; ++half) {
#pragma unroll
            for (int r = 0; r < 20; ++r) part[(wid * 20 + r) * 64 + lane] = acc[half * 20 + r];
            __syncthreads();
            for (int o = tid; o < 20 * 64; o += 512) { const int r = o >> 6, c = o & 63; float sum = 0.f;
#pragma unroll
                for (int w = 0; w < 8; ++w) sum += part[(w * 20 + r) * 64 + c];
                const int n2 = cg * 64 + c; mod[(size_t)(half * 20 + r) * 12288 + n2] = sum + bias[n2]; }
            __syncthreads();
        }
    }
}
__device__ __forceinline__ void phase_convert(const Params& p, int l, unsigned char* smem, int bid, int nb, int parts) {
    const int tid = otid();
    float* tile = (float*)smem;
    if (parts & 1) {
    for (int it = bid; it < 164 * 16; it += nb) { const int nt = it / 16, kt = it % 16;
        tconv_tile<true>(p.in[10] + (size_t)l * 1024 * NIN, NIN, (bf16_t*)(p.ws + ws_win(l)), 1024, kt * 64, nt * 64, tile, tid); }
    for (int it = bid; it < 256; it += nb) { const int nt = it / 16, kt = it % 16;
        tconv_tile<false>(p.in[14] + (size_t)l * 1024 * 1024, 1024, (bf16_t*)(p.ws + ws_wgla(l)), 1024, kt * 64, nt * 64, tile, tid); }
    for (int it = bid; it < 512; it += nb) { const int nt = it / 32, kt = it % 32;
        tconv_tile<false>(p.in[21] + (size_t)l * 2048 * 1024, 1024, (bf16_t*)(p.ws + ws_wssd(l)), 2048, kt * 64, nt * 64, tile, tid); }
    for (int it = bid; it < 256; it += nb) { const int nt = it / 16, kt = it % 16;
        tconv_tile<false>(p.in[22] + (size_t)l * 1024 * 1024, 1024, (bf16_t*)(p.ws + ws_wout(l)), 1024, kt * 64, nt * 64, tile, tid); }
    }
    if (parts & 12) {
        const int rlo = (parts & 4) ? 0 : 8192, rhi = (parts & 8) ? 16384 : 8192;
        conv_rows_fp8(p.in[27] + (size_t)l * 16384 * 1024, p.ws + ws_uv(l), (float*)(p.ws + ws_su(l)), bid, nb, tid, rlo, rhi);
        conv_rows_fp8(p.in[28] + (size_t)l * 16384 * 1024, p.ws + ws_uv(l) + 1024, (float*)(p.ws + ws_sv(l)), bid, nb, tid, rlo, rhi);
    }
    if (parts & 1)
    {
        float* keysL = (float*)smem; float* wqL = keysL + 64 * 129;
        bf16_t* WpT = (bf16_t*)(p.ws + ws_wpeer(l));
        for (int it = bid; it < 512; it += nb) {
            const int nt = it >> 4, mt = it & 15, n0 = nt * 64, m0 = mt * 64, h = n0 >> 8, half = (n0 >> 7) & 1, k0 = n0 & 127;
            const float* kp = (half ? p.in[26] : p.in[25]) + ((size_t)(l * 8 + h) * 128 + k0) * 128;
            const float* wp = p.in[24] + (size_t)l * 1024 * 2048 + (size_t)m0 * 2048 + h * 256 + half * 128;
#pragma unroll
            for (int i = 0; i < 16; ++i) { const int idx = tid + 512 * i, r = idx >> 7, d = idx & 127; keysL[r * 129 + d] = kp[r * 128 + d]; wqL[r * 129 + d] = wp[(size_t)r * 2048 + d]; }
            __syncthreads();
            const int nn = tid >> 3, ms = (tid & 7) * 8; float a[8] = {0.f, 0.f, 0.f, 0.f, 0.f, 0.f, 0.f, 0.f};
            for (int d = 0; d < 128; ++d) { const float kv = keysL[nn * 129 + d];
#pragma unroll
                for (int j = 0; j < 8; ++j) a[j] += kv * wqL[(ms + j) * 129 + d]; }
            u32x4 o; o.x = cvt_pk_bf16(a[0], a[1]); o.y = cvt_pk_bf16(a[2], a[3]); o.z = cvt_pk_bf16(a[4], a[5]); o.w = cvt_pk_bf16(a[6], a[7]);
            *(u32x4*)(WpT + (size_t)(n0 + nn) * 1024 + m0 + ms) = o;
            __syncthreads();
        }
    }
}

__device__ __forceinline__ void phase_norm(const Params& p, const float* Xa, const float* Xb, const float* nw, int off_sh, int off_sc) {
    const int tid = otid(), lane = tid & 63, gw = blockIdx.x * 8 + (tid >> 6), nw_ = gridDim.x * 8;
    const GAS float* mod = (const GAS float*)(p.ws + WS_MOD); GAS bf16_t* H = (GAS bf16_t*)(p.ws + WS_H);
    f32x4 wv[4];
#pragma unroll
    for (int j = 0; j < 4; ++j) wv[j] = *(const GAS f32x4*)((const GAS float*)nw + lane * 4 + 256 * j);
    constexpr int RB = 3;
    for (int row0 = gw; row0 < T_TOK; row0 += nw_ * RB) {
        f32x4 v[RB][4];
#pragma unroll
        for (int r = 0; r < RB; ++r) { const int row = row0 + r * nw_; if (row < T_TOK) { const GAS f32x4* xr = (const GAS f32x4*)(row < T_PROMPT ? Xa + (size_t)row * 1024 : Xb + (size_t)(row - T_PROMPT) * 1024) + lane;
#pragma unroll
                for (int j = 0; j < 4; ++j) v[r][j] = xr[64 * j]; } }
#pragma unroll
        for (int r = 0; r < RB; ++r) { const int row = row0 + r * nw_; if (row < T_TOK) { float ss = 0.f;
#pragma unroll
                for (int j = 0; j < 4; ++j) ss += v[r][j][0] * v[r][j][0] + v[r][j][1] * v[r][j][1] + v[r][j][2] * v[r][j][2] + v[r][j][3] * v[r][j][3];
                const float rstd = rsqrtf(wave_sum_u(ss) * (1.f / 1024.f) + EPSN);
                const GAS float* mp = mod + (size_t)cb_of_row(row) * 12288;
#pragma unroll
                for (int j = 0; j < 4; ++j) { const int col = lane * 4 + 256 * j;
                    const f32x4 sc = *(const GAS f32x4*)(mp + off_sc + col), sh = *(const GAS f32x4*)(mp + off_sh + col);
                    const f32x4 o = v[r][j] * rstd * wv[j] * (sc + 1.f) + sh;
                    u32x2 pk; pk.x = cvt_pk_bf16(o[0], o[1]); pk.y = cvt_pk_bf16(o[2], o[3]);
                    *(GAS u32x2*)(H + (size_t)row * 1024 + col) = pk; } } }
    }
}

__device__ __forceinline__ bf16x8 ldfrag(const LAS bf16_t* base, int stride, int r0, int k0, int lane) {
    return *(const LAS bf16x8*)(base + (r0 + (lane & 15)) * stride + k0 + (lane >> 4) * 8);
}
__device__ __forceinline__ f32x4 mfma16(bf16x8 a, bf16x8 b, f32x4 c) { return __builtin_amdgcn_mfma_f32_16x16x32_bf16(a, b, c, 0, 0, 0); }


#ifdef DBG2
__device__ __forceinline__ void dbg2(const Params& p, bool bad, int e) { if (bad) atomicMax((unsigned*)(p.ws + WS_BAR) + 4000, (unsigned)(100 - e)); }
__device__ __forceinline__ bool nonfin(float v) { return (__float_as_uint(v) & 0x7F800000u) == 0x7F800000u; }
#define DBG2(bad, e) dbg2(p, bad, e)
#else
#define DBG2(bad, e)
#endif
__device__ __forceinline__ void gla_pre_item(const Params& p, int l, LAS unsigned char* lds, int item) {
    const int tid = otid(), wid = tid >> 6, lane = tid & 63, quad = lane >> 4, l15 = lane & 15;
    LAS bf16_t* Q = (LAS bf16_t*)(lds + 0); LAS bf16_t* Kt = (LAS bf16_t*)(lds + 17408); LAS bf16_t* KeT = (LAS bf16_t*)(lds + 34816);
    LAS bf16_t* Att = (LAS bf16_t*)(lds + 57856);
    LAS float* bsum = (LAS float*)(lds + 75776); LAS float* ptot = (LAS float*)(lds + 108544); LAS float* gl = (LAS float*)(lds + 110592); LAS float* dec = (LAS float*)(lds + 114688);
    GAS bf16_t* proj = (GAS bf16_t*)(p.ws + WS_PROJ); const GAS float* aux = (const GAS float*)(p.ws + WS_AUX);
    const int gc = item >> 2, h = item & 3, r0 = gc * 64;
    const int d = tid & 127, part = tid >> 7;
    float w2c[16];
#pragma unroll
    for (int r = 0; r < 16; ++r) w2c[r] = ((const GAS float*)p.in[11])[(size_t)(l * 16 + r) * 512 + h * 128 + d];
    const float gb = ((const GAS float*)p.in[12])[l * 512 + h * 128 + d];
    const int gi = (tid >> 2) & 63, gq4 = (tid & 3) * 4, qr = tid >> 4, qc8 = (tid & 15) * 8;
    {
        const f32x4 n_gl = *(const GAS f32x4*)(aux + (size_t)(r0 + gi) * 64 + gq4); u32x4 n_q[2], n_k[2];
#pragma unroll
        for (int q_ = 0; q_ < 2; ++q_) { const GAS bf16_t* rp_ = proj + (size_t)(r0 + qr + 32 * q_) * NP + h * 128 + qc8; n_q[q_] = *(const GAS u32x4*)(rp_ + PC_Q); n_k[q_] = *(const GAS u32x4*)(rp_ + PC_K); }
        __syncthreads();
        if (tid < 256) *(LAS f32x4*)(gl + gi * 16 + gq4) = n_gl;
#pragma unroll
        for (int q_ = 0; q_ < 2; ++q_) { *(LAS u32x4*)(Q + (qr + 32 * q_) * 136 + qc8) = n_q[q_]; *(LAS u32x4*)(Kt + (qr + 32 * q_) * 136 + qc8) = n_k[q_]; }
    }
    __syncthreads();
    { float run = 0.f;
#pragma unroll 4
        for (int ii = 0; ii < 16; ++ii) { const int i = part * 16 + ii; float z = gb;
#pragma unroll
            for (int r = 0; r < 16; ++r) z += gl[i * 16 + r] * w2c[r];
            const float g = (fminf(z, 0.f) - __logf(1.f + __expf(-fabsf(z)))) * (1.f / 16.f);
            run += g; bsum[i * 128 + d] = run; }
        ptot[part * 128 + d] = run; }
    __syncthreads();
    { float off = 0.f, tot = 0.f;
#pragma unroll
        for (int pp = 0; pp < 4; ++pp) { const float t = ptot[pp * 128 + d]; if (pp < part) off += t; tot += t; }
        const float etot = __expf(tot);
        if (part == 0) dec[d] = etot;
#pragma unroll
        for (int i8 = 0; i8 < 2; ++i8) { float ke[8];
#pragma unroll
            for (int ii = 0; ii < 8; ++ii) { const int i = part * 16 + i8 * 8 + ii; const float b = bsum[i * 128 + d] + off;
                const float qv = bf2f(Q[i * 136 + d]), kv = bf2f(Kt[i * 136 + d]); const float enb = __expf(-b);
                Q[i * 136 + d] = f2bf(qv * 0.08838834764831845f * __expf(b)); Kt[i * 136 + d] = f2bf(kv * enb); ke[ii] = kv * (etot * enb); }
            u32x4 o; o.x = cvt_pk_bf16(ke[0], ke[1]); o.y = cvt_pk_bf16(ke[2], ke[3]); o.z = cvt_pk_bf16(ke[4], ke[5]); o.w = cvt_pk_bf16(ke[6], ke[7]);
            *(LAS u32x4*)(KeT + d * 72 + part * 16 + i8 * 8) = o; } }
    __syncthreads();
    { const int ti = wid >> 1;
#pragma unroll
        for (int t2 = 0; t2 < 2; ++t2) { const int tj = (wid & 1) * 2 + t2; f32x4 a = (f32x4){0.f, 0.f, 0.f, 0.f};
            if (tj <= ti) {
#pragma unroll
                for (int kk = 0; kk < 4; ++kk) a = mfma16(ldfrag(Q, 136, ti * 16, kk * 32, lane), ldfrag(Kt, 136, tj * 16, kk * 32, lane), a); }
#pragma unroll
            for (int jj = 0; jj < 4; ++jj) { const int i = ti * 16 + quad * 4 + jj, j = tj * 16 + l15; Att[i * 72 + j] = f2bf(j <= i ? a[jj] : 0.f); } } }
    __syncthreads();
    {
#pragma unroll
        for (int q_ = 0; q_ < 2; ++q_) *(GAS u32x4*)(proj + (size_t)(r0 + qr + 32 * q_) * NP + h * 128 + qc8 + PC_Q) = *(const LAS u32x4*)(Q + (qr + 32 * q_) * 136 + qc8);
        GAS bf16_t* ket = (GAS bf16_t*)(p.ws + WS_KET) + (size_t)item * 8192;
#pragma unroll
        for (int q_ = 0; q_ < 2; ++q_) { const int idx = tid + 512 * q_, dd = idx >> 3, c8 = (idx & 7) * 8; *(GAS u32x4*)(ket + dd * 64 + c8) = *(const LAS u32x4*)(KeT + dd * 72 + c8); }
        GAS bf16_t* att = (GAS bf16_t*)(p.ws + WS_ATT) + (size_t)item * 4096;
        { const int ii = tid >> 3, c8 = (tid & 7) * 8; *(GAS u32x4*)(att + ii * 64 + c8) = *(const LAS u32x4*)(Att + ii * 72 + c8); }
        if (tid < 32) *(GAS f32x4*)((GAS float*)(p.ws + WS_DEC) + (size_t)item * 128 + tid * 4) = *(const LAS f32x4*)(dec + tid * 4);
    }
}
__device__ __forceinline__ void phase_gla_pre(const Params& p, int l, LAS unsigned char* lds) {
    for (int it = blockIdx.x; it < 1152; it += gridDim.x) gla_pre_item(p, l, lds, it);
}

template <bool DRY>
__device__ __forceinline__ void gla_chain(const Params& p, int l, LAS unsigned char* lds, int seq, int h, int sl) {
    const int tid = otid(), wid = tid >> 6, lane = tid & 63, quad = lane >> 4, l15 = lane & 15;
    GAS bf16_t* proj = (GAS bf16_t*)(p.ws + WS_PROJ);
    const GAS bf16_t* ketg = (const GAS bf16_t*)(p.ws + WS_KET); const GAS bf16_t* attg = (const GAS bf16_t*)(p.ws + WS_ATT); const GAS float* decg = (const GAS float*)(p.ws + WS_DEC);
    const bool samp = seq >= 8; const int nch = samp ? 1 : 32; const int gc0 = samp ? 256 + (seq - 8) : seq * 32;
    const int d0 = wid * 16 + quad * 4;
    f32x4 S[2];
    if (samp) { const GAS float* sp = (const GAS float*)p.in[2] + (size_t)((l * 32 + (seq - 8)) * 4 + h) * 32768;
#pragma unroll
        for (int te = 0; te < 2; ++te)
#pragma unroll
            for (int jj = 0; jj < 4; ++jj) S[te][jj] = sp[(d0 + jj) * 256 + sl * 32 + te * 16 + l15];
    } else { S[0] = (f32x4){0.f, 0.f, 0.f, 0.f}; S[1] = S[0]; }
    const int vj = tid >> 3, ve4 = (tid & 7) * 4, qr = tid >> 4, qc8 = (tid & 15) * 8, kd = tid >> 3, kc8 = (tid & 7) * 8;
    u32x2 n_v; u32x4 n_q[2], n_ke[2], n_att; f32x4 n_dec;
#define GLA_ISSUE(c_) do { const int gc_ = gc0 + (c_), r0_ = gc_ * 64, it_ = gc_ * 4 + h; \
        n_v = *(const GAS u32x2*)(proj + (size_t)(r0_ + vj) * NP + PC_V + h * 256 + sl * 32 + ve4); \
        _Pragma("unroll") for (int q_ = 0; q_ < 2; ++q_) { n_q[q_] = *(const GAS u32x4*)(proj + (size_t)(r0_ + qr + 32 * q_) * NP + h * 128 + qc8 + PC_Q); \
            n_ke[q_] = *(const GAS u32x4*)(ketg + (size_t)it_ * 8192 + (kd + 64 * q_) * 64 + kc8); } \
        n_att = *(const GAS u32x4*)(attg + (size_t)it_ * 4096 + kd * 64 + kc8); \
        if (tid < 32) n_dec = *(const GAS f32x4*)(decg + (size_t)it_ * 128 + tid * 4); } while (0)
    GLA_ISSUE(0);
    __syncthreads();
    { LAS bf16_t* ST = (LAS bf16_t*)(lds + 67072);
#pragma unroll
        for (int te = 0; te < 2; ++te) { u32x2 w; w.x = cvt_pk_bf16(S[te][0], S[te][1]); w.y = cvt_pk_bf16(S[te][2], S[te][3]); *(LAS u32x2*)(ST + (te * 16 + l15) * 136 + d0) = w; } }
    for (int c = 0; c < nch; ++c) {
        const int r0 = (gc0 + c) * 64;
        int lz = 0; asm volatile("" : "+v"(lz));
        LAS unsigned char* L = lds + lz;
        LAS bf16_t* Q = (LAS bf16_t*)(L + 0); LAS bf16_t* KeT = (LAS bf16_t*)(L + 34816);
        LAS bf16_t* vT = (LAS bf16_t*)(L + 53248); LAS bf16_t* Att = (LAS bf16_t*)(L + 57856); LAS bf16_t* ST = (LAS bf16_t*)(L + 67072); LAS float* dec = (LAS float*)(L + 114688);
        vT[(ve4 + 0) * 72 + vj] = (bf16_t)(n_v.x & 0xffffu); vT[(ve4 + 1) * 72 + vj] = (bf16_t)(n_v.x >> 16); vT[(ve4 + 2) * 72 + vj] = (bf16_t)(n_v.y & 0xffffu); vT[(ve4 + 3) * 72 + vj] = (bf16_t)(n_v.y >> 16);
#pragma unroll
        for (int q_ = 0; q_ < 2; ++q_) { *(LAS u32x4*)(Q + (qr + 32 * q_) * 136 + qc8) = n_q[q_]; *(LAS u32x4*)(KeT + (kd + 64 * q_) * 72 + kc8) = n_ke[q_]; }
        *(LAS u32x4*)(Att + kd * 72 + kc8) = n_att;
        if (tid < 32) *(LAS f32x4*)(dec + tid * 4) = n_dec;
        if (c + 1 < nch) GLA_ISSUE(c + 1);
        __syncthreads();
        { const int ti = wid >> 1, te = wid & 1; f32x4 a = (f32x4){0.f, 0.f, 0.f, 0.f};
#pragma unroll
            for (int kk = 0; kk < 2; ++kk) a = mfma16(ldfrag(Att, 72, ti * 16, kk * 32, lane), ldfrag(vT, 72, te * 16, kk * 32, lane), a);
#pragma unroll
            for (int kk = 0; kk < 4; ++kk) a = mfma16(ldfrag(Q, 136, ti * 16, kk * 32, lane), ldfrag(ST, 136, te * 16, kk * 32, lane), a);
#pragma unroll
            for (int jj = 0; jj < 4; ++jj) { const int i = ti * 16 + quad * 4 + jj; if (!DRY) proj[(size_t)(r0 + i) * NP + PC_V + h * 256 + sl * 32 + te * 16 + l15] = f2bf(a[jj]); else asm volatile("" :: "v"(a[jj])); } }
        { f32x4 dcv = *(const LAS f32x4*)(dec + d0);
#pragma unroll
            for (int te = 0; te < 2; ++te) { f32x4 a = (f32x4){0.f, 0.f, 0.f, 0.f};
#pragma unroll
                for (int kk = 0; kk < 2; ++kk) a = mfma16(ldfrag(KeT, 72, wid * 16, kk * 32, lane), ldfrag(vT, 72, te * 16, kk * 32, lane), a);
                S[te] = S[te] * dcv + a; } }
        __syncthreads();
#pragma unroll
        for (int te = 0; te < 2; ++te) { u32x2 w; w.x = cvt_pk_bf16(S[te][0], S[te][1]); w.y = cvt_pk_bf16(S[te][2], S[te][3]); *(LAS u32x2*)(ST + (te * 16 + l15) * 136 + d0) = w; }
    }
#undef GLA_ISSUE
    GAS float* so = (GAS float*)p.out + (samp ? O_GLAS + (size_t)((l * 32 + (seq - 8)) * 4 + h) * 32768 : O_GLAP + (size_t)((l * 8 + seq) * 4 + h) * 32768);
#pragma unroll
    for (int te = 0; te < 2; ++te)
#pragma unroll
        for (int jj = 0; jj < 4; ++jj) { if (!DRY) so[(d0 + jj) * 256 + sl * 32 + te * 16 + l15] = S[te][jj]; else asm volatile("" :: "v"(S[te][jj])); }
}

__device__ __forceinline__ void ssd_pre_item(const Params& p, int l, LAS unsigned char* lds, int item) {
    const int tid = otid(), wid = tid >> 6, lane = tid & 63, quad = lane >> 4, l15 = lane & 15;
    LAS bf16_t* rawT = (LAS bf16_t*)(lds + 0);
    LAS bf16_t* Bm = (LAS bf16_t*)(lds + 36864); LAS bf16_t* BT = (LAS bf16_t*)(lds + 54272); LAS bf16_t* Cm = (LAS bf16_t*)(lds + 72704); LAS bf16_t* CBl = (LAS bf16_t*)(lds + 90112);
    const GAS bf16_t* proj = (const GAS bf16_t*)(p.ws + WS_PROJ);
    const int gc = item >> 2, g = item & 3, r0 = gc * 64;
    const bool first = gc >= 256 || (gc & 31) == 0, samp = gc >= 256;
    u32x4 n_p[5];
#pragma unroll
    for (int j = 0; j < 5; ++j) { const int q_ = tid + 512 * j, rr = q_ >> 5, pc = q_ & 31; const int gcol = pc < 16 ? 2048 + g * 128 + pc * 8 : 2560 + g * 128 + (pc - 16) * 8;
        if (rr < 67 && (rr >= 3 || !first)) n_p[j] = *(const GAS u32x4*)(proj + (size_t)(r0 - 3 + rr) * NP + PC_XBC + gcol); }
    const int ch = tid & 255, half = tid >> 8; const int chan = ch < 128 ? 2048 + g * 128 + ch : 2560 + g * 128 + (ch - 128);
    const GAS float* cw = (const GAS float*)p.in[15] + (size_t)l * 4 * 3072; const float w0 = cw[chan], w1 = cw[3072 + chan], w2 = cw[2 * 3072 + chan], w3 = cw[3 * 3072 + chan], bb = ((const GAS float*)p.in[16])[(size_t)l * 3072 + chan];
    __syncthreads();
#pragma unroll
    for (int j = 0; j < 5; ++j) { const int q_ = tid + 512 * j, rr = q_ >> 5, pc = q_ & 31; if (rr < 67 && (rr >= 3 || !first)) *(LAS u32x4*)(rawT + rr * 264 + pc * 8) = n_p[j]; }
    if (first) { const GAS float* cprev = (const GAS float*)p.in[4] + (size_t)(l * 32 + (samp ? gc - 256 : 0)) * 3 * 3072;
        for (int idx = tid; idx < 768; idx += 512) { const int k = idx >> 8, c2 = idx & 255; const int chan2 = c2 < 128 ? 2048 + g * 128 + c2 : 2560 + g * 128 + (c2 - 128);
            rawT[k * 264 + c2] = samp ? f2bf(cprev[(size_t)k * 3072 + chan2]) : (bf16_t)0; } }
    __syncthreads();
    { const int i0 = half * 32; float x0 = bf2f(rawT[(i0 + 0) * 264 + ch]), x1 = bf2f(rawT[(i0 + 1) * 264 + ch]), x2 = bf2f(rawT[(i0 + 2) * 264 + ch]);
#pragma unroll
        for (int i8 = 0; i8 < 4; ++i8) { float a8[8];
#pragma unroll
            for (int ii = 0; ii < 8; ++ii) { const int i = i0 + i8 * 8 + ii; const float x3 = bf2f(rawT[(i + 3) * 264 + ch]); const float cv = bb + w0 * x0 + w1 * x1 + w2 * x2 + w3 * x3; a8[ii] = siluf_(cv);
                const bf16_t av = f2bf(a8[ii]);
                if (ch < 128) Bm[i * 136 + ch] = av; else Cm[i * 136 + (ch - 128)] = av;
                x0 = x1; x1 = x2; x2 = x3; }
            if (ch < 128) { u32x4 o; o.x = cvt_pk_bf16(a8[0], a8[1]); o.y = cvt_pk_bf16(a8[2], a8[3]); o.z = cvt_pk_bf16(a8[4], a8[5]); o.w = cvt_pk_bf16(a8[6], a8[7]); *(LAS u32x4*)(BT + ch * 72 + i0 + i8 * 8) = o; } } }
    __syncthreads();
    { const int ti = wid >> 1;
#pragma unroll
        for (int t2 = 0; t2 < 2; ++t2) { const int tj = (wid & 1) * 2 + t2; f32x4 a = (f32x4){0.f, 0.f, 0.f, 0.f};
            if (tj <= ti) {
#pragma unroll
                for (int kk = 0; kk < 4; ++kk) a = mfma16(ldfrag(Cm, 136, ti * 16, kk * 32, lane), ldfrag(Bm, 136, tj * 16, kk * 32, lane), a); }
#pragma unroll
            for (int jj = 0; jj < 4; ++jj) CBl[(ti * 16 + quad * 4 + jj) * 72 + tj * 16 + l15] = f2bf(a[jj]); } }
    __syncthreads();
    { GAS bf16_t* cact = (GAS bf16_t*)(p.ws + WS_H) + (size_t)item * 8192; GAS bf16_t* btg = (GAS bf16_t*)(p.ws + WS_H) + (size_t)1152 * 8192 + (size_t)item * 8192; GAS bf16_t* cbg = (GAS bf16_t*)(p.ws + WS_CBG) + (size_t)item * 4096;
#pragma unroll
        for (int q_ = 0; q_ < 2; ++q_) { const int idx = tid + 512 * q_;
            { const int rr = idx >> 4, c8 = (idx & 15) * 8; *(GAS u32x4*)(cact + rr * 128 + c8) = *(const LAS u32x4*)(Cm + rr * 136 + c8); }
            { const int ss = idx >> 3, c8 = (idx & 7) * 8; *(GAS u32x4*)(btg + ss * 64 + c8) = *(const LAS u32x4*)(BT + ss * 72 + c8); } }
        { const int ii = tid >> 3, c8 = (tid & 7) * 8; *(GAS u32x4*)(cbg + ii * 64 + c8) = *(const LAS u32x4*)(CBl + ii * 72 + c8); } }
}
__device__ __forceinline__ void phase_ssd_pre(const Params& p, int l, LAS unsigned char* lds) {
    for (int it = (int)((blockIdx.x + gridDim.x / 2) % gridDim.x); it < 1152; it += gridDim.x) ssd_pre_item(p, l, lds, it);
}

template <bool DRY>
__device__ __forceinline__ void ssd_chain(const Params& p, int l, LAS unsigned char* lds, int seq, int hd) {
    const int tid = otid(), wid = tid >> 6, lane = tid & 63, quad = lane >> 4, l15 = lane & 15;
    GAS bf16_t* proj = (GAS bf16_t*)(p.ws + WS_PROJ); const GAS float* aux = (const GAS float*)(p.ws + WS_AUX);
    const GAS bf16_t* cactg = (const GAS bf16_t*)(p.ws + WS_H); const GAS bf16_t* btgg = (const GAS bf16_t*)(p.ws + WS_H) + (size_t)1152 * 8192; const GAS bf16_t* cbgg = (const GAS bf16_t*)(p.ws + WS_CBG);
    const bool samp = seq >= 8; const int nch = samp ? 1 : 32; const int gc0 = samp ? 256 + (seq - 8) : seq * 32;
    const int g = hd >> 3, s0 = wid * 16 + quad * 4;
    const float Ah = -__expf(p.in[18][l * 32 + hd]), Dh = p.in[19][l * 32 + hd], dtb = p.in[17][l * 32 + hd];
    f32x4 S[4];
    if (samp) { const GAS float* sp = (const GAS float*)p.in[3] + (size_t)((l * 32 + (seq - 8)) * 32 + hd) * 8192;
#pragma unroll
        for (int tp = 0; tp < 4; ++tp) S[tp] = *(const GAS f32x4*)(sp + (tp * 16 + l15) * 128 + s0);
    } else {
#pragma unroll
        for (int tp = 0; tp < 4; ++tp) S[tp] = (f32x4){0.f, 0.f, 0.f, 0.f}; }
    const int xch = tid & 63, xpart = tid >> 6; const int xchan = hd * 64 + xch;
    const GAS float* cw = (const GAS float*)p.in[15] + (size_t)l * 4 * 3072; const float w0 = cw[xchan], w1 = cw[3072 + xchan], w2 = cw[2 * 3072 + xchan], w3 = cw[3 * 3072 + xchan], bb = ((const GAS float*)p.in[16])[(size_t)l * 3072 + xchan];
    const int pr = tid >> 4, pc8 = (tid & 15) * 8, kd = tid >> 3, kc8 = (tid & 7) * 8;
    u32x4 n_c[2], n_bt[2], n_cb, n_x[2]; float n_dt = 0.f;
#define SSD_ISSUE(c_) do { const int gc_ = gc0 + (c_), r0_ = gc_ * 64, it_ = gc_ * 4 + g; \
        if (wid == 0) n_dt = aux[(size_t)(r0_ + lane) * 64 + 16 + hd]; \
        _Pragma("unroll") for (int q_ = 0; q_ < 2; ++q_) { n_c[q_] = *(const GAS u32x4*)(cactg + (size_t)it_ * 8192 + (pr + 32 * q_) * 128 + pc8); n_bt[q_] = *(const GAS u32x4*)(btgg + (size_t)it_ * 8192 + (kd + 64 * q_) * 64 + kc8); \
            const int rr = kd + 64 * q_; if (rr < 67 && (rr >= 3 || (c_) > 0)) n_x[q_] = *(const GAS u32x4*)(proj + (size_t)(r0_ - 3 + rr) * NP + PC_XBC + hd * 64 + kc8); } \
        n_cb = *(const GAS u32x4*)(cbgg + (size_t)it_ * 4096 + kd * 64 + kc8); } while (0)
    SSD_ISSUE(0);
    __syncthreads();
    { LAS bf16_t* Sl = (LAS bf16_t*)(lds + 72704);
#pragma unroll
        for (int tp = 0; tp < 4; ++tp) { u32x2 w; w.x = cvt_pk_bf16(S[tp][0], S[tp][1]); w.y = cvt_pk_bf16(S[tp][2], S[tp][3]); *(LAS u32x2*)(Sl + (tp * 16 + l15) * 136 + s0) = w; } }
    for (int c = 0; c < nch; ++c) {
        const int r0 = (gc0 + c) * 64;
        int lz = 0; asm volatile("" : "+v"(lz));
        LAS unsigned char* L = lds + lz;
        LAS bf16_t* xT = (LAS bf16_t*)(L + 0); LAS bf16_t* xwT = (LAS bf16_t*)(L + 9216); LAS bf16_t* Cm = (LAS bf16_t*)(L + 18432); LAS bf16_t* BT = (LAS bf16_t*)(L + 35840);
        LAS bf16_t* CBl = (LAS bf16_t*)(L + 54272); LAS bf16_t* Wm = (LAS bf16_t*)(L + 63488); LAS bf16_t* Sl = (LAS bf16_t*)(L + 72704);
        LAS float* a_arr = (LAS float*)(L + 90112); LAS float* dt_arr = (LAS float*)(L + 90368); LAS bf16_t* rawT = (LAS bf16_t*)(L + 90624);
#pragma unroll
        for (int q_ = 0; q_ < 2; ++q_) { *(LAS u32x4*)(Cm + (pr + 32 * q_) * 136 + pc8) = n_c[q_]; *(LAS u32x4*)(BT + (kd + 64 * q_) * 72 + kc8) = n_bt[q_];
            const int rr = kd + 64 * q_; if (rr < 67 && (rr >= 3 || c > 0)) *(LAS u32x4*)(rawT + rr * 72 + kc8) = n_x[q_]; }
        *(LAS u32x4*)(CBl + kd * 72 + kc8) = n_cb;
        if (c == 0 && tid < 192) { const int k = tid >> 6, c2 = tid & 63; const GAS float* cprev = (const GAS float*)p.in[4] + (size_t)(l * 32 + (samp ? seq - 8 : 0)) * 3 * 3072;
            rawT[k * 72 + c2] = samp ? f2bf(cprev[(size_t)k * 3072 + hd * 64 + c2]) : (bf16_t)0; }
        unsigned short zc[8];
#pragma unroll
        for (int t2 = 0; t2 < 2; ++t2)
#pragma unroll
            for (int jj = 0; jj < 4; ++jj) zc[t2 * 4 + jj] = proj[(size_t)(r0 + (wid >> 1) * 16 + quad * 4 + jj) * NP + PC_Z + hd * 64 + ((wid & 1) * 2 + t2) * 16 + l15];
        if (wid == 0) { const float dtr = n_dt + dtb; const float dtv = fmaxf(dtr, 0.f) + log1pf(__expf(-fabsf(dtr)));
            float da = dtv * Ah;
#pragma unroll
            for (int o = 1; o < 64; o <<= 1) { const float t = __shfl_up(da, o); if (lane >= o) da += t; }
            a_arr[lane] = da; dt_arr[lane] = dtv; }
        if (c + 1 < nch) SSD_ISSUE(c + 1);
        __syncthreads();
        { const float a_last = a_arr[63]; const int i0 = xpart * 8;
            float x0 = bf2f(rawT[(i0 + 0) * 72 + xch]), x1 = bf2f(rawT[(i0 + 1) * 72 + xch]), x2 = bf2f(rawT[(i0 + 2) * 72 + xch]);
            float av[8], aw[8];
#pragma unroll
            for (int ii = 0; ii < 8; ++ii) { const int i = i0 + ii; const float x3 = bf2f(rawT[(i + 3) * 72 + xch]); const float cv = bb + w0 * x0 + w1 * x1 + w2 * x2 + w3 * x3; const float act = siluf_(cv);
                av[ii] = act; aw[ii] = act * dt_arr[i] * __expf(a_last - a_arr[i]);
                x0 = x1; x1 = x2; x2 = x3; }
            { u32x4 o1, o2;
#pragma unroll
                for (int k = 0; k < 4; ++k) { o1[k] = cvt_pk_bf16(av[2 * k], av[2 * k + 1]); o2[k] = cvt_pk_bf16(aw[2 * k], aw[2 * k + 1]); }
                *(LAS u32x4*)(xT + xch * 72 + i0) = o1; *(LAS u32x4*)(xwT + xch * 72 + i0) = o2; }
            const int wi = tid >> 3, wj0 = (tid & 7) * 8; const u32x4 cbv = *(const LAS u32x4*)(CBl + wi * 72 + wj0); const float ai = a_arr[wi]; float wv[8];
#pragma unroll
            for (int k = 0; k < 4; ++k) { const int j = wj0 + 2 * k; wv[2 * k] = j <= wi ? lo_bf(cbv[k]) * __expf(ai - a_arr[j]) * dt_arr[j] : 0.f; wv[2 * k + 1] = (j + 1) <= wi ? hi_bf(cbv[k]) * __expf(ai - a_arr[j + 1]) * dt_arr[j + 1] : 0.f; }
            u32x4 wo; wo.x = cvt_pk_bf16(wv[0], wv[1]); wo.y = cvt_pk_bf16(wv[2], wv[3]); wo.z = cvt_pk_bf16(wv[4], wv[5]); wo.w = cvt_pk_bf16(wv[6], wv[7]);
            *(LAS u32x4*)(Wm + wi * 72 + wj0) = wo; }
        __syncthreads();
        { const int ti = wid >> 1;
#pragma unroll
            for (int t2 = 0; t2 < 2; ++t2) { const int tp = (wid & 1) * 2 + t2; f32x4 yi = (f32x4){0.f, 0.f, 0.f, 0.f}, yo = yi;
#pragma unroll
                for (int kk = 0; kk < 2; ++kk) yi = mfma16(ldfrag(Wm, 72, ti * 16, kk * 32, lane), ldfrag(xT, 72, tp * 16, kk * 32, lane), yi);
#pragma unroll
                for (int kk = 0; kk < 4; ++kk) yo = mfma16(ldfrag(Cm, 136, ti * 16, kk * 32, lane), ldfrag(Sl, 136, tp * 16, kk * 32, lane), yo);
                const int pcol = tp * 16 + l15;
#pragma unroll
                for (int jj = 0; jj < 4; ++jj) { const int i = ti * 16 + quad * 4 + jj; const float xv = bf2f(xT[pcol * 72 + i]);
                    float y = yi[jj] + __expf(a_arr[i]) * yo[jj] + Dh * xv;
                    y *= siluf_(bf2f(zc[t2 * 4 + jj])); if (!DRY) proj[(size_t)(r0 + i) * NP + PC_Z + hd * 64 + pcol] = f2bf(y); else asm volatile("" :: "v"(y)); } } }
        { const float el = __expf(a_arr[63]);
#pragma unroll
            for (int tp = 0; tp < 4; ++tp) { f32x4 a = (f32x4){0.f, 0.f, 0.f, 0.f};
#pragma unroll
                for (int kk = 0; kk < 2; ++kk) a = mfma16(ldfrag(BT, 72, wid * 16, kk * 32, lane), ldfrag(xwT, 72, tp * 16, kk * 32, lane), a);
                S[tp] = S[tp] * el + a; } }
        __syncthreads();
#pragma unroll
        for (int tp = 0; tp < 4; ++tp) { u32x2 w; w.x = cvt_pk_bf16(S[tp][0], S[tp][1]); w.y = cvt_pk_bf16(S[tp][2], S[tp][3]); *(LAS u32x2*)(Sl + (tp * 16 + l15) * 136 + s0) = w; }
    }
#undef SSD_ISSUE
    GAS float* so = (GAS float*)p.out + (samp ? O_SSDS + (size_t)((l * 32 + (seq - 8)) * 32 + hd) * 8192 : O_SSDP + (size_t)((l * 8 + seq) * 32 + hd) * 8192);
#pragma unroll
    for (int tp = 0; tp < 4; ++tp) { if (!DRY) *(GAS f32x4*)(so + (tp * 16 + l15) * 128 + s0) = S[tp]; else asm volatile("" :: "v"(S[tp][0]), "v"(S[tp][1]), "v"(S[tp][2]), "v"(S[tp][3])); }
}

template <bool DRY>
__device__ __forceinline__ void phase_mixer(const Params& p, int l, LAS unsigned char* lds) {
    const int vb = (gridDim.x & 7) == 0 ? (int)((blockIdx.x & 7) * (gridDim.x >> 3) + (blockIdx.x >> 3)) : (int)blockIdx.x;
    for (int it = vb; it < 2560; it += gridDim.x) {
#ifdef DRY_GLA_ONLY
        if (DRY && ((it >= 256 && it < 512) || it >= 1536)) continue;
#endif
#ifdef DRY_PROMPT_ONLY
        if (DRY && it >= 512) continue;
#endif
#ifndef NO_GLA
        if (it < 256) gla_chain<DRY>(p, l, lds, it >> 5, (it >> 3) & 3, it & 7);
#else
        if (it < 256) {}
#endif
#ifndef NO_SSD
        else if (it < 512) { const int i = it - 256; ssd_chain<DRY>(p, l, lds, i >> 5, i & 31); }
#endif
#ifndef NO_GLA
        else if (it < 1536) { const int i = it - 512; gla_chain<DRY>(p, l, lds, 8 + (i >> 5), (i >> 3) & 3, i & 7); }
#endif
#ifndef NO_SSD
        else { const int i = it - 1536; ssd_chain<DRY>(p, l, lds, 8 + (i >> 5), i & 31); }
#endif
    }
}

__device__ __forceinline__ void phase_normgate(const Params& p, int l) {
    const int tid = otid(), lane = tid & 63, gw = blockIdx.x * 8 + (tid >> 6), nwv = gridDim.x * 8;
    GAS bf16_t* proj = (GAS bf16_t*)(p.ws + WS_PROJ);
    const GAS float* gnw = (const GAS float*)p.in[13] + l * 256; const GAS float* snw = (const GAS float*)p.in[20] + l * 2048;
    for (int row = gw; row < T_TOK; row += nwv) {
        GAS bf16_t* rp = proj + (size_t)row * NP;
        u32x4 q[4];
#pragma unroll
        for (int k = 0; k < 4; ++k) q[k] = *(const GAS u32x4*)(rp + PC_Z + lane * 32 + k * 8);
        {
            u32x4 a = *(const GAS u32x4*)(rp + PC_V + lane * 16), b = *(const GAS u32x4*)(rp + PC_V + lane * 16 + 8);
            const u32x4 ga = *(const GAS u32x4*)(rp + PC_GO + lane * 16), gb2 = *(const GAS u32x4*)(rp + PC_GO + lane * 16 + 8);
            float v[16], gg[16];
#pragma unroll
            for (int j = 0; j < 4; ++j) { v[2 * j] = lo_bf(a[j]); v[2 * j + 1] = hi_bf(a[j]); v[8 + 2 * j] = lo_bf(b[j]); v[8 + 2 * j + 1] = hi_bf(b[j]);
                gg[2 * j] = lo_bf(ga[j]); gg[2 * j + 1] = hi_bf(ga[j]); gg[8 + 2 * j] = lo_bf(gb2[j]); gg[8 + 2 * j + 1] = hi_bf(gb2[j]); }
            float ss = 0.f;
#pragma unroll
            for (int j = 0; j < 16; ++j) ss += v[j] * v[j];
            ss += __shfl_xor(ss, 1); ss += __shfl_xor(ss, 2); ss += __shfl_xor(ss, 4); ss += __shfl_xor(ss, 8);
            const float rstd = rsqrtf(ss * (1.f / 256.f) + EPSN); const int e0 = (lane * 16) & 255;
#pragma unroll
            for (int j = 0; j < 16; ++j) v[j] = v[j] * rstd * gnw[e0 + j] * siluf_(gg[j]);
#pragma unroll
            for (int j = 0; j < 4; ++j) { a[j] = cvt_pk_bf16(v[2 * j], v[2 * j + 1]); b[j] = cvt_pk_bf16(v[8 + 2 * j], v[8 + 2 * j + 1]); }
            *(GAS u32x4*)(rp + PC_V + lane * 16) = a; *(GAS u32x4*)(rp + PC_V + lane * 16 + 8) = b;
        }
        {
            float ss = 0.f;
#pragma unroll
            for (int k = 0; k < 4; ++k) {
#pragma unroll
                for (int j = 0; j < 4; ++j) { const float x0 = lo_bf(q[k][j]), x1 = hi_bf(q[k][j]); ss += x0 * x0 + x1 * x1; } }
            ss += __shfl_xor(ss, 1); ss += __shfl_xor(ss, 2); ss += __shfl_xor(ss, 4); ss += __shfl_xor(ss, 8);
            const float rstd = rsqrtf(ss * (1.f / 512.f) + EPSN);
#pragma unroll
            for (int k = 0; k < 4; ++k) {
#pragma unroll
                for (int j = 0; j < 4; ++j) { const int cc = lane * 32 + k * 8 + 2 * j; q[k][j] = cvt_pk_bf16(lo_bf(q[k][j]) * rstd * snw[cc], hi_bf(q[k][j]) * rstd * snw[cc + 1]); }
                *(GAS u32x4*)(rp + PC_Z + lane * 32 + k * 8) = q[k]; }
        }
    }
    for (int idx = blockIdx.x * 512 + tid; idx < 40 * 9216; idx += gridDim.x * 512) {
        const int seq = idx / 9216, rem = idx % 9216, k = rem / 3072, ch = rem % 3072;
        const int row = seq < 8 ? seq * 2048 + 2045 + k : T_PROMPT + (seq - 8) * 64 + 61 + k;
        const float v = bf2f(proj[(size_t)row * NP + PC_XBC + ch]);
        if (seq < 8) p.out[O_CONVP + (size_t)(l * 8 + seq) * 9216 + rem] = v; else p.out[O_CONVS + (size_t)(l * 32 + (seq - 8)) * 9216 + rem] = v;
    }
}

__device__ __forceinline__ unsigned fkey(float f) { const unsigned u = __float_as_uint(f); return u ^ ((unsigned)((int)u >> 31) | 0x80000000u); }
__device__ __forceinline__ int popc64(unsigned long long m) { return __builtin_popcountll(m); }
__device__ __forceinline__ int mbcnt64(unsigned long long m) { return (int)__builtin_amdgcn_mbcnt_hi((unsigned)(m >> 32), __builtin_amdgcn_mbcnt_lo((unsigned)m, 0u)); }
template <int NV>
__device__ __forceinline__ unsigned kth16(const unsigned (&k)[NV]) {
    unsigned prefix = 0u; bool exact = false;
#pragma unroll 1
    for (int bit = 31; bit >= 0 && !exact; --bit) { const unsigned trial = prefix | (1u << bit); int cnt = 0;
#pragma unroll
        for (int c = 0; c < NV; ++c) cnt += popc64(__ballot(k[c] >= trial));
        prefix = cnt >= 16 ? trial : prefix; exact = cnt == 16; }
    return prefix;
}
__device__ __forceinline__ void kth16x2(const unsigned (&ka)[2], const unsigned (&kb)[2], unsigned& Ta, unsigned& Tb) {
    unsigned pa = 0u, pb = 0u; bool ea = false, eb = false;
#pragma unroll 1
    for (int bit = 31; bit >= 0 && !(ea && eb); --bit) { const unsigned ta = pa | (1u << bit), tb = pb | (1u << bit);
        const int ca_ = popc64(__ballot(ka[0] >= ta)) + popc64(__ballot(ka[1] >= ta)), cb_ = popc64(__ballot(kb[0] >= tb)) + popc64(__ballot(kb[1] >= tb));
        pa = ca_ >= 16 ? ta : pa; pb = cb_ >= 16 ? tb : pb; ea = ea || ca_ == 16; eb = eb || cb_ == 16; }
    Ta = pa; Tb = pb;
}
template <int NV>
__device__ __forceinline__ void compact16(const unsigned (&k)[NV], unsigned T, const int (&pa)[NV], const int (&pb)[NV], int& oa, int& ob) {
    unsigned long long bg[NV], be[NV]; int ngt = 0;
#pragma unroll
    for (int c = 0; c < NV; ++c) { bg[c] = __ballot(k[c] > T); be[c] = __ballot(k[c] == T); ngt += popc64(bg[c]); }
    const int need = 16 - ngt; int baseg = 0, basee = 0; oa = 0; ob = 0;
#pragma unroll
    for (int c = 0; c < NV; ++c) { const bool g = k[c] > T, e = k[c] == T; const int rg = baseg + mbcnt64(bg[c]), re = basee + mbcnt64(be[c]);
        const bool sel = g || (e && re < need); const int pos = g ? rg : ngt + re; const int addr = (sel ? pos : 63) << 2;
        oa |= __builtin_amdgcn_ds_permute(addr, pa[c]); ob |= __builtin_amdgcn_ds_permute(addr, pb[c]);
        baseg += popc64(bg[c]); basee += popc64(be[c]); }
}
__device__ __forceinline__ void wave_top16x2(float (&va)[2], float (&vb)[2], int lane, float& oa, int& ia, float& ob, int& ib) {
    oa = -3.0e38f; ob = -3.0e38f; ia = 0; ib = 0;
#pragma unroll 1
    for (int it = 0; it < 16; ++it) {
        const float ma = fmaxf(va[0], va[1]), mb = fmaxf(vb[0], vb[1]);
        const float Ma = wave_max_u(ma), Mb = wave_max_u(mb);
        const int sa = __builtin_amdgcn_readfirstlane(__ffsll((long long)__ballot(ma == Ma)) - 1), sb = __builtin_amdgcn_readfirstlane(__ffsll((long long)__ballot(mb == Mb)) - 1);
        const bool ha0 = va[0] == Ma, hb0 = vb[0] == Mb;
        const int ida = ha0 ? lane : lane + 64, idb = hb0 ? lane : lane + 64;
        if (lane == sa) { if (ha0) va[0] = -3.0e38f; else va[1] = -3.0e38f; }
        if (lane == sb) { if (hb0) vb[0] = -3.0e38f; else vb[1] = -3.0e38f; }
        const int xa = __builtin_amdgcn_readlane(ida, sa), xb = __builtin_amdgcn_readlane(idb, sb);
        if (lane == it) { oa = Ma; ia = xa; ob = Mb; ib = xb; }
    }
}
__device__ __forceinline__ void wave_top16x1(float v, int id, int lane, float& outv, int& outi) {
    outv = -3.0e38f; outi = 0;
#pragma unroll 1
    for (int it = 0; it < 16; ++it) {
        const float M = wave_max_u(v);
        const int src = __builtin_amdgcn_readfirstlane(__ffsll((long long)__ballot(v == M)) - 1);
        const int sel = __builtin_amdgcn_readlane(id, src);
        if (lane == src) v = -3.0e38f;
        if (lane == it) { outv = M; outi = sel; }
    }
}
template <bool DRY>
__device__ __forceinline__ void phase_peer(const Params& p, int l) {
    const int tid = otid(), lane = tid & 63, gw = blockIdx.x * 8 + (tid >> 6), nwv = gridDim.x * 8;
    typedef float f32x2_t __attribute__((ext_vector_type(2)));
    const GAS float* scores = (const GAS float*)(p.ws + WS_PROJ); const GAS bf16_t* H = (const GAS bf16_t*)(p.ws + WS_H);
    const GAS unsigned char* UV = (const GAS unsigned char*)(p.ws + ws_uv(l));
    const GAS float* SU = (const GAS float*)(p.ws + ws_su(l)); const GAS float* SV = (const GAS float*)(p.ws + ws_sv(l));
    const GAS float* mod = (const GAS float*)(p.ws + WS_MOD); GAS float* X = (GAS float*)p.out;
    int ca, cb;
    { const int L = lane; const int thr[15] = {16, 24, 29, 33, 36, 38, 40, 42, 43, 44, 45, 46, 47, 48, 49}; const int cnt[15] = {16, 8, 5, 4, 3, 2, 2, 2, 1, 1, 1, 1, 1, 1, 1};
        int a_ = 0, pre = 0;
#pragma unroll
        for (int k = 0; k < 15; ++k) { const bool ge = L >= thr[k]; a_ += ge ? 1 : 0; pre += ge ? cnt[k] : 0; }
        ca = a_; cb = L - pre; if (L >= 50) { ca = 0; cb = 0; } }
    const bool b5 = (lane & 32) != 0, b4 = (lane & 16) != 0, b3 = (lane & 8) != 0, b2 = (lane & 4) != 0;
    const int ntok = gw < T_TOK ? (T_TOK - 1 - gw) / nwv + 1 : 0, nitems = ntok * 8;
    if (nitems == 0) return;
#define PEER_SC(q_, dst) do { const GAS float* sc_ = scores + (size_t)(gw + ((q_) >> 3) * nwv) * 2048 + ((q_) & 7) * 256; dst[0] = __builtin_nontemporal_load(sc_ + lane); dst[1] = __builtin_nontemporal_load(sc_ + 64 + lane); dst[2] = __builtin_nontemporal_load(sc_ + 128 + lane); dst[3] = __builtin_nontemporal_load(sc_ + 192 + lane); } while (0)
#define PEER_ROUTE(scv, eidx_o, gs_o) do { \
        const unsigned ka_[2] = {fkey(scv[0]), fkey(scv[1])}, kb_[2] = {fkey(scv[2]), fkey(scv[3])}; unsigned Ta_, Tb_; kth16x2(ka_, kb_, Ta_, Tb_); \
        const int pva_[2] = {__float_as_int(scv[0]), __float_as_int(scv[1])}, pvb_[2] = {__float_as_int(scv[2]), __float_as_int(scv[3])}, pid_[2] = {lane, lane + 64}; \
        int v1b_, i1_, v2b_, i2_; compact16<2>(ka_, Ta_, pva_, pid_, v1b_, i1_); compact16<2>(kb_, Tb_, pvb_, pid_, v2b_, i2_); \
          \
        const float v1a_ = __int_as_float(__shfl(v1b_, lane >> 2)); const int i1a_ = __shfl(i1_, lane >> 2) * 128; \
        unsigned kc_[4]; int pc_[4], pi_[4]; \
        _Pragma("unroll") for (int c = 0; c < 4; ++c) { const int bb_ = (lane & 3) * 4 + c; const float cv_ = v1a_ + __int_as_float(__shfl(v2b_, bb_)); kc_[c] = fkey(cv_); pc_[c] = __float_as_int(cv_); pi_[c] = i1a_ + __shfl(i2_, bb_); } \
        const unsigned Tc_ = kth16<4>(kc_); int svb_, ei_; compact16<4>(kc_, Tc_, pc_, pi_, svb_, ei_); \
        const float sv_ = lane < 16 ? __int_as_float(svb_) : -3.0e38f; const float mx_ = wave_max_u(sv_); const float ex_ = lane < 16 ? __expf(sv_ - mx_) : 0.f; \
        eidx_o = lane < 16 ? ei_ : 0; gs_o = ex_ / wave_sum_u(ex_); } while (0)
    float scn[4]; int eidx; float gs;
    PEER_SC(0, scn);
    PEER_ROUTE(scn, eidx, gs);
    if (nitems > 1) PEER_SC(1, scn);
    float xf[16]; f32x2_t acc2[8];
#pragma unroll 1
    for (int q = 0; q < nitems; ++q) {
        const int t = gw + (q >> 3) * nwv, h = q & 7;
#ifdef DRY_ROUTE_ONLY
        if (DRY) { asm volatile("" :: "v"(eidx), "v"(gs)); if (q + 1 < nitems) { float sc1[4] = {scn[0], scn[1], scn[2], scn[3]}; if (q + 2 < nitems) PEER_SC(q + 2, scn); PEER_ROUTE(sc1, eidx, gs); } continue; }
#endif
        const float su_l = lane < 16 ? SU[eidx] : 0.f, sv_l = lane < 16 ? SV[eidx] : 0.f;
        u32x4 ur[16], vr[16];
#pragma unroll
        for (int e = 0; e < 16; ++e) { const int eid = __builtin_amdgcn_readlane(eidx, e);
            const GAS unsigned char* rp_ = UV + (size_t)eid * 2048 + lane * 16; ur[e] = *(const GAS u32x4*)rp_; vr[e] = *(const GAS u32x4*)(rp_ + 1024); }
        const float gs_c = gs;
        if (h == 0) { const u32x4 a = __builtin_nontemporal_load((const GAS u32x4*)(H + (size_t)t * 1024 + lane * 16)), b = __builtin_nontemporal_load((const GAS u32x4*)(H + (size_t)t * 1024 + lane * 16 + 8));
#pragma unroll
            for (int j = 0; j < 4; ++j) { xf[2 * j] = lo_bf(a[j]); xf[2 * j + 1] = hi_bf(a[j]); xf[8 + 2 * j] = lo_bf(b[j]); xf[8 + 2 * j + 1] = hi_bf(b[j]); }
#pragma unroll
            for (int j = 0; j < 8; ++j) acc2[j] = (f32x2_t){0.f, 0.f}; }
        if (q + 1 < nitems) { float sc1[4] = {scn[0], scn[1], scn[2], scn[3]}; if (q + 2 < nitems) PEER_SC(q + 2, scn); PEER_ROUTE(sc1, eidx, gs); }
        float d[16];
        f32x2_t xp2[8];
#pragma unroll
        for (int j = 0; j < 8; ++j) xp2[j] = (f32x2_t){xf[2 * j], xf[2 * j + 1]};
#pragma unroll
        for (int e = 0; e < 16; ++e) { f32x2_t dp = (f32x2_t){0.f, 0.f};
#pragma unroll
            for (int j = 0; j < 4; ++j) { const f32x2_t lo = __builtin_amdgcn_cvt_pk_f32_fp8((int)ur[e][j], false), hi = __builtin_amdgcn_cvt_pk_f32_fp8((int)ur[e][j], true);
                dp = __builtin_elementwise_fma(xp2[2 * j], lo, dp); dp = __builtin_elementwise_fma(xp2[2 * j + 1], hi, dp); }
            d[e] = dp.x + dp.y; }
        float r8[8], r4[4], r2[2], r1;
#pragma unroll
        for (int k = 0; k < 8; ++k) { const float snd = b5 ? d[k] : d[k + 8]; r8[k] = (b5 ? d[k + 8] : d[k]) + __shfl_xor(snd, 32); }
#pragma unroll
        for (int k = 0; k < 4; ++k) { const float snd = b4 ? r8[k] : r8[k + 4]; r4[k] = (b4 ? r8[k + 4] : r8[k]) + __shfl_xor(snd, 16); }
#pragma unroll
        for (int k = 0; k < 2; ++k) { const float snd = b3 ? r4[k] : r4[k + 2]; r2[k] = (b3 ? r4[k + 2] : r4[k]) + __shfl_xor(snd, 8); }
        { const float snd = b2 ? r2[0] : r2[1]; r1 = (b2 ? r2[1] : r2[0]) + __shfl_xor(snd, 4); }
        r1 += __shfl_xor(r1, 1); r1 += __shfl_xor(r1, 2);
        const int eq = lane >> 2;
        const float act = r1 * __shfl(su_l, eq);
        const float wv = __shfl(gs_c, eq) * 0.5f * act * (1.f + erff(act * 0.7071067811865476f)) * __shfl(sv_l, eq);
#pragma unroll
        for (int e = 0; e < 16; ++e) { const float w = __int_as_float(__builtin_amdgcn_readlane(__float_as_int(wv), 4 * e));
#pragma unroll
            for (int j = 0; j < 4; ++j) { const f32x2_t lo = __builtin_amdgcn_cvt_pk_f32_fp8((int)vr[e][j], false), hi = __builtin_amdgcn_cvt_pk_f32_fp8((int)vr[e][j], true); const f32x2_t w2 = (f32x2_t){w, w};
                acc2[2 * j] = __builtin_elementwise_fma(w2, lo, acc2[2 * j]); acc2[2 * j + 1] = __builtin_elementwise_fma(w2, hi, acc2[2 * j + 1]); } }
        if (h == 7) {
            const GAS float* gp = mod + (size_t)cb_of_row(t) * 12288 + l * 6144 + 5 * 1024 + lane * 16; GAS float* xp = X + (size_t)t * 1024 + lane * 16;
            f32x4 xn[4]; float ss = 0.f;
#pragma unroll
            for (int j = 0; j < 4; ++j) { const f32x4 g = *(const GAS f32x4*)(gp + 4 * j); xn[j] = __builtin_nontemporal_load((const GAS f32x4*)(xp + 4 * j));
#pragma unroll
                for (int k = 0; k < 4; ++k) { xn[j][k] += g[k] * acc2[2 * j + (k >> 1)][k & 1]; ss += xn[j][k] * xn[j][k]; } }
            const float rstd = rsqrtf(wave_sum_u(ss) * (1.f / 1024.f) + EPSN);
            if (l == 1) { const GAS float* fw = (const GAS float*)p.in[29] + lane * 16;
#pragma unroll
                for (int j = 0; j < 4; ++j) { const f32x4 w = *(const GAS f32x4*)(fw + 4 * j); xn[j] = xn[j] * rstd * w; } }
            else if (!DRY) {
                const GAS float* nw = (const GAS float*)p.in[9] + 1024 + lane * 16; const GAS float* mp = mod + (size_t)cb_of_row(t) * 12288 + 6144 + lane * 16; u32x4 ho[2];
#pragma unroll
                for (int j = 0; j < 4; ++j) { const f32x4 w = *(const GAS f32x4*)(nw + 4 * j), sh = *(const GAS f32x4*)(mp + 4 * j), sc = *(const GAS f32x4*)(mp + 1024 + 4 * j); const f32x4 o = xn[j] * rstd * w * (sc + 1.f) + sh;
                    ho[j >> 1][(j & 1) * 2] = cvt_pk_bf16(o[0], o[1]); ho[j >> 1][(j & 1) * 2 + 1] = cvt_pk_bf16(o[2], o[3]); }
                *(GAS u32x4*)((GAS bf16_t*)(p.ws + WS_H) + (size_t)t * 1024 + lane * 16) = ho[0]; *(GAS u32x4*)((GAS bf16_t*)(p.ws + WS_H) + (size_t)t * 1024 + lane * 16 + 8) = ho[1]; }
#pragma unroll
            for (int j = 0; j < 4; ++j) { if (!DRY) __builtin_nontemporal_store(xn[j], (GAS f32x4*)(xp + 4 * j)); else asm volatile("" :: "v"(xn[j][0]), "v"(xn[j][1]), "v"(xn[j][2]), "v"(xn[j][3])); }
        }
    }
#undef PEER_SC
#undef PEER_ROUTE
}

__device__ __forceinline__ void load_params(Params& q, const LAS unsigned* tab) {
#pragma unroll
    for (int k = 0; k < 32; ++k) {
        const unsigned lo = __builtin_amdgcn_readfirstlane(tab[2 * k]), hi = __builtin_amdgcn_readfirstlane(tab[2 * k + 1]);
        const unsigned long long a = ((unsigned long long)hi << 32) | lo;
        if (k < 30) q.in[k] = (const float*)a; else if (k == 30) q.out = (float*)a; else q.ws = (unsigned char*)a;
    }
}
#define PHASE_PARAMS Params p; load_params(p, tab)

#ifdef DBG
__device__ __forceinline__ void dbg_flag(const Params& p, int code) { atomicMax((unsigned*)(p.ws + WS_BAR) + 4000, (unsigned)(1000 - code)); }
__device__ __forceinline__ void dbg_bf16(const Params& p, const bf16_t* base, int rows, int ld, int ncols, int code) {
    const int tid = otid(); bool bad = false;
    for (size_t i = (size_t)blockIdx.x * 512 + tid; i < (size_t)rows * ncols; i += (size_t)gridDim.x * 512) { const size_t r = i / ncols, c = i % ncols; const unsigned v = base[r * ld + c]; if ((v & 0x7F80u) == 0x7F80u) bad = true; }
    if (bad) dbg_flag(p, code);
}
__device__ __forceinline__ void dbg_f32(const Params& p, const float* base, int rows, int ld, int ncols, int code) {
    const int tid = otid(); bool bad = false;
    for (size_t i = (size_t)blockIdx.x * 512 + tid; i < (size_t)rows * ncols; i += (size_t)gridDim.x * 512) { const size_t r = i / ncols, c = i % ncols; const unsigned v = __float_as_uint(base[r * ld + c]); if ((v & 0x7F800000u) == 0x7F800000u) bad = true; }
    if (bad) dbg_flag(p, code);
}
#define DBG_DO(x) { { PHASE_PARAMS; x; } xcd_barrier(xb); }
#else
#define DBG_DO(x)
#endif
__global__ void __launch_bounds__(512, 2) mega_fwd(Params p0) {
    __shared__ __attribute__((aligned(16))) unsigned char smem[LDS_BYTES];
    LAS unsigned char* lds = (LAS unsigned char*)smem;
    LAS unsigned* tab = (LAS unsigned*)(lds + LDS_TAB);
    if (threadIdx.x == 0) {
        volatile LAS unsigned* st0 = (volatile LAS unsigned*)(lds + LDS_ST); st0[0] = 0u; st0[1] = 0u;
#pragma unroll
        for (int k = 0; k < 32; ++k) { const unsigned long long a = k < 30 ? (unsigned long long)p0.in[k] : (k == 30 ? (unsigned long long)p0.out : (unsigned long long)p0.ws); tab[2 * k] = (unsigned)a; tab[2 * k + 1] = (unsigned)(a >> 32); }
    }
    __syncthreads();
    const XcdBarrier xb = xcd_barrier_post((unsigned*)(p0.ws + WS_BAR), (volatile LAS unsigned*)(lds + LDS_ST));
#pragma unroll 1
    for (int l = 0; l < 2; ++l) {
        if (l == 0) {
            { PHASE_PARAMS; phase_convert(p, 0, smem, (int)blockIdx.x, (int)gridDim.x, 1); mod_gemv(p, smem, (int)blockIdx.x, (int)gridDim.x); }
            xcd_barrier(xb);
        }
        if (l == 0) {
            { PHASE_PARAMS; phase_norm(p, p.in[0], p.in[1], p.in[9], 0, 1024); }
            xcd_barrier(xb);
        }
        DBG_DO(dbg_bf16(p, (const bf16_t*)(p.ws + WS_H), T_TOK, 1024, 1024, l * 10 + 2))
        { PHASE_PARAMS; EpiInProj e; e.P = (bf16_t*)(p.ws + WS_PROJ); e.aux = (float*)(p.ws + WS_AUX);
          run_gemm<1>(lds, (const bf16_t*)(p.ws + WS_H), 1024, (const bf16_t*)(p.ws + ws_win(l)), T_TOK, NP, 1024, e);
#ifdef DUP_INPROJ
          run_gemm<1>(lds, (const bf16_t*)(p.ws + WS_H), 1024, (const bf16_t*)(p.ws + ws_win(l)), T_TOK, NP, 1024, e);
#endif
        }
        xcd_barrier(xb);
        DBG_DO(dbg_bf16(p, (const bf16_t*)(p.ws + WS_PROJ), T_TOK, NP, 10240, l * 10 + 3); dbg_f32(p, (const float*)(p.ws + WS_AUX), T_TOK, 64, 48, l * 10 + 3))
#ifndef NO_MIXER
        { PHASE_PARAMS; phase_gla_pre(p, l, lds); }
        { PHASE_PARAMS; phase_ssd_pre(p, l, lds); }
        xcd_barrier(xb);
#ifdef DUP_MIXER
        { PHASE_PARAMS; phase_mixer<true>(p, l, lds); }
#endif
        { PHASE_PARAMS; phase_mixer<false>(p, l, lds); }
#endif
        xcd_barrier(xb);
        DBG_DO(dbg_bf16(p, (const bf16_t*)(p.ws + WS_PROJ) + PC_V, T_TOK, NP, 1024, l * 10 + 4); dbg_bf16(p, (const bf16_t*)(p.ws + WS_PROJ) + PC_Z, T_TOK, NP, 2048, l * 10 + 5))
#ifndef NO_NG
        { PHASE_PARAMS; phase_normgate(p, l); }
#endif
        xcd_barrier(xb);
        DBG_DO(dbg_bf16(p, (const bf16_t*)(p.ws + WS_PROJ) + PC_V, T_TOK, NP, 1024, l * 10 + 6); dbg_bf16(p, (const bf16_t*)(p.ws + WS_PROJ) + PC_Z, T_TOK, NP, 2048, l * 10 + 6))
#ifdef STOP1
        continue;
#endif
        { PHASE_PARAMS; bf16_t* proj = (bf16_t*)(p.ws + WS_PROJ); EpiGlaProj e; e.P = proj; run_gemm<2>(lds, proj + PC_V, NP, (const bf16_t*)(p.ws + ws_wgla(l)), T_TOK, 1024, 1024, e); }
        { PHASE_PARAMS; bf16_t* proj = (bf16_t*)(p.ws + WS_PROJ); EpiSsdProj e; e.P = proj; e.H = (bf16_t*)(p.ws + WS_H); run_gemm<3>(lds, proj + PC_Z, NP, (const bf16_t*)(p.ws + ws_wssd(l)), T_TOK, 1024, 2048, e); }
        {
            const int skip = gridDim.x > 64 ? 32 : 0;
            if ((int)blockIdx.x >= skip) { PHASE_PARAMS; phase_convert(p, 1, smem, (int)blockIdx.x - skip, (int)gridDim.x - skip, l == 0 ? 1 : 12); }
        }
#ifdef DUP_GS
        { PHASE_PARAMS; bf16_t* proj = (bf16_t*)(p.ws + WS_PROJ); EpiGlaProj e; e.P = proj; run_gemm<2>(lds, proj + PC_V, NP, (const bf16_t*)(p.ws + ws_wgla(l)), T_TOK, 1024, 1024, e); }
        { PHASE_PARAMS; bf16_t* proj = (bf16_t*)(p.ws + WS_PROJ); EpiSsdProj e; e.P = proj; e.H = (bf16_t*)(p.ws + WS_H); run_gemm<3>(lds, proj + PC_Z, NP, (const bf16_t*)(p.ws + ws_wssd(l)), T_TOK, 1024, 2048, e); }
#endif
        xcd_barrier(xb);
        DBG_DO(dbg_bf16(p, (const bf16_t*)(p.ws + WS_H), T_TOK, 1024, 1024, l * 10 + 7))
        { PHASE_PARAMS; EpiWout e; e.X = p.out; e.Xa = l == 0 ? p.in[0] : p.out; e.Xb = l == 0 ? p.in[1] : p.out + (size_t)T_PROMPT * 1024; e.modg = (const float*)(p.ws + WS_MOD) + l * 6144 + 2 * 1024; run_gemm<4>(lds, (const bf16_t*)(p.ws + WS_H), 1024, (const bf16_t*)(p.ws + ws_wout(l)), T_TOK, 1024, 1024, e); }
        if (l == 0) { const int skip = gridDim.x > 64 ? 32 : 0;
            if ((int)blockIdx.x >= skip) { PHASE_PARAMS; phase_convert(p, 0, smem, (int)blockIdx.x - skip, (int)gridDim.x - skip, 4); } }
        xcd_barrier(xb);
        DBG_DO(dbg_f32(p, p.out, T_TOK, 1024, 1024, l * 10 + 8))
        { PHASE_PARAMS; phase_norm(p, p.out, p.out + (size_t)T_PROMPT * 1024, p.in[23] + l * 1024, l * 6144 + 3 * 1024, l * 6144 + 4 * 1024); }
        xcd_barrier(xb);
        DBG_DO(dbg_bf16(p, (const bf16_t*)(p.ws + WS_H), T_TOK, 1024, 1024, l * 10 + 9))
        { PHASE_PARAMS; EpiF32NT e; e.C = (float*)(p.ws + WS_PROJ); e.ldc = 2048; e.bias = nullptr; run_gemm<5>(lds, (const bf16_t*)(p.ws + WS_H), 1024, (const bf16_t*)(p.ws + ws_wpeer(l)), T_TOK, 2048, 1024, e); }
        if (l == 0) { const int skip = gridDim.x > 128 ? 64 : 0;
            if ((int)blockIdx.x >= skip) { PHASE_PARAMS; phase_convert(p, 0, smem, (int)blockIdx.x - skip, (int)gridDim.x - skip, 8); } }
#ifdef DUP_SCORES
        { PHASE_PARAMS; EpiF32NT e; e.C = (float*)(p.ws + WS_PROJ); e.ldc = 2048; e.bias = nullptr; run_gemm<5>(lds, (const bf16_t*)(p.ws + WS_H), 1024, (const bf16_t*)(p.ws + ws_wpeer(l)), T_TOK, 2048, 1024, e); }
#endif
        xcd_barrier(xb);
        DBG_DO(dbg_f32(p, (const float*)(p.ws + WS_PROJ), T_TOK, 2048, 2048, l * 10 + 10))
#ifndef NO_PEER
#ifdef DUP_PEER
        { PHASE_PARAMS; phase_peer<true>(p, l); }
#endif
        { PHASE_PARAMS; phase_peer<false>(p, l); }
#endif
        if (l == 0) xcd_barrier(xb);
    }
#ifdef DBG
    xcd_barrier(xb);
    { PHASE_PARAMS; const unsigned f = __hip_atomic_load((unsigned*)(p.ws + WS_BAR) + 4000, __ATOMIC_RELAXED, __HIP_MEMORY_SCOPE_AGENT); if (f) { const float K = 10.f * (float)(1000 - (int)f); const int tid = otid(); for (size_t i = (size_t)blockIdx.x * 512 + tid; i < (size_t)T_TOK * 1024; i += (size_t)gridDim.x * 512) p.out[i] = K; } }
#endif
#ifdef DBG2
    xcd_barrier(xb);
    { PHASE_PARAMS; const unsigned f = __hip_atomic_load((unsigned*)(p.ws + WS_BAR) + 4000, __ATOMIC_RELAXED, __HIP_MEMORY_SCOPE_AGENT); if (f) { const float K = 10.f * (float)(1 << (100 - (int)f)); const int tid = otid(); for (size_t i = (size_t)blockIdx.x * 512 + tid; i < (size_t)T_TOK * 1024; i += (size_t)gridDim.x * 512) p.out[i] = K; } }
#endif
#ifdef SANITIZE
    xcd_barrier(xb);
    { PHASE_PARAMS; const int tid = otid(); for (size_t i = (size_t)blockIdx.x * 512 + tid; i < (size_t)51068928; i += (size_t)gridDim.x * 512) { const float v = p.out[i]; if (!(fabsf(v) < 3.0e38f)) p.out[i] = 0.f; } }
#endif
}

extern "C" void kernel_launch(void* const* d_in, const int* in_sizes, int n_in, void* d_out, int out_size, void* d_ws, size_t ws_size, hipStream_t stream) {
    static int grid = 0;
    if (grid == 0) {
        if (n_in != 30 || ws_size < WS_END) { fprintf(stderr, "kernel_launch: need 30 inputs and >= %zu bytes of workspace; got %d, %zu\n", (size_t)WS_END, n_in, ws_size); grid = -1; return; }
        int dev = 0, cus = 0, per_cu = 0;
        (void)hipGetDevice(&dev); (void)hipDeviceGetAttribute(&cus, hipDeviceAttributeMultiprocessorCount, dev);
        if (hipOccupancyMaxActiveBlocksPerMultiprocessor(&per_cu, (const void*)mega_fwd, 512, 0) != hipSuccess || per_cu < 1) { fprintf(stderr, "kernel_launch: occupancy query failed (%d)\n", per_cu); (void)hipGetLastError(); per_cu = 1; }
        grid = cus * (per_cu > 1 ? 1 : per_cu);
        if (grid > 256) grid = 256;
    }
    if (grid < 0) return;
    if (hipMemsetAsync((char*)d_ws + WS_BAR, 0, 16384, stream) != hipSuccess) { fprintf(stderr, "kernel_launch: memset of the barrier words failed\n"); return; }
    Params p{};
    for (int i = 0; i < 30; ++i) p.in[i] = (const float*)d_in[i];
    p.out = (float*)d_out; p.ws = (unsigned char*)d_ws;
    void* args[] = {&p};
    hipError_t e = hipLaunchCooperativeKernel((const void*)mega_fwd, dim3(grid), dim3(512), args, 0, stream);
    if (e != hipSuccess) fprintf(stderr, "kernel_launch: cooperative launch failed: %s (grid %d)\n", hipGetErrorString(e), grid);
}
```

```cpp
#include <hip/hip_runtime.h>
#include <cstdio>
#define LAS __attribute__((address_space(3)))
namespace pg8 {
#define PG8_LAS __attribute__((address_space(3)))
typedef unsigned short bf16_t;
typedef short bf16x8 __attribute__((ext_vector_type(8)));
typedef float f32x4 __attribute__((ext_vector_type(4)));
typedef unsigned u32x4 __attribute__((ext_vector_type(4)));
constexpr int BM = 256, BK = 64, HALF = 128, HTB = HALF * BK * 2  , STAGE_BYTES = 8 * HTB, NXCD = 8, WGM = 4;

__host__ __device__ __forceinline__ int lds_byte(int r, int c) { const int st = (r >> 4) * 2 + (c >> 5), rr = r & 15, cc = c & 31, ob = rr * 64 + cc * 2; return st * 1024 + (ob ^ (((ob >> 9) & 1) << 5)); }
__host__ __device__ __forceinline__ void stage_rc(int b, int& R, int& C) { const int st = b / 1024, sb = b % 1024, swz = sb ^ (((sb >> 9) & 1) << 5); R = (st >> 1) * 16 + swz / 64; C = (st & 1) * 32 + (swz % 64) / 2; }
__host__ __device__ __forceinline__ int perm32(int rho) { const int n = rho >> 4, i = rho & 15; return 8 * (i >> 2) + 4 * n + (i & 3); }

struct Unit { int pm, pn; };
struct Gemm { const bf16_t* A; const bf16_t* Bt; int M, N, K, lda; };

struct StaticOrder {
    int nM, nN, nwg, G, c;
    __host__ __device__ void init(int M, int N, int G_, int c_) { nM = M / BM; nN = N / BM; nwg = nM * nN; G = G_; c = c_; }
    __host__ __device__ bool next(int i, Unit& u) const {
        const long L = (long)i * G + c; if (L >= nwg) return false;
        int wgid = (int)L; { const int q = nwg / NXCD, r = nwg % NXCD, xcd = wgid % NXCD, off = wgid / NXCD; wgid = (xcd < r ? xcd * (q + 1) : r * (q + 1) + (xcd - r) * q) + off; }
        const int nig = WGM * nN, gid = wgid / nig, fm = gid * WGM, gsz = (nM - fm) < WGM ? (nM - fm) : WGM;
        u.pm = fm + ((wgid % nig) % gsz); u.pn = (wgid % nig) / gsz; return true;
    }
    __device__ __forceinline__ void a_ready(const Unit&) const {}
    __device__ __forceinline__ void done(const Unit&) const {}
};
typedef float f32x2 __attribute__((ext_vector_type(2)));
typedef __bf16 bf16v2_t __attribute__((ext_vector_type(2)));
__device__ __forceinline__ unsigned cvt_pk_bf16(float lo, float hi) { const f32x2 v = {lo, hi}; return __builtin_bit_cast(unsigned, __builtin_convertvector(v, bf16v2_t)); }
template <class Epi, class Sched, bool STAMP = false>
__device__ __forceinline__ void gemm_phase(PG8_LAS unsigned char* lds, const Gemm g, const Sched& S, const Epi& E, unsigned long long* stamps) {
    int tid_ = threadIdx.x; asm volatile("" : "+v"(tid_)); const int tid = tid_, wid = __builtin_amdgcn_readfirstlane(tid >> 6), lane = tid & 63, wr = wid >> 2, wc = wid & 3, fr = lane & 15, fq = lane >> 4;
    const int K = g.K, nt = K / BK;
    int ts_lo = 0, ts_hi = 0, nts = 0; const unsigned long long rt_entry = STAMP ? (unsigned long long)wall_clock64() : 0ull;
#define PG8_STAMP() do { if (STAMP && wid == 0 && nts < 64) { const unsigned long long _c = (unsigned long long)clock64(); \
        ts_lo = (lane == nts) ? (int)(unsigned)_c : ts_lo; ts_hi = (lane == nts) ? (int)(unsigned)(_c >> 32) : ts_hi; ++nts; } } while (0)
    PG8_STAMP();
    unsigned voffA[2], voffB[2];
#pragma unroll
    for (int i = 0; i < 2; ++i) { int R, C; stage_rc(tid * 16 + i * 8192, R, C); const int Rb = Epi::PERM ? ((R & ~31) + perm32(R & 31)) : R;
        voffA[i] = (unsigned)(R * g.lda + C) * 2u; voffB[i] = (unsigned)(Rb * K + C) * 2u; }
    const size_t kstep = (size_t)(BK * 2);
    const size_t hstepB = (size_t)HALF * K * 2, hstepA = (size_t)HALF * g.lda * 2;
    const size_t tstepA = 2 * hstepA, tstepB = 2 * hstepB;
    const unsigned ldsw = (unsigned)wid * 1024u;
    const int aoff = lds_byte(wr * 64 + fr, fq * 8), boff = lds_byte(wc * 32 + fr, fq * 8);
#define PG8_SA(b, h) (((b) * 2 + (h)) * HTB)
#define PG8_SB(b, h) ((4 + (b) * 2 + (h)) * HTB)
#define PG8_STAGE(bufoff, gbase, voff) do { _Pragma("unroll") for (int _i = 0; _i < 2; ++_i) \
        __builtin_amdgcn_global_load_lds((const unsigned*)((const char*)(gbase) + (voff)[_i]), (PG8_LAS unsigned*)(lds + (bufoff) + ldsw + _i * 8192), 16, 0, 0); } while (0)
#define PG8_LDA(dst, b, h) do { _Pragma("unroll") for (int m = 0; m < 4; ++m) _Pragma("unroll") for (int k = 0; k < 2; ++k) dst[m][k] = *(const PG8_LAS bf16x8*)(lds + PG8_SA(b, h) + aoff + m * 2048 + k * 1024); } while (0)
#define PG8_LDB(dst, b, h) do { _Pragma("unroll") for (int n = 0; n < 2; ++n) _Pragma("unroll") for (int k = 0; k < 2; ++k) dst[n][k] = *(const PG8_LAS bf16x8*)(lds + PG8_SB(b, h) + boff + n * 2048 + k * 1024); } while (0)
#define PG8_MMA(ai, bj, At, Bt) do { __builtin_amdgcn_s_setprio(1); _Pragma("unroll") for (int m = 0; m < 4; ++m) _Pragma("unroll") for (int n = 0; n < 2; ++n) _Pragma("unroll") for (int k = 0; k < 2; ++k) \
        acc[ai][bj][m][n] = __builtin_amdgcn_mfma_f32_16x16x32_bf16(Bt[n][k], At[m][k], acc[ai][bj][m][n], 0, 0, 0); __builtin_amdgcn_s_setprio(0); } while (0)
#define PG8_WAIT_V(n) asm volatile("s_waitcnt vmcnt(" #n ")" ::: "memory")
#define PG8_WAIT_L(n) asm volatile("s_waitcnt lgkmcnt(" #n ")" ::: "memory")
#define PG8_BAR __builtin_amdgcn_s_barrier()
#define PG8_SCHED __builtin_amdgcn_sched_barrier(0)
    Unit cur, nxt; int ui = 0;
    if (!S.next(0, cur)) return;
    f32x4 acc[2][2][4][2];
#pragma unroll
    for (int a = 0; a < 2; ++a)
#pragma unroll
        for (int b = 0; b < 2; ++b)
#pragma unroll
            for (int m = 0; m < 4; ++m)
#pragma unroll
                for (int n = 0; n < 2; ++n) acc[a][b][m][n] = (f32x4){0.f, 0.f, 0.f, 0.f};
    bf16x8 At[4][2], B0[2][2], B1[2][2];
    const char* cA = (const char*)g.A + (size_t)cur.pm * tstepA; const char* cB = (const char*)g.Bt + (size_t)cur.pn * tstepB;
    S.a_ready(cur);
    PG8_STAGE(PG8_SB(0, 0), cB, voffB); PG8_STAGE(PG8_SA(0, 0), cA, voffA); PG8_STAGE(PG8_SB(0, 1), cB + hstepB, voffB); PG8_STAGE(PG8_SA(0, 1), cA + hstepA, voffA);
    if (wr == 1) PG8_BAR;
    PG8_WAIT_V(4); PG8_BAR;
    PG8_STAGE(PG8_SB(1, 0), cB + kstep, voffB); PG8_STAGE(PG8_SA(1, 0), cA + kstep, voffA); PG8_STAGE(PG8_SB(1, 1), cB + hstepB + kstep, voffB);
    PG8_WAIT_V(6); PG8_BAR;
    PG8_STAMP();
    for (;;) {
        const bool has_next = S.next(ui + 1, nxt);
        const char* nA = has_next ? (const char*)g.A + (size_t)nxt.pm * tstepA : cA; const char* nB = has_next ? (const char*)g.Bt + (size_t)nxt.pn * tstepB : cB;
        for (int t = 0; t < nt; t += 2) {
            const bool last = (t == nt - 2);
            const char* a1 = cA + (size_t)(t + 1) * kstep;
            const char* a2 = last ? nA : cA + (size_t)(t + 2) * kstep; const char* b2 = last ? nB : cB + (size_t)(t + 2) * kstep;
            const char* a3 = a2 + kstep; const char* b3 = b2 + kstep;
            if (last && has_next) S.a_ready(nxt);
            PG8_LDB(B0, 0, 0); PG8_SCHED; PG8_LDA(At, 0, 0); PG8_STAGE(PG8_SA(1, 1), a1 + hstepA, voffA);
            PG8_WAIT_L(8); PG8_BAR; PG8_WAIT_L(0); PG8_MMA(0, 0, At, B0); PG8_BAR; PG8_SCHED;
            PG8_LDB(B1, 0, 1); PG8_STAGE(PG8_SB(0, 0), b2, voffB);
            PG8_BAR; PG8_WAIT_L(0); PG8_MMA(0, 1, At, B1); PG8_BAR;
            PG8_LDA(At, 0, 1); PG8_STAGE(PG8_SA(0, 0), a2, voffA);
            PG8_BAR; PG8_WAIT_L(0); PG8_MMA(1, 0, At, B0); PG8_BAR; PG8_SCHED;
            PG8_STAGE(PG8_SB(0, 1), b2 + hstepB, voffB);
            PG8_WAIT_V(6); PG8_BAR; PG8_MMA(1, 1, At, B1); PG8_BAR;
            PG8_LDB(B0, 1, 0); PG8_SCHED; PG8_LDA(At, 1, 0); PG8_STAGE(PG8_SA(0, 1), a2 + hstepA, voffA);
            PG8_WAIT_L(8); PG8_BAR; PG8_WAIT_L(0); PG8_MMA(0, 0, At, B0); PG8_BAR; PG8_SCHED;
            PG8_LDB(B1, 1, 1); PG8_STAGE(PG8_SB(1, 0), b3, voffB);
            PG8_BAR; PG8_WAIT_L(0); PG8_MMA(0, 1, At, B1); PG8_BAR;
            PG8_LDA(At, 1, 1); PG8_STAGE(PG8_SA(1, 0), a3, voffA);
            PG8_BAR; PG8_WAIT_L(0); PG8_MMA(1, 0, At, B0); PG8_BAR; PG8_SCHED;
            PG8_STAGE(PG8_SB(1, 1), b3 + hstepB, voffB);
            PG8_WAIT_V(6); PG8_BAR; PG8_MMA(1, 1, At, B1); PG8_BAR;
        }
        PG8_STAMP();
        if constexpr (!Epi::AFTER_DRAIN) { E(acc, cur, wr, wc, fr, fq); S.done(cur); }
        PG8_STAMP();
        if (!has_next) break;
#pragma unroll
        for (int a = 0; a < 2; ++a)
#pragma unroll
            for (int b = 0; b < 2; ++b)
#pragma unroll
                for (int m = 0; m < 4; ++m)
#pragma unroll
                    for (int n = 0; n < 2; ++n) acc[a][b][m][n] = (f32x4){0.f, 0.f, 0.f, 0.f};
        cur = nxt; cA = nA; cB = nB; ++ui;
    }
    PG8_WAIT_V(0);
    if (wr == 0) PG8_BAR;
    PG8_BAR;
    if constexpr (Epi::AFTER_DRAIN) { E.fused(acc, cur, wr, wc, fr, fq, lds, wid, lane); S.done(cur); }
    PG8_STAMP();
    if (STAMP && wid == 0) { stamps[lane] = lane < nts ? (((unsigned long long)(unsigned)ts_hi << 32) | (unsigned)ts_lo) : 0ull;
        if (lane == 62) stamps[62] = rt_entry; if (lane == 63) stamps[63] = (unsigned long long)wall_clock64(); }
#undef PG8_STAMP
#undef PG8_SA
#undef PG8_SB
#undef PG8_STAGE
#undef PG8_LDA
#undef PG8_LDB
#undef PG8_MMA
#undef PG8_WAIT_V
#undef PG8_WAIT_L
#undef PG8_BAR
#undef PG8_SCHED
}
}
#define XB_TMO      128
#define XB_XCNT(j)  (256  + 64 * (j))
#define XB_XSUB(j)  (1280 + 64 * (j))
#define XB_XGEN(j)  (2304 + 64 * (j))
#define XB_TOP      3328
#define XB_TOPGEN   3392
#define XCD_BAR_WORDS 3456
#define XB_SPIN_CAP (1u << 18)

__device__ __forceinline__ unsigned xb_ld(unsigned* p)              { return __hip_atomic_load(p, __ATOMIC_RELAXED, __HIP_MEMORY_SCOPE_AGENT); }
__device__ __forceinline__ unsigned xb_add(unsigned* p, unsigned v) { return __hip_atomic_fetch_add(p, v, __ATOMIC_RELAXED, __HIP_MEMORY_SCOPE_AGENT); }
__device__ __forceinline__ unsigned xb_xcc_id() { return (unsigned)__builtin_amdgcn_s_getreg((3 << 11) | 20) & 0xFu; }
#define XB_SPIN(cond, bar) do { unsigned _sp = 0; while (cond) { __builtin_amdgcn_s_sleep(1); \
    if ((++_sp & 255u) == 0u) { if (xb_ld(&(bar)[XB_TMO])) break; if (_sp > XB_SPIN_CAP) { atomicAdd(&(bar)[XB_TMO], 1u); break; } } } } while (0)

struct XcdBarrier {
    unsigned* bar; unsigned x;
    volatile LAS unsigned* st;
};

__device__ __forceinline__ XcdBarrier xcd_barrier_post(unsigned* bar, volatile LAS unsigned* st) {
    XcdBarrier b; b.bar = bar; b.x = xb_xcc_id(); b.st = st;
    if (threadIdx.x == 0) (void)xb_add(&bar[XB_XCNT(b.x)], 1u);
    return b;
}
__device__ __forceinline__ void xcd_barrier_complete(unsigned* bar, unsigned x, unsigned& nloc, unsigned& nx) {
    const unsigned G = gridDim.x * gridDim.y * gridDim.z;
    unsigned sum, cnt, mine, sp = 0u;
    for (;;) {
        sum = 0u; cnt = 0u; mine = 0u;
#pragma unroll
        for (unsigned j = 0; j < 16; ++j) { const unsigned c = xb_ld(&bar[XB_XCNT(j)]); sum += c; cnt += (c > 0u) ? 1u : 0u; mine = (j == x) ? c : mine; }
        if (sum == G) break;
        __builtin_amdgcn_s_sleep(1);
        if ((++sp & 255u) == 0u) { if (xb_ld(&bar[XB_TMO])) break; if (sp > XB_SPIN_CAP) { atomicAdd(&bar[XB_TMO], 1u); break; } }
    }
    nloc = mine > 0u ? mine : 1u; nx = cnt > 0u ? cnt : 1u;
}

__device__ __forceinline__ void xcd_barrier(const XcdBarrier& b) {
    asm volatile("s_waitcnt vmcnt(0)" ::: "memory");
    __syncthreads();
    int xb_tid = threadIdx.x; asm volatile("" : "+v"(xb_tid));
    if (xb_tid == 0) {
        unsigned* bar = b.bar; asm volatile("" : "+v"(bar));
        unsigned bx = b.x; asm volatile("" : "+v"(bx));
        __builtin_amdgcn_s_waitcnt(0);
        unsigned nloc = b.st[0], nx = b.st[1];
        if (nloc == 0u) { xcd_barrier_complete(bar, bx, nloc, nx); b.st[0] = nloc; b.st[1] = nx; }
        const unsigned old = xb_add(&bar[XB_XSUB(bx)], 1u);
        const unsigned gen = old / nloc;
        if (old + 1u == (gen + 1u) * nloc) {
            __builtin_amdgcn_fence(__ATOMIC_RELEASE, "agent");
            asm volatile("s_waitcnt vmcnt(0)" ::: "memory");
            const unsigned og = xb_add(&bar[XB_TOP], 1u);
            const unsigned tg = og / nx;
            if (og + 1u == (tg + 1u) * nx) xb_add(&bar[XB_TOPGEN], 1u);
            else XB_SPIN(xb_ld(&bar[XB_TOPGEN]) == tg, bar);
            __builtin_amdgcn_fence(__ATOMIC_ACQUIRE, "agent");
            xb_add(&bar[XB_XGEN(bx)], 1u);
            asm volatile("s_waitcnt vmcnt(0)" ::: "memory");
        } else {
            XB_SPIN(xb_ld(&bar[XB_XGEN(bx)]) == gen, bar);
            __builtin_amdgcn_fence(__ATOMIC_ACQUIRE, "agent");
            asm volatile("s_waitcnt vmcnt(0)" ::: "memory");
        }
    }
    __syncthreads();
}


using pg8::bf16_t; using pg8::bf16x8; using pg8::f32x4; using pg8::u32x4; using pg8::Unit; using pg8::cvt_pk_bf16;
typedef unsigned u32x2 __attribute__((ext_vector_type(2)));
constexpr int T_TOK = 18432, T_PROMPT = 16384, DM = 1024, NP = 10496, NIN = 10288;
constexpr float EPSN = 1e-6f;
constexpr int LDS_BYTES = 163840, LDS_ST = 163328, LDS_TAB = 163344;
constexpr size_t WS_BAR = 0;
constexpr size_t WS_WADA = 16384;
constexpr size_t WS_WIN = WS_WADA + (size_t)12288 * 1024 * 2;
constexpr size_t WS_WGLA = WS_WIN + (size_t)NP * 1024 * 2;
constexpr size_t WS_WSSD = WS_WGLA + (size_t)1024 * 1024 * 2;
constexpr size_t WS_WOUT = WS_WSSD + (size_t)1024 * 2048 * 2;
constexpr size_t WS_WPEER = WS_WOUT + (size_t)1024 * 1024 * 2;
constexpr size_t WS_U = WS_WPEER + (size_t)2048 * 1024 * 2;
constexpr size_t WS_V = WS_U + (size_t)16384 * 1024 * 2;
constexpr size_t WS_SILUC = WS_V + (size_t)16384 * 1024 * 2;
constexpr size_t WS_MOD = WS_SILUC + (size_t)256 * 1024 * 2;
constexpr size_t WS_H = WS_MOD + (size_t)256 * 12288 * 4;
constexpr size_t WS_AUX = WS_H + (size_t)T_TOK * 1024 * 2;
constexpr size_t WS_PROJ = WS_AUX + (size_t)T_TOK * 64 * 4;
constexpr size_t WS_KET = WS_PROJ + (size_t)T_TOK * NP * 2;
constexpr size_t WS_ATT = WS_KET + (size_t)1152 * 8192 * 2;
constexpr size_t WS_DEC = WS_ATT + (size_t)1152 * 4096 * 2;
constexpr size_t WS_CBG = WS_DEC + (size_t)1152 * 128 * 4;
constexpr size_t WS_SM1 = WS_CBG + (size_t)1152 * 4096 * 2;
constexpr size_t WS_SCL = WS_SM1 + (size_t)12 * 1024 * 1024;
constexpr size_t WS_END = WS_SCL + (size_t)4 * 16384 * 4;
__host__ __device__ constexpr size_t ws_win(int l) { return l ? WS_WADA : WS_WIN; }
__host__ __device__ constexpr size_t ws_wgla(int l) { return l ? WS_SM1 : WS_WGLA; }
__host__ __device__ constexpr size_t ws_wssd(int l) { return l ? WS_SM1 + (size_t)2 * 1024 * 1024 : WS_WSSD; }
__host__ __device__ constexpr size_t ws_wout(int l) { return l ? WS_SM1 + (size_t)6 * 1024 * 1024 : WS_WOUT; }
__host__ __device__ constexpr size_t ws_wpeer(int l) { return l ? WS_SM1 + (size_t)8 * 1024 * 1024 : WS_WPEER; }
__host__ __device__ constexpr size_t ws_uv(int l) { return l ? WS_V : WS_U; }
__host__ __device__ constexpr size_t ws_su(int l) { return WS_SCL + (size_t)l * 131072; }
__host__ __device__ constexpr size_t ws_sv(int l) { return WS_SCL + (size_t)l * 131072 + 65536; }
constexpr int PC_Q = 0, PC_K = 512, PC_V = 1024, PC_GO = 2048, PC_Z = 3072, PC_XBC = 5120, PC_GATE = 8192;
constexpr size_t O_GLAP = 18874368, O_SSDP = 20971520, O_CONVP = 25165824, O_GLAS = 25313280, O_SSDS = 33701888, O_CONVS = 50479104;

#ifndef GEMM_MASK
#define GEMM_MASK 63
#endif
#define GAS __attribute__((address_space(1)))
struct Params { const float* in[30]; float* out; unsigned char* ws; };

__device__ __forceinline__ float bf2f(bf16_t b) { return __uint_as_float(((unsigned)b) << 16); }
__device__ __forceinline__ bf16_t f2bf(float f) { return (bf16_t)(cvt_pk_bf16(f, 0.f) & 0xffffu); }
__device__ __forceinline__ float lo_bf(unsigned w) { return __uint_as_float(w << 16); }
__device__ __forceinline__ float hi_bf(unsigned w) { return __uint_as_float(w & 0xffff0000u); }
__device__ __forceinline__ float sigmoidf_(float x) { return 1.f / (1.f + __expf(-x)); }
__device__ __forceinline__ float siluf_(float x) { return x / (1.f + __expf(-x)); }
__device__ __forceinline__ int otid() { int t = threadIdx.x; asm volatile("" : "+v"(t)); return t; }
__device__ __forceinline__ int cb_of_row(int r) { return r < T_PROMPT ? (r >> 11) : 8 + ((r - T_PROMPT) >> 6); }
__device__ __forceinline__ float wave_sum(float v) {
#pragma unroll
    for (int o = 32; o >= 1; o >>= 1) v += __shfl_xor(v, o);
    return v;
}
__device__ __forceinline__ float wave_max(float v) {
#pragma unroll
    for (int o = 32; o >= 1; o >>= 1) v = fmaxf(v, __shfl_xor(v, o));
    return v;
}

struct EpiF32 {
    static constexpr bool PERM = false, AFTER_DRAIN = false;
    float* C; int ldc; const float* bias;
    __device__ __forceinline__ void operator()(const f32x4 (&acc)[2][2][4][2], const Unit& u, int wr, int wc, int fr, int fq) const {
        const int row0 = u.pm * 256 + wr * 64 + fr, col0 = u.pn * 256 + wc * 32 + 4 * fq;
        f32x4 bv[2][2];
#pragma unroll
        for (int bj = 0; bj < 2; ++bj)
#pragma unroll
            for (int n = 0; n < 2; ++n) bv[bj][n] = bias ? *(const f32x4*)(bias + col0 + bj * 128 + n * 16) : (f32x4){0.f, 0.f, 0.f, 0.f};
#pragma unroll
        for (int ai = 0; ai < 2; ++ai)
#pragma unroll
            for (int m = 0; m < 4; ++m) { float* rowp = C + (size_t)(row0 + ai * 128 + m * 16) * ldc + col0;
#pragma unroll
                for (int bj = 0; bj < 2; ++bj)
#pragma unroll
                    for (int n = 0; n < 2; ++n) *(f32x4*)(rowp + bj * 128 + n * 16) = acc[ai][bj][m][n] + bv[bj][n]; }
    }
};
struct EpiF32NT {
    static constexpr bool PERM = false, AFTER_DRAIN = false;
    float* C; int ldc; const float* bias;
    __device__ __forceinline__ void operator()(const f32x4 (&acc)[2][2][4][2], const Unit& u, int wr, int wc, int fr, int fq) const {
        const int row0 = u.pm * 256 + wr * 64 + fr, col0 = u.pn * 256 + wc * 32 + 4 * fq;
        f32x4 bv[2][2];
#pragma unroll
        for (int bj = 0; bj < 2; ++bj)
#pragma unroll
            for (int n = 0; n < 2; ++n) bv[bj][n] = bias ? *(const f32x4*)(bias + col0 + bj * 128 + n * 16) : (f32x4){0.f, 0.f, 0.f, 0.f};
#pragma unroll
        for (int ai = 0; ai < 2; ++ai)
#pragma unroll
            for (int m = 0; m < 4; ++m) { float* rowp = C + (size_t)(row0 + ai * 128 + m * 16) * ldc + col0;
#pragma unroll
                for (int bj = 0; bj < 2; ++bj)
#pragma unroll
                    for (int n = 0; n < 2; ++n) __builtin_nontemporal_store(acc[ai][bj][m][n] + bv[bj][n], (GAS f32x4*)(rowp + bj * 128 + n * 16)); }
    }
};
struct EpiInProj {
    static constexpr bool PERM = true, AFTER_DRAIN = false;
    bf16_t* P; float* aux;
    __device__ __forceinline__ void operator()(const f32x4 (&acc)[2][2][4][2], const Unit& u, int wr, int wc, int fr, int fq) const {
        const int row0 = u.pm * 256 + wr * 64 + fr;
        if (u.pn == 40) {
            if (wc < 2) {
#pragma unroll
                for (int ai = 0; ai < 2; ++ai)
#pragma unroll
                    for (int m = 0; m < 4; ++m) { GAS float* rowp = (GAS float*)aux + (size_t)(row0 + ai * 128 + m * 16) * 64 + wc * 32 + 8 * fq;
                        *(GAS f32x4*)rowp = acc[ai][0][m][0]; *(GAS f32x4*)(rowp + 4) = acc[ai][0][m][1]; }
            }
        } else {
            const int col0 = u.pn * 256 + wc * 32 + 8 * fq;
#pragma unroll
            for (int ai = 0; ai < 2; ++ai)
#pragma unroll
                for (int m = 0; m < 4; ++m) { GAS bf16_t* rowp = (GAS bf16_t*)P + (size_t)(row0 + ai * 128 + m * 16) * NP + col0;
#pragma unroll
                    for (int bj = 0; bj < 2; ++bj) { const f32x4 v0 = acc[ai][bj][m][0], v1 = acc[ai][bj][m][1];
                        u32x4 w; w.x = cvt_pk_bf16(v0[0], v0[1]); w.y = cvt_pk_bf16(v0[2], v0[3]); w.z = cvt_pk_bf16(v1[0], v1[1]); w.w = cvt_pk_bf16(v1[2], v1[3]);
                        *(GAS u32x4*)(rowp + bj * 128) = w; } }
        }
    }
};
struct EpiGlaProj {
    static constexpr bool PERM = false, AFTER_DRAIN = false;
    bf16_t* P;
    __device__ __forceinline__ void operator()(const f32x4 (&acc)[2][2][4][2], const Unit& u, int wr, int wc, int fr, int fq) const {
        const int row0 = u.pm * 256 + wr * 64 + fr, col0 = u.pn * 256 + wc * 32 + 4 * fq;
#pragma unroll
        for (int ai = 0; ai < 2; ++ai)
#pragma unroll
            for (int m = 0; m < 4; ++m) { bf16_t* rowp = P + (size_t)(row0 + ai * 128 + m * 16) * NP + col0;
#pragma unroll
                for (int bj = 0; bj < 2; ++bj)
#pragma unroll
                    for (int n = 0; n < 2; ++n) { const f32x4 v = acc[ai][bj][m][n]; const u32x2 g = *(const u32x2*)(rowp + PC_GATE + bj * 128 + n * 16);
                        u32x2 w; w.x = cvt_pk_bf16(v[0] * sigmoidf_(lo_bf(g.x)), v[1] * sigmoidf_(hi_bf(g.x))); w.y = cvt_pk_bf16(v[2] * sigmoidf_(lo_bf(g.y)), v[3] * sigmoidf_(hi_bf(g.y)));
                        *(u32x2*)(rowp + bj * 128 + n * 16) = w; } }
    }
};
struct EpiSsdProj {
    static constexpr bool PERM = false, AFTER_DRAIN = false;
    const bf16_t* P; bf16_t* H;
    __device__ __forceinline__ void operator()(const f32x4 (&acc)[2][2][4][2], const Unit& u, int wr, int wc, int fr, int fq) const {
        const int row0 = u.pm * 256 + wr * 64 + fr, col0 = u.pn * 256 + wc * 32 + 4 * fq;
#pragma unroll
        for (int ai = 0; ai < 2; ++ai)
#pragma unroll
            for (int m = 0; m < 4; ++m) { const int row = row0 + ai * 128 + m * 16; const bf16_t* rowp = P + (size_t)row * NP + col0; bf16_t* hp = H + (size_t)row * 1024 + col0;
#pragma unroll
                for (int bj = 0; bj < 2; ++bj)
#pragma unroll
                    for (int n = 0; n < 2; ++n) { const f32x4 v = acc[ai][bj][m][n]; const u32x2 g = *(const u32x2*)(rowp + PC_GATE + 1024 + bj * 128 + n * 16); const u32x2 t = *(const u32x2*)(rowp + bj * 128 + n * 16);
                        u32x2 w; w.x = cvt_pk_bf16(lo_bf(t.x) + v[0] * sigmoidf_(lo_bf(g.x)), hi_bf(t.x) + v[1] * sigmoidf_(hi_bf(g.x)));
                        w.y = cvt_pk_bf16(lo_bf(t.y) + v[2] * sigmoidf_(lo_bf(g.y)), hi_bf(t.y) + v[3] * sigmoidf_(hi_bf(g.y)));
                        *(u32x2*)(hp + bj * 128 + n * 16) = w; } }
    }
};
struct EpiWout {
    static constexpr bool PERM = false, AFTER_DRAIN = false;
    float* X; const float* Xa; const float* Xb; const float* modg;
    __device__ __forceinline__ void operator()(const f32x4 (&acc)[2][2][4][2], const Unit& u, int wr, int wc, int fr, int fq) const {
        const int row0 = u.pm * 256 + wr * 64 + fr, col0 = u.pn * 256 + wc * 32 + 4 * fq;
#pragma unroll
        for (int ai = 0; ai < 2; ++ai)
#pragma unroll
            for (int m = 0; m < 4; ++m) { const int row = row0 + ai * 128 + m * 16; float* xp = X + (size_t)row * 1024 + col0; const float* xi = (row < T_PROMPT ? Xa + (size_t)row * 1024 : Xb + (size_t)(row - T_PROMPT) * 1024) + col0; const float* gp = modg + (size_t)cb_of_row(row) * 12288 + col0;
#pragma unroll
                for (int bj = 0; bj < 2; ++bj)
#pragma unroll
                    for (int n = 0; n < 2; ++n) { const f32x4 g = *(const f32x4*)(gp + bj * 128 + n * 16); f32x4 xv = *(const f32x4*)(xi + bj * 128 + n * 16); xv = xv + g * acc[ai][bj][m][n]; *(f32x4*)(xp + bj * 128 + n * 16) = xv; } }
    }
};

template <int ID, class Epi>
__device__ __forceinline__ void run_gemm(LAS unsigned char* lds, const bf16_t* A, int lda, const bf16_t* Bt, int M, int N, int K, const Epi& E) {
    pg8::Gemm g; g.A = A; g.Bt = Bt; g.M = M; g.N = N; g.K = K; g.lda = lda;
    pg8::StaticOrder S; S.init(M, N, (int)gridDim.x, (int)blockIdx.x);
#ifndef NO_GEMM
    if (!((GEMM_MASK >> ID) & 1)) return;
    pg8::gemm_phase<Epi, pg8::StaticOrder, false>(lds, g, S, E, nullptr);
#endif
    __syncthreads();
}

__device__ __forceinline__ int win_src_col(int n) {
    if (n < 3072) return n;
    if (n < 8192) return n + 16;
    if (n < 10240) return n + 48;
    if (n < 10256) return n - 10240 + 3072;
    if (n < 10288) return n - 10256 + 8208;
    return -1;
}
template <bool MAP>
__device__ __forceinline__ void tconv_tile(const float* W, int Nsrc, bf16_t* Wt, int ldt, int k0, int n0, float* tile, int tid) {
    {
        const int nn = tid & 63, n = n0 + nn; const int sc = MAP ? win_src_col(n) : n;
#pragma unroll
        for (int i = 0; i < 8; ++i) { const int kk = i * 8 + (tid >> 6); tile[kk * 65 + nn] = sc >= 0 ? __builtin_nontemporal_load(W + (size_t)(k0 + kk) * Nsrc + sc) : 0.f; }
    }
    __syncthreads();
    {
        const int nn = tid >> 3, ks = (tid & 7) * 8; const float* s = tile + ks * 65 + nn;
        u32x4 o; o.x = cvt_pk_bf16(s[0], s[65]); o.y = cvt_pk_bf16(s[2 * 65], s[3 * 65]); o.z = cvt_pk_bf16(s[4 * 65], s[5 * 65]); o.w = cvt_pk_bf16(s[6 * 65], s[7 * 65]);
        *(u32x4*)(Wt + (size_t)(n0 + nn) * ldt + k0 + ks) = o;
    }
    __syncthreads();
}
__device__ __forceinline__ void conv_rows_bf16(const float* src, bf16_t* dst, size_t n8, int bid, int nb, int tid) {
    for (size_t i = (size_t)bid * 512 + tid; i < n8; i += (size_t)nb * 512) {
        const f32x4 a = *(const f32x4*)(src + i * 8), b = *(const f32x4*)(src + i * 8 + 4);
        u32x4 o; o.x = cvt_pk_bf16(a[0], a[1]); o.y = cvt_pk_bf16(a[2], a[3]); o.z = cvt_pk_bf16(b[0], b[1]); o.w = cvt_pk_bf16(b[2], b[3]);
        *(u32x4*)(dst + i * 8) = o;
    }
}
#define DPPF(old, src, ctrl, rm, bm) __int_as_float(__builtin_amdgcn_update_dpp(__float_as_int(old), __float_as_int(src), ctrl, rm, bm, false))
__device__ __forceinline__ float wave_max_u(float v) {
    const float ninf = -3.4e38f;
    v = fmaxf(v, DPPF(ninf, v, 0x111, 0xf, 0xf)); v = fmaxf(v, DPPF(ninf, v, 0x112, 0xf, 0xf)); v = fmaxf(v, DPPF(ninf, v, 0x114, 0xf, 0xf)); v = fmaxf(v, DPPF(ninf, v, 0x118, 0xf, 0xf));
    v = fmaxf(v, DPPF(ninf, v, 0x142, 0xa, 0xf)); v = fmaxf(v, DPPF(ninf, v, 0x143, 0xc, 0xf));
    return __int_as_float(__builtin_amdgcn_readlane(__float_as_int(v), 63));
}
__device__ __forceinline__ float wave_sum_u(float v) {
    v += DPPF(0.f, v, 0x111, 0xf, 0xf); v += DPPF(0.f, v, 0x112, 0xf, 0xf); v += DPPF(0.f, v, 0x114, 0xf, 0xf); v += DPPF(0.f, v, 0x118, 0xf, 0xf);
    v += DPPF(0.f, v, 0x142, 0xa, 0xf); v += DPPF(0.f, v, 0x143, 0xc, 0xf);
    return __int_as_float(__builtin_amdgcn_readlane(__float_as_int(v), 63));
}
__device__ __forceinline__ void conv_rows_fp8(const float* src, unsigned char* dst, float* scl, int bid, int nb, int tid, int row_lo, int row_hi) {
    const int lane = tid & 63;
    for (int row = row_lo + bid * 8 + (tid >> 6); row < row_hi; row += nb * 8) {
        const GAS f32x4* sp = (const GAS f32x4*)((const GAS float*)src + (size_t)row * 1024) + lane; f32x4 v[4]; float am = 0.f;
#pragma unroll
        for (int j = 0; j < 4; ++j) { v[j] = __builtin_nontemporal_load(sp + 64 * j); am = fmaxf(am, fmaxf(fmaxf(fabsf(v[j][0]), fabsf(v[j][1])), fmaxf(fabsf(v[j][2]), fabsf(v[j][3])))); }
        am = wave_max_u(am); const float q = am > 0.f ? 448.f / am : 1.f;
        GAS unsigned* dp = (GAS unsigned*)((GAS unsigned char*)dst + (size_t)row * 2048) + lane;
#pragma unroll
        for (int j = 0; j < 4; ++j) { int w = 0; w = __builtin_amdgcn_cvt_pk_fp8_f32(v[j][0] * q, v[j][1] * q, w, false); w = __builtin_amdgcn_cvt_pk_fp8_f32(v[j][2] * q, v[j][3] * q, w, true); dp[64 * j] = (unsigned)w; }
        if (lane == 0) scl[row] = am > 0.f ? am * (1.f / 448.f) : 1.f;
    }
}
__device__ __forceinline__ void mod_gemv(const Params& p, unsigned char* smem, int bid, int nb) {
    typedef __bf16 bf16v2_l __attribute__((ext_vector_type(2)));
    const int tid = otid(), wid = tid >> 6, lane = tid & 63;
    unsigned* sc2 = (unsigned*)smem;
    float* part = (float*)(smem + 81920);
    GAS float* mod = (GAS float*)(p.ws + WS_MOD); const GAS float* bias = (const GAS float*)p.in[8];
    for (int idx = tid; idx < 40 * 512; idx += 512) { const int cb = idx >> 9, kp = idx & 511; const GAS float* cp = cb < 8 ? (const GAS float*)p.in[5] + cb * 1024 : (const GAS float*)p.in[6] + (cb - 8) * 1024;
        sc2[kp * 40 + cb] = cvt_pk_bf16(siluf_(cp[2 * kp]), siluf_(cp[2 * kp + 1])); }
    __syncthreads();
    for (int cg = bid; cg < 192; cg += nb) {
        const int n = cg * 64 + lane, la = n / 6144, nn = n - la * 6144;
        const GAS float* W = (const GAS float*)p.in[7] + (size_t)la * 1024 * 6144 + nn + (size_t)(wid * 128) * 6144;
        float acc[40];
#pragma unroll
        for (int r = 0; r < 40; ++r) acc[r] = 0.f;
#pragma unroll 1
        for (int kb = 0; kb < 64; kb += 16) {
            float wv[32];
#pragma unroll
            for (int j = 0; j < 32; ++j) wv[j] = __builtin_nontemporal_load(W + (size_t)(2 * kb + j) * 6144);
#pragma unroll
            for (int j = 0; j < 16; ++j) { const bf16v2_l wp = __builtin_bit_cast(bf16v2_l, cvt_pk_bf16(wv[2 * j], wv[2 * j + 1])); const unsigned* sr = sc2 + (wid * 64 + kb + j) * 40;
#pragma unroll
                for (int r = 0; r < 40; ++r) acc[r] = __builtin_amdgcn_fdot2_f32_bf16(wp, __builtin_bit_cast(bf16v2_l, sr[r]), acc[r], false); }
        }
#pragma unroll
        for (int half = 0; half < 2; ++half) {
#pragma unroll
            for (int r = 0; r < 20; ++r) part[(wid * 20 + r) * 64 + lane] = acc[half * 20 + r];
            __syncthreads();
            for (int o = tid; o < 20 * 64; o += 512) { const int r = o >> 6, c = o & 63; float sum = 0.f;
#pragma unroll
                for (int w = 0; w < 8; ++w) sum += part[(w * 20 + r) * 64 + c];
                const int n2 = cg * 64 + c; mod[(size_t)(half * 20 + r) * 12288 + n2] = sum + bias[n2]; }
            __syncthreads();
        }
    }
}
__device__ __forceinline__ void phase_convert(const Params& p, int l, unsigned char* smem, int bid, int nb, int parts) {
    const int tid = otid();
    float* tile = (float*)smem;
    if (parts & 1) {
    for (int it = bid; it < 164 * 16; it += nb) { const int nt = it / 16, kt = it % 16;
        tconv_tile<true>(p.in[10] + (size_t)l * 1024 * NIN, NIN, (bf16_t*)(p.ws + ws_win(l)), 1024, kt * 64, nt * 64, tile, tid); }
    for (int it = bid; it < 256; it += nb) { const int nt = it / 16, kt = it % 16;
        tconv_tile<false>(p.in[14] + (size_t)l * 1024 * 1024, 1024, (bf16_t*)(p.ws + ws_wgla(l)), 1024, kt * 64, nt * 64, tile, tid); }
    for (int it = bid; it < 512; it += nb) { const int nt = it / 32, kt = it % 32;
        tconv_tile<false>(p.in[21] + (size_t)l * 2048 * 1024, 1024, (bf16_t*)(p.ws + ws_wssd(l)), 2048, kt * 64, nt * 64, tile, tid); }
    for (int it = bid; it < 256; it += nb) { const int nt = it / 16, kt = it % 16;
        tconv_tile<false>(p.in[22] + (size_t)l * 1024 * 1024, 1024, (bf16_t*)(p.ws + ws_wout(l)), 1024, kt * 64, nt * 64, tile, tid); }
    }
    if (parts & 12) {
        const int rlo = (parts & 4) ? 0 : 8192, rhi = (parts & 8) ? 16384 : 8192;
        conv_rows_fp8(p.in[27] + (size_t)l * 16384 * 1024, p.ws + ws_uv(l), (float*)(p.ws + ws_su(l)), bid, nb, tid, rlo, rhi);
        conv_rows_fp8(p.in[28] + (size_t)l * 16384 * 1024, p.ws + ws_uv(l) + 1024, (float*)(p.ws + ws_sv(l)), bid, nb, tid, rlo, rhi);
    }
    if (parts & 1)
    {
        float* keysL = (float*)smem; float* wqL = keysL + 64 * 129;
        bf16_t* WpT = (bf16_t*)(p.ws + ws_wpeer(l));
        for (int it = bid; it < 512; it += nb) {
            const int nt = it >> 4, mt = it & 15, n0 = nt * 64, m0 = mt * 64, h = n0 >> 8, half = (n0 >> 7) & 1, k0 = n0 & 127;
            const float* kp = (half ? p.in[26] : p.in[25]) + ((size_t)(l * 8 + h) * 128 + k0) * 128;
            const float* wp = p.in[24] + (size_t)l * 1024 * 2048 + (size_t)m0 * 2048 + h * 256 + half * 128;
#pragma unroll
            for (int i = 0; i < 16; ++i) { const int idx = tid + 512 * i, r = idx >> 7, d = idx & 127; keysL[r * 129 + d] = kp[r * 128 + d]; wqL[r * 129 + d] = wp[(size_t)r * 2048 + d]; }
            __syncthreads();
            const int nn = tid >> 3, ms = (tid & 7) * 8; float a[8] = {0.f, 0.f, 0.f, 0.f, 0.f, 0.f, 0.f, 0.f};
            for (int d = 0; d < 128; ++d) { const float kv = keysL[nn * 129 + d];
#pragma unroll
                for (int j = 0; j < 8; ++j) a[j] += kv * wqL[(ms + j) * 129 + d]; }
            u32x4 o; o.x = cvt_pk_bf16(a[0], a[1]); o.y = cvt_pk_bf16(a[2], a[3]); o.z = cvt_pk_bf16(a[4], a[5]); o.w = cvt_pk_bf16(a[6], a[7]);
            *(u32x4*)(WpT + (size_t)(n0 + nn) * 1024 + m0 + ms) = o;
            __syncthreads();
        }
    }
}

__device__ __forceinline__ void phase_norm(const Params& p, const float* Xa, const float* Xb, const float* nw, int off_sh, int off_sc) {
    const int tid = otid(), lane = tid & 63, gw = blockIdx.x * 8 + (tid >> 6), nw_ = gridDim.x * 8;
    const GAS float* mod = (const GAS float*)(p.ws + WS_MOD); GAS bf16_t* H = (GAS bf16_t*)(p.ws + WS_H);
    f32x4 wv[4];
#pragma unroll
    for (int j = 0; j < 4; ++j) wv[j] = *(const GAS f32x4*)((const GAS float*)nw + lane * 4 + 256 * j);
    constexpr int RB = 3;
    for (int row0 = gw; row0 < T_TOK; row0 += nw_ * RB) {
        f32x4 v[RB][4];
#pragma unroll
        for (int r = 0; r < RB; ++r) { const int row = row0 + r * nw_; if (row < T_TOK) { const GAS f32x4* xr = (const GAS f32x4*)(row < T_PROMPT ? Xa + (size_t)row * 1024 : Xb + (size_t)(row - T_PROMPT) * 1024) + lane;
#pragma unroll
                for (int j = 0; j < 4; ++j) v[r][j] = xr[64 * j]; } }
#pragma unroll
        for (int r = 0; r < RB; ++r) { const int row = row0 + r * nw_; if (row < T_TOK) { float ss = 0.f;
#pragma unroll
                for (int j = 0; j < 4; ++j) ss += v[r][j][0] * v[r][j][0] + v[r][j][1] * v[r][j][1] + v[r][j][2] * v[r][j][2] + v[r][j][3] * v[r][j][3];
                const float rstd = rsqrtf(wave_sum_u(ss) * (1.f / 1024.f) + EPSN);
                const GAS float* mp = mod + (size_t)cb_of_row(row) * 12288;
#pragma unroll
                for (int j = 0; j < 4; ++j) { const int col = lane * 4 + 256 * j;
                    const f32x4 sc = *(const GAS f32x4*)(mp + off_sc + col), sh = *(const GAS f32x4*)(mp + off_sh + col);
                    const f32x4 o = v[r][j] * rstd * wv[j] * (sc + 1.f) + sh;
                    u32x2 pk; pk.x = cvt_pk_bf16(o[0], o[1]); pk.y = cvt_pk_bf16(o[2], o[3]);
                    *(GAS u32x2*)(H + (size_t)row * 1024 + col) = pk; } } }
    }
}

__device__ __forceinline__ bf16x8 ldfrag(const LAS bf16_t* base, int stride, int r0, int k0, int lane) {
    return *(const LAS bf16x8*)(base + (r0 + (lane & 15)) * stride + k0 + (lane >> 4) * 8);
}
__device__ __forceinline__ f32x4 mfma16(bf16x8 a, bf16x8 b, f32x4 c) { return __builtin_amdgcn_mfma_f32_16x16x32_bf16(a, b, c, 0, 0, 0); }


#ifdef DBG2
__device__ __forceinline__ void dbg2(const Params& p, bool bad, int e) { if (bad) atomicMax((unsigned*)(p.ws + WS_BAR) + 4000, (unsigned)(100 - e)); }
__device__ __forceinline__ bool nonfin(float v) { return (__float_as_uint(v) & 0x7F800000u) == 0x7F800000u; }
#define DBG2(bad, e) dbg2(p, bad, e)
#else
#define DBG2(bad, e)
#endif
__device__ __forceinline__ void gla_pre_item(const Params& p, int l, LAS unsigned char* lds, int item) {
    const int tid = otid(), wid = tid >> 6, lane = tid & 63, quad = lane >> 4, l15 = lane & 15;
    LAS bf16_t* Q = (LAS bf16_t*)(lds + 0); LAS bf16_t* Kt = (LAS bf16_t*)(lds + 17408); LAS bf16_t* KeT = (LAS bf16_t*)(lds + 34816);
    LAS bf16_t* Att = (LAS bf16_t*)(lds + 57856);
    LAS float* bsum = (LAS float*)(lds + 75776); LAS float* ptot = (LAS float*)(lds + 108544); LAS float* gl = (LAS float*)(lds + 110592); LAS float* dec = (LAS float*)(lds + 114688);
    GAS bf16_t* proj = (GAS bf16_t*)(p.ws + WS_PROJ); const GAS float* aux = (const GAS float*)(p.ws + WS_AUX);
    const int gc = item >> 2, h = item & 3, r0 = gc * 64;
    const int d = tid & 127, part = tid >> 7;
    float w2c[16];
#pragma unroll
    for (int r = 0; r < 16; ++r) w2c[r] = ((const GAS float*)p.in[11])[(size_t)(l * 16 + r) * 512 + h * 128 + d];
    const float gb = ((const GAS float*)p.in[12])[l * 512 + h * 128 + d];
    const int gi = (tid >> 2) & 63, gq4 = (tid & 3) * 4, qr = tid >> 4, qc8 = (tid & 15) * 8;
    {
        const f32x4 n_gl = *(const GAS f32x4*)(aux + (size_t)(r0 + gi) * 64 + gq4); u32x4 n_q[2], n_k[2];
#pragma unroll
        for (int q_ = 0; q_ < 2; ++q_) { const GAS bf16_t* rp_ = proj + (size_t)(r0 + qr + 32 * q_) * NP + h * 128 + qc8; n_q[q_] = *(const GAS u32x4*)(rp_ + PC_Q); n_k[q_] = *(const GAS u32x4*)(rp_ + PC_K); }
        __syncthreads();
        if (tid < 256) *(LAS f32x4*)(gl + gi * 16 + gq4) = n_gl;
#pragma unroll
        for (int q_ = 0; q_ < 2; ++q_) { *(LAS u32x4*)(Q + (qr + 32 * q_) * 136 + qc8) = n_q[q_]; *(LAS u32x4*)(Kt + (qr + 32 * q_) * 136 + qc8) = n_k[q_]; }
    }
    __syncthreads();
    { float run = 0.f;
#pragma unroll 4
        for (int ii = 0; ii < 16; ++ii) { const int i = part * 16 + ii; float z = gb;
#pragma unroll
            for (int r = 0; r < 16; ++r) z += gl[i * 16 + r] * w2c[r];
            const float g = (fminf(z, 0.f) - __logf(1.f + __expf(-fabsf(z)))) * (1.f / 16.f);
            run += g; bsum[i * 128 + d] = run; }
        ptot[part * 128 + d] = run; }
    __syncthreads();
    { float off = 0.f, tot = 0.f;
#pragma unroll
        for (int pp = 0; pp < 4; ++pp) { const float t = ptot[pp * 128 + d]; if (pp < part) off += t; tot += t; }
        const float etot = __expf(tot);
        if (part == 0) dec[d] = etot;
#pragma unroll
        for (int i8 = 0; i8 < 2; ++i8) { float ke[8];
#pragma unroll
            for (int ii = 0; ii < 8; ++ii) { const int i = part * 16 + i8 * 8 + ii; const float b = bsum[i * 128 + d] + off;
                const float qv = bf2f(Q[i * 136 + d]), kv = bf2f(Kt[i * 136 + d]); const float enb = __expf(-b);
                Q[i * 136 + d] = f2bf(qv * 0.08838834764831845f * __expf(b)); Kt[i * 136 + d] = f2bf(kv * enb); ke[ii] = kv * (etot * enb); }
            u32x4 o; o.x = cvt_pk_bf16(ke[0], ke[1]); o.y = cvt_pk_bf16(ke[2], ke[3]); o.z = cvt_pk_bf16(ke[4], ke[5]); o.w = cvt_pk_bf16(ke[6], ke[7]);
            *(LAS u32x4*)(KeT + d * 72 + part * 16 + i8 * 8) = o; } }
    __syncthreads();
    { const int ti = wid >> 1;
#pragma unroll
        for (int t2 = 0; t2 < 2; ++t2) { const int tj = (wid & 1) * 2 + t2; f32x4 a = (f32x4){0.f, 0.f, 0.f, 0.f};
            if (tj <= ti) {
#pragma unroll
                for (int kk = 0; kk < 4; ++kk) a = mfma16(ldfrag(Q, 136, ti * 16, kk * 32, lane), ldfrag(Kt, 136, tj * 16, kk * 32, lane), a); }
#pragma unroll
            for (int jj = 0; jj < 4; ++jj) { const int i = ti * 16 + quad * 4 + jj, j = tj * 16 + l15; Att[i * 72 + j] = f2bf(j <= i ? a[jj] : 0.f); } } }
    __syncthreads();
    {
#pragma unroll
        for (int q_ = 0; q_ < 2; ++q_) *(GAS u32x4*)(proj + (size_t)(r0 + qr + 32 * q_) * NP + h * 128 + qc8 + PC_Q) = *(const LAS u32x4*)(Q + (qr + 32 * q_) * 136 + qc8);
        GAS bf16_t* ket = (GAS bf16_t*)(p.ws + WS_KET) + (size_t)item * 8192;
#pragma unroll
        for (int q_ = 0; q_ < 2; ++q_) { const int idx = tid + 512 * q_, dd = idx >> 3, c8 = (idx & 7) * 8; *(GAS u32x4*)(ket + dd * 64 + c8) = *(const LAS u32x4*)(KeT + dd * 72 + c8); }
        GAS bf16_t* att = (GAS bf16_t*)(p.ws + WS_ATT) + (size_t)item * 4096;
        { const int ii = tid >> 3, c8 = (tid & 7) * 8; *(GAS u32x4*)(att + ii * 64 + c8) = *(const LAS u32x4*)(Att + ii * 72 + c8); }
        if (tid < 32) *(GAS f32x4*)((GAS float*)(p.ws + WS_DEC) + (size_t)item * 128 + tid * 4) = *(const LAS f32x4*)(dec + tid * 4);
    }
}
__device__ __forceinline__ void phase_gla_pre(const Params& p, int l, LAS unsigned char* lds) {
    for (int it = blockIdx.x; it < 1152; it += gridDim.x) gla_pre_item(p, l, lds, it);
}

template <bool DRY>
__device__ __forceinline__ void gla_chain(const Params& p, int l, LAS unsigned char* lds, int seq, int h, int sl) {
    const int tid = otid(), wid = tid >> 6, lane = tid & 63, quad = lane >> 4, l15 = lane & 15;
    GAS bf16_t* proj = (GAS bf16_t*)(p.ws + WS_PROJ);
    const GAS bf16_t* ketg = (const GAS bf16_t*)(p.ws + WS_KET); const GAS bf16_t* attg = (const GAS bf16_t*)(p.ws + WS_ATT); const GAS float* decg = (const GAS float*)(p.ws + WS_DEC);
    const bool samp = seq >= 8; const int nch = samp ? 1 : 32; const int gc0 = samp ? 256 + (seq - 8) : seq * 32;
    const int d0 = wid * 16 + quad * 4;
    f32x4 S[2];
    if (samp) { const GAS float* sp = (const GAS float*)p.in[2] + (size_t)((l * 32 + (seq - 8)) * 4 + h) * 32768;
#pragma unroll
        for (int te = 0; te < 2; ++te)
#pragma unroll
            for (int jj = 0; jj < 4; ++jj) S[te][jj] = sp[(d0 + jj) * 256 + sl * 32 + te * 16 + l15];
    } else { S[0] = (f32x4){0.f, 0.f, 0.f, 0.f}; S[1] = S[0]; }
    const int vj = tid >> 3, ve4 = (tid & 7) * 4, qr = tid >> 4, qc8 = (tid & 15) * 8, kd = tid >> 3, kc8 = (tid & 7) * 8;
    u32x2 n_v; u32x4 n_q[2], n_ke[2], n_att; f32x4 n_dec;
#define GLA_ISSUE(c_) do { const int gc_ = gc0 + (c_), r0_ = gc_ * 64, it_ = gc_ * 4 + h; \
        n_v = *(const GAS u32x2*)(proj + (size_t)(r0_ + vj) * NP + PC_V + h * 256 + sl * 32 + ve4); \
        _Pragma("unroll") for (int q_ = 0; q_ < 2; ++q_) { n_q[q_] = *(const GAS u32x4*)(proj + (size_t)(r0_ + qr + 32 * q_) * NP + h * 128 + qc8 + PC_Q); \
            n_ke[q_] = *(const GAS u32x4*)(ketg + (size_t)it_ * 8192 + (kd + 64 * q_) * 64 + kc8); } \
        n_att = *(const GAS u32x4*)(attg + (size_t)it_ * 4096 + kd * 64 + kc8); \
        if (tid < 32) n_dec = *(const GAS f32x4*)(decg + (size_t)it_ * 128 + tid * 4); } while (0)
    GLA_ISSUE(0);
    __syncthreads();
    { LAS bf16_t* ST = (LAS bf16_t*)(lds + 67072);
#pragma unroll
        for (int te = 0; te < 2; ++te) { u32x2 w; w.x = cvt_pk_bf16(S[te][0], S[te][1]); w.y = cvt_pk_bf16(S[te][2], S[te][3]); *(LAS u32x2*)(ST + (te * 16 + l15) * 136 + d0) = w; } }
    for (int c = 0; c < nch; ++c) {
        const int r0 = (gc0 + c) * 64;
        int lz = 0; asm volatile("" : "+v"(lz));
        LAS unsigned char* L = lds + lz;
        LAS bf16_t* Q = (LAS bf16_t*)(L + 0); LAS bf16_t* KeT = (LAS bf16_t*)(L + 34816);
        LAS bf16_t* vT = (LAS bf16_t*)(L + 53248); LAS bf16_t* Att = (LAS bf16_t*)(L + 57856); LAS bf16_t* ST = (LAS bf16_t*)(L + 67072); LAS float* dec = (LAS float*)(L + 114688);
        vT[(ve4 + 0) * 72 + vj] = (bf16_t)(n_v.x & 0xffffu); vT[(ve4 + 1) * 72 + vj] = (bf16_t)(n_v.x >> 16); vT[(ve4 + 2) * 72 + vj] = (bf16_t)(n_v.y & 0xffffu); vT[(ve4 + 3) * 72 + vj] = (bf16_t)(n_v.y >> 16);
#pragma unroll
        for (int q_ = 0; q_ < 2; ++q_) { *(LAS u32x4*)(Q + (qr + 32 * q_) * 136 + qc8) = n_q[q_]; *(LAS u32x4*)(KeT + (kd + 64 * q_) * 72 + kc8) = n_ke[q_]; }
        *(LAS u32x4*)(Att + kd * 72 + kc8) = n_att;
        if (tid < 32) *(LAS f32x4*)(dec + tid * 4) = n_dec;
        if (c + 1 < nch) GLA_ISSUE(c + 1);
        __syncthreads();
        { const int ti = wid >> 1, te = wid & 1; f32x4 a = (f32x4){0.f, 0.f, 0.f, 0.f};
#pragma unroll
            for (int kk = 0; kk < 2; ++kk) a = mfma16(ldfrag(Att, 72, ti * 16, kk * 32, lane), ldfrag(vT, 72, te * 16, kk * 32, lane), a);
#pragma unroll
            for (int kk = 0; kk < 4; ++kk) a = mfma16(ldfrag(Q, 136, ti * 16, kk * 32, lane), ldfrag(ST, 136, te * 16, kk * 32, lane), a);
#pragma unroll
            for (int jj = 0; jj < 4; ++jj) { const int i = ti * 16 + quad * 4 + jj; if (!DRY) proj[(size_t)(r0 + i) * NP + PC_V + h * 256 + sl * 32 + te * 16 + l15] = f2bf(a[jj]); else asm volatile("" :: "v"(a[jj])); } }
        { f32x4 dcv = *(const LAS f32x4*)(dec + d0);
#pragma unroll
            for (int te = 0; te < 2; ++te) { f32x4 a = (f32x4){0.f, 0.f, 0.f, 0.f};
#pragma unroll
                for (int kk = 0; kk < 2; ++kk) a = mfma16(ldfrag(KeT, 72, wid * 16, kk * 32, lane), ldfrag(vT, 72, te * 16, kk * 32, lane), a);
                S[te] = S[te] * dcv + a; } }
        __syncthreads();
#pragma unroll
        for (int te = 0; te < 2; ++te) { u32x2 w; w.x = cvt_pk_bf16(S[te][0], S[te][1]); w.y = cvt_pk_bf16(S[te][2], S[te][3]); *(LAS u32x2*)(ST + (te * 16 + l15) * 136 + d0) = w; }
    }
#undef GLA_ISSUE
    GAS float* so = (GAS float*)p.out + (samp ? O_GLAS + (size_t)((l * 32 + (seq - 8)) * 4 + h) * 32768 : O_GLAP + (size_t)((l * 8 + seq) * 4 + h) * 32768);
#pragma unroll
    for (int te = 0; te < 2; ++te)
#pragma unroll
        for (int jj = 0; jj < 4; ++jj) { if (!DRY) so[(d0 + jj) * 256 + sl * 32 + te * 16 + l15] = S[te][jj]; else asm volatile("" :: "v"(S[te][jj])); }
}

__device__ __forceinline__ void ssd_pre_item(const Params& p, int l, LAS unsigned char* lds, int item) {
    const int tid = otid(), wid = tid >> 6, lane = tid & 63, quad = lane >> 4, l15 = lane & 15;
    LAS bf16_t* rawT = (LAS bf16_t*)(lds + 0);
    LAS bf16_t* Bm = (LAS bf16_t*)(lds + 36864); LAS bf16_t* BT = (LAS bf16_t*)(lds + 54272); LAS bf16_t* Cm = (LAS bf16_t*)(lds + 72704); LAS bf16_t* CBl = (LAS bf16_t*)(lds + 90112);
    const GAS bf16_t* proj = (const GAS bf16_t*)(p.ws + WS_PROJ);
    const int gc = item >> 2, g = item & 3, r0 = gc * 64;
    const bool first = gc >= 256 || (gc & 31) == 0, samp = gc >= 256;
    u32x4 n_p[5];
#pragma unroll
    for (int j = 0; j < 5; ++j) { const int q_ = tid + 512 * j, rr = q_ >> 5, pc = q_ & 31; const int gcol = pc < 16 ? 2048 + g * 128 + pc * 8 : 2560 + g * 128 + (pc - 16) * 8;
        if (rr < 67 && (rr >= 3 || !first)) n_p[j] = *(const GAS u32x4*)(proj + (size_t)(r0 - 3 + rr) * NP + PC_XBC + gcol); }
    const int ch = tid & 255, half = tid >> 8; const int chan = ch < 128 ? 2048 + g * 128 + ch : 2560 + g * 128 + (ch - 128);
    const GAS float* cw = (const GAS float*)p.in[15] + (size_t)l * 4 * 3072; const float w0 = cw[chan], w1 = cw[3072 + chan], w2 = cw[2 * 3072 + chan], w3 = cw[3 * 3072 + chan], bb = ((const GAS float*)p.in[16])[(size_t)l * 3072 + chan];
    __syncthreads();
#pragma unroll
    for (int j = 0; j < 5; ++j) { const int q_ = tid + 512 * j, rr = q_ >> 5, pc = q_ & 31; if (rr < 67 && (rr >= 3 || !first)) *(LAS u32x4*)(rawT + rr * 264 + pc * 8) = n_p[j]; }
    if (first) { const GAS float* cprev = (const GAS float*)p.in[4] + (size_t)(l * 32 + (samp ? gc - 256 : 0)) * 3 * 3072;
        for (int idx = tid; idx < 768; idx += 512) { const int k = idx >> 8, c2 = idx & 255; const int chan2 = c2 < 128 ? 2048 + g * 128 + c2 : 2560 + g * 128 + (c2 - 128);
            rawT[k * 264 + c2] = samp ? f2bf(cprev[(size_t)k * 3072 + chan2]) : (bf16_t)0; } }
    __syncthreads();
    { const int i0 = half * 32; float x0 = bf2f(rawT[(i0 + 0) * 264 + ch]), x1 = bf2f(rawT[(i0 + 1) * 264 + ch]), x2 = bf2f(rawT[(i0 + 2) * 264 + ch]);
#pragma unroll
        for (int i8 = 0; i8 < 4; ++i8) { float a8[8];
#pragma unroll
            for (int ii = 0; ii < 8; ++ii) { const int i = i0 + i8 * 8 + ii; const float x3 = bf2f(rawT[(i + 3) * 264 + ch]); const float cv = bb + w0 * x0 + w1 * x1 + w2 * x2 + w3 * x3; a8[ii] = siluf_(cv);
                const bf16_t av = f2bf(a8[ii]);
                if (ch < 128) Bm[i * 136 + ch] = av; else Cm[i * 136 + (ch - 128)] = av;
                x0 = x1; x1 = x2; x2 = x3; }
            if (ch < 128) { u32x4 o; o.x = cvt_pk_bf16(a8[0], a8[1]); o.y = cvt_pk_bf16(a8[2], a8[3]); o.z = cvt_pk_bf16(a8[4], a8[5]); o.w = cvt_pk_bf16(a8[6], a8[7]); *(LAS u32x4*)(BT + ch * 72 + i0 + i8 * 8) = o; } } }
    __syncthreads();
    { const int ti = wid >> 1;
#pragma unroll
        for (int t2 = 0; t2 < 2; ++t2) { const int tj = (wid & 1) * 2 + t2; f32x4 a = (f32x4){0.f, 0.f, 0.f, 0.f};
            if (tj <= ti) {
#pragma unroll
                for (int kk = 0; kk < 4; ++kk) a = mfma16(ldfrag(Cm, 136, ti * 16, kk * 32, lane), ldfrag(Bm, 136, tj * 16, kk * 32, lane), a); }
#pragma unroll
            for (int jj = 0; jj < 4; ++jj) CBl[(ti * 16 + quad * 4 + jj) * 72 + tj * 16 + l15] = f2bf(a[jj]); } }
    __syncthreads();
    { GAS bf16_t* cact = (GAS bf16_t*)(p.ws + WS_H) + (size_t)item * 8192; GAS bf16_t* btg = (GAS bf16_t*)(p.ws + WS_H) + (size_t)1152 * 8192 + (size_t)item * 8192; GAS bf16_t* cbg = (GAS bf16_t*)(p.ws + WS_CBG) + (size_t)item * 4096;
#pragma unroll
        for (int q_ = 0; q_ < 2; ++q_) { const int idx = tid + 512 * q_;
            { const int rr = idx >> 4, c8 = (idx & 15) * 8; *(GAS u32x4*)(cact + rr * 128 + c8) = *(const LAS u32x4*)(Cm + rr * 136 + c8); }
            { const int ss = idx >> 3, c8 = (idx & 7) * 8; *(GAS u32x4*)(btg + ss * 64 + c8) = *(const LAS u32x4*)(BT + ss * 72 + c8); } }
        { const int ii = tid >> 3, c8 = (tid & 7) * 8; *(GAS u32x4*)(cbg + ii * 64 + c8) = *(const LAS u32x4*)(CBl + ii * 72 + c8); } }
}
__device__ __forceinline__ void phase_ssd_pre(const Params& p, int l, LAS unsigned char* lds) {
    for (int it = (int)((blockIdx.x + gridDim.x / 2) % gridDim.x); it < 1152; it += gridDim.x) ssd_pre_item(p, l, lds, it);
}

template <bool DRY>
__device__ __forceinline__ void ssd_chain(const Params& p, int l, LAS unsigned char* lds, int seq, int hd) {
    const int tid = otid(), wid = tid >> 6, lane = tid & 63, quad = lane >> 4, l15 = lane & 15;
    GAS bf16_t* proj = (GAS bf16_t*)(p.ws + WS_PROJ); const GAS float* aux = (const GAS float*)(p.ws + WS_AUX);
    const GAS bf16_t* cactg = (const GAS bf16_t*)(p.ws + WS_H); const GAS bf16_t* btgg = (const GAS bf16_t*)(p.ws + WS_H) + (size_t)1152 * 8192; const GAS bf16_t* cbgg = (const GAS bf16_t*)(p.ws + WS_CBG);
    const bool samp = seq >= 8; const int nch = samp ? 1 : 32; const int gc0 = samp ? 256 + (seq - 8) : seq * 32;
    const int g = hd >> 3, s0 = wid * 16 + quad * 4;
    const float Ah = -__expf(p.in[18][l * 32 + hd]), Dh = p.in[19][l * 32 + hd], dtb = p.in[17][l * 32 + hd];
    f32x4 S[4];
    if (samp) { const GAS float* sp = (const GAS float*)p.in[3] + (size_t)((l * 32 + (seq - 8)) * 32 + hd) * 8192;
#pragma unroll
        for (int tp = 0; tp < 4; ++tp) S[tp] = *(const GAS f32x4*)(sp + (tp * 16 + l15) * 128 + s0);
    } else {
#pragma unroll
        for (int tp = 0; tp < 4; ++tp) S[tp] = (f32x4){0.f, 0.f, 0.f, 0.f}; }
    const int xch = tid & 63, xpart = tid >> 6; const int xchan = hd * 64 + xch;
    const GAS float* cw = (const GAS float*)p.in[15] + (size_t)l * 4 * 3072; const float w0 = cw[xchan], w1 = cw[3072 + xchan], w2 = cw[2 * 3072 + xchan], w3 = cw[3 * 3072 + xchan], bb = ((const GAS float*)p.in[16])[(size_t)l * 3072 + xchan];
    const int pr = tid >> 4, pc8 = (tid & 15) * 8, kd = tid >> 3, kc8 = (tid & 7) * 8;
    u32x4 n_c[2], n_bt[2], n_cb, n_x[2]; float n_dt = 0.f;
#define SSD_ISSUE(c_) do { const int gc_ = gc0 + (c_), r0_ = gc_ * 64, it_ = gc_ * 4 + g; \
        if (wid == 0) n_dt = aux[(size_t)(r0_ + lane) * 64 + 16 + hd]; \
        _Pragma("unroll") for (int q_ = 0; q_ < 2; ++q_) { n_c[q_] = *(const GAS u32x4*)(cactg + (size_t)it_ * 8192 + (pr + 32 * q_) * 128 + pc8); n_bt[q_] = *(const GAS u32x4*)(btgg + (size_t)it_ * 8192 + (kd + 64 * q_) * 64 + kc8); \
            const int rr = kd + 64 * q_; if (rr < 67 && (rr >= 3 || (c_) > 0)) n_x[q_] = *(const GAS u32x4*)(proj + (size_t)(r0_ - 3 + rr) * NP + PC_XBC + hd * 64 + kc8); } \
        n_cb = *(const GAS u32x4*)(cbgg + (size_t)it_ * 4096 + kd * 64 + kc8); } while (0)
    SSD_ISSUE(0);
    __syncthreads();
    { LAS bf16_t* Sl = (LAS bf16_t*)(lds + 72704);
#pragma unroll
        for (int tp = 0; tp < 4; ++tp) { u32x2 w; w.x = cvt_pk_bf16(S[tp][0], S[tp][1]); w.y = cvt_pk_bf16(S[tp][2], S[tp][3]); *(LAS u32x2*)(Sl + (tp * 16 + l15) * 136 + s0) = w; } }
    for (int c = 0; c < nch; ++c) {
        const int r0 = (gc0 + c) * 64;
        int lz = 0; asm volatile("" : "+v"(lz));
        LAS unsigned char* L = lds + lz;
        LAS bf16_t* xT = (LAS bf16_t*)(L + 0); LAS bf16_t* xwT = (LAS bf16_t*)(L + 9216); LAS bf16_t* Cm = (LAS bf16_t*)(L + 18432); LAS bf16_t* BT = (LAS bf16_t*)(L + 35840);
        LAS bf16_t* CBl = (LAS bf16_t*)(L + 54272); LAS bf16_t* Wm = (LAS bf16_t*)(L + 63488); LAS bf16_t* Sl = (LAS bf16_t*)(L + 72704);
        LAS float* a_arr = (LAS float*)(L + 90112); LAS float* dt_arr = (LAS float*)(L + 90368); LAS bf16_t* rawT = (LAS bf16_t*)(L + 90624);
#pragma unroll
        for (int q_ = 0; q_ < 2; ++q_) { *(LAS u32x4*)(Cm + (pr + 32 * q_) * 136 + pc8) = n_c[q_]; *(LAS u32x4*)(BT + (kd + 64 * q_) * 72 + kc8) = n_bt[q_];
            const int rr = kd + 64 * q_; if (rr < 67 && (rr >= 3 || c > 0)) *(LAS u32x4*)(rawT + rr * 72 + kc8) = n_x[q_]; }
        *(LAS u32x4*)(CBl + kd * 72 + kc8) = n_cb;
        if (c == 0 && tid < 192) { const int k = tid >> 6, c2 = tid & 63; const GAS float* cprev = (const GAS float*)p.in[4] + (size_t)(l * 32 + (samp ? seq - 8 : 0)) * 3 * 3072;
            rawT[k * 72 + c2] = samp ? f2bf(cprev[(size_t)k * 3072 + hd * 64 + c2]) : (bf16_t)0; }
        unsigned short zc[8];
#pragma unroll
        for (int t2 = 0; t2 < 2; ++t2)
#pragma unroll
            for (int jj = 0; jj < 4; ++jj) zc[t2 * 4 + jj] = proj[(size_t)(r0 + (wid >> 1) * 16 + quad * 4 + jj) * NP + PC_Z + hd * 64 + ((wid & 1) * 2 + t2) * 16 + l15];
        if (wid == 0) { const float dtr = n_dt + dtb; const float dtv = fmaxf(dtr, 0.f) + log1pf(__expf(-fabsf(dtr)));
            float da = dtv * Ah;
#pragma unroll
            for (int o = 1; o < 64; o <<= 1) { const float t = __shfl_up(da, o); if (lane >= o) da += t; }
            a_arr[lane] = da; dt_arr[lane] = dtv; }
        if (c + 1 < nch) SSD_ISSUE(c + 1);
        __syncthreads();
        { const float a_last = a_arr[63]; const int i0 = xpart * 8;
            float x0 = bf2f(rawT[(i0 + 0) * 72 + xch]), x1 = bf2f(rawT[(i0 + 1) * 72 + xch]), x2 = bf2f(rawT[(i0 + 2) * 72 + xch]);
            float av[8], aw[8];
#pragma unroll
            for (int ii = 0; ii < 8; ++ii) { const int i = i0 + ii; const float x3 = bf2f(rawT[(i + 3) * 72 + xch]); const float cv = bb + w0 * x0 + w1 * x1 + w2 * x2 + w3 * x3; const float act = siluf_(cv);
                av[ii] = act; aw[ii] = act * dt_arr[i] * __expf(a_last - a_arr[i]);
                x0 = x1; x1 = x2; x2 = x3; }
            { u32x4 o1, o2;
#pragma unroll
                for (int k = 0; k < 4; ++k) { o1[k] = cvt_pk_bf16(av[2 * k], av[2 * k + 1]); o2[k] = cvt_pk_bf16(aw[2 * k], aw[2 * k + 1]); }
                *(LAS u32x4*)(xT + xch * 72 + i0) = o1; *(LAS u32x4*)(xwT + xch * 72 + i0) = o2; }
            const int wi = tid >> 3, wj0 = (tid & 7) * 8; const u32x4 cbv = *(const LAS u32x4*)(CBl + wi * 72 + wj0); const float ai = a_arr[wi]; float wv[8];
#pragma unroll
            for (int k = 0; k < 4; ++k) { const int j = wj0 + 2 * k; wv[2 * k] = j <= wi ? lo_bf(cbv[k]) * __expf(ai - a_arr[j]) * dt_arr[j] : 0.f; wv[2 * k + 1] = (j + 1) <= wi ? hi_bf(cbv[k]) * __expf(ai - a_arr[j + 1]) * dt_arr[j + 1] : 0.f; }
            u32x4 wo; wo.x = cvt_pk_bf16(wv[0], wv[1]); wo.y = cvt_pk_bf16(wv[2], wv[3]); wo.z = cvt_pk_bf16(wv[4], wv[5]); wo.w = cvt_pk_bf16(wv[6], wv[7]);
            *(LAS u32x4*)(Wm + wi * 72 + wj0) = wo; }
        __syncthreads();
        { const int ti = wid >> 1;
#pragma unroll
            for (int t2 = 0; t2 < 2; ++t2) { const int tp = (wid & 1) * 2 + t2; f32x4 yi = (f32x4){0.f, 0.f, 0.f, 0.f}, yo = yi;
#pragma unroll
                for (int kk = 0; kk < 2; ++kk) yi = mfma16(ldfrag(Wm, 72, ti * 16, kk * 32, lane), ldfrag(xT, 72, tp * 16, kk * 32, lane), yi);
#pragma unroll
                for (int kk = 0; kk < 4; ++kk) yo = mfma16(ldfrag(Cm, 136, ti * 16, kk * 32, lane), ldfrag(Sl, 136, tp * 16, kk * 32, lane), yo);
                const int pcol = tp * 16 + l15;
#pragma unroll
                for (int jj = 0; jj < 4; ++jj) { const int i = ti * 16 + quad * 4 + jj; const float xv = bf2f(xT[pcol * 72 + i]);
                    float y = yi[jj] + __expf(a_arr[i]) * yo[jj] + Dh * xv;
                    y *= siluf_(bf2f(zc[t2 * 4 + jj])); if (!DRY) proj[(size_t)(r0 + i) * NP + PC_Z + hd * 64 + pcol] = f2bf(y); else asm volatile("" :: "v"(y)); } } }
        { const float el = __expf(a_arr[63]);
#pragma unroll
            for (int tp = 0; tp < 4; ++tp) { f32x4 a = (f32x4){0.f, 0.f, 0.f, 0.f};
#pragma unroll
                for (int kk = 0; kk < 2; ++kk) a = mfma16(ldfrag(BT, 72, wid * 16, kk * 32, lane), ldfrag(xwT, 72, tp * 16, kk * 32, lane), a);
                S[tp] = S[tp] * el + a; } }
        __syncthreads();
#pragma unroll
        for (int tp = 0; tp < 4; ++tp) { u32x2 w; w.x = cvt_pk_bf16(S[tp][0], S[tp][1]); w.y = cvt_pk_bf16(S[tp][2], S[tp][3]); *(LAS u32x2*)(Sl + (tp * 16 + l15) * 136 + s0) = w; }
    }
#undef SSD_ISSUE
    GAS float* so = (GAS float*)p.out + (samp ? O_SSDS + (size_t)((l * 32 + (seq - 8)) * 32 + hd) * 8192 : O_SSDP + (size_t)((l * 8 + seq) * 32 + hd) * 8192);
#pragma unroll
    for (int tp = 0; tp < 4; ++tp) { if (!DRY) *(GAS f32x4*)(so + (tp * 16 + l15) * 128 + s0) = S[tp]; else asm volatile("" :: "v"(S[tp][0]), "v"(S[tp][1]), "v"(S[tp][2]), "v"(S[tp][3])); }
}

template <bool DRY>
__device__ __forceinline__ void phase_mixer(const Params& p, int l, LAS unsigned char* lds) {
    const int vb = (gridDim.x & 7) == 0 ? (int)((blockIdx.x & 7) * (gridDim.x >> 3) + (blockIdx.x >> 3)) : (int)blockIdx.x;
    for (int it = vb; it < 2560; it += gridDim.x) {
#ifdef DRY_GLA_ONLY
        if (DRY && ((it >= 256 && it < 512) || it >= 1536)) continue;
#endif
#ifdef DRY_PROMPT_ONLY
        if (DRY && it >= 512) continue;
#endif
#ifndef NO_GLA
        if (it < 256) gla_chain<DRY>(p, l, lds, it >> 5, (it >> 3) & 3, it & 7);
#else
        if (it < 256) {}
#endif
#ifndef NO_SSD
        else if (it < 512) { const int i = it - 256; ssd_chain<DRY>(p, l, lds, i >> 5, i & 31); }
#endif
#ifndef NO_GLA
        else if (it < 1536) { const int i = it - 512; gla_chain<DRY>(p, l, lds, 8 + (i >> 5), (i >> 3) & 3, i & 7); }
#endif
#ifndef NO_SSD
        else { const int i = it - 1536; ssd_chain<DRY>(p, l, lds, 8 + (i >> 5), i & 31); }
#endif
    }
}

__device__ __forceinline__ void phase_normgate(const Params& p, int l) {
    const int tid = otid(), lane = tid & 63, gw = blockIdx.x * 8 + (tid >> 6), nwv = gridDim.x * 8;
    GAS bf16_t* proj = (GAS bf16_t*)(p.ws + WS_PROJ);
    const GAS float* gnw = (const GAS float*)p.in[13] + l * 256; const GAS float* snw = (const GAS float*)p.in[20] + l * 2048;
    for (int row = gw; row < T_TOK; row += nwv) {
        GAS bf16_t* rp = proj + (size_t)row * NP;
        u32x4 q[4];
#pragma unroll
        for (int k = 0; k < 4; ++k) q[k] = *(const GAS u32x4*)(rp + PC_Z + lane * 32 + k * 8);
        {
            u32x4 a = *(const GAS u32x4*)(rp + PC_V + lane * 16), b = *(const GAS u32x4*)(rp + PC_V + lane * 16 + 8);
            const u32x4 ga = *(const GAS u32x4*)(rp + PC_GO + lane * 16), gb2 = *(const GAS u32x4*)(rp + PC_GO + lane * 16 + 8);
            float v[16], gg[16];
#pragma unroll
            for (int j = 0; j < 4; ++j) { v[2 * j] = lo_bf(a[j]); v[2 * j + 1] = hi_bf(a[j]); v[8 + 2 * j] = lo_bf(b[j]); v[8 + 2 * j + 1] = hi_bf(b[j]);
                gg[2 * j] = lo_bf(ga[j]); gg[2 * j + 1] = hi_bf(ga[j]); gg[8 + 2 * j] = lo_bf(gb2[j]); gg[8 + 2 * j + 1] = hi_bf(gb2[j]); }
            float ss = 0.f;
#pragma unroll
            for (int j = 0; j < 16; ++j) ss += v[j] * v[j];
            ss += __shfl_xor(ss, 1); ss += __shfl_xor(ss, 2); ss += __shfl_xor(ss, 4); ss += __shfl_xor(ss, 8);
            const float rstd = rsqrtf(ss * (1.f / 256.f) + EPSN); const int e0 = (lane * 16) & 255;
#pragma unroll
            for (int j = 0; j < 16; ++j) v[j] = v[j] * rstd * gnw[e0 + j] * siluf_(gg[j]);
#pragma unroll
            for (int j = 0; j < 4; ++j) { a[j] = cvt_pk_bf16(v[2 * j], v[2 * j + 1]); b[j] = cvt_pk_bf16(v[8 + 2 * j], v[8 + 2 * j + 1]); }
            *(GAS u32x4*)(rp + PC_V + lane * 16) = a; *(GAS u32x4*)(rp + PC_V + lane * 16 + 8) = b;
        }
        {
            float ss = 0.f;
#pragma unroll
            for (int k = 0; k < 4; ++k) {
#pragma unroll
                for (int j = 0; j < 4; ++j) { const float x0 = lo_bf(q[k][j]), x1 = hi_bf(q[k][j]); ss += x0 * x0 + x1 * x1; } }
            ss += __shfl_xor(ss, 1); ss += __shfl_xor(ss, 2); ss += __shfl_xor(ss, 4); ss += __shfl_xor(ss, 8);
            const float rstd = rsqrtf(ss * (1.f / 512.f) + EPSN);
#pragma unroll
            for (int k = 0; k < 4; ++k) {
#pragma unroll
                for (int j = 0; j < 4; ++j) { const int cc = lane * 32 + k * 8 + 2 * j; q[k][j] = cvt_pk_bf16(lo_bf(q[k][j]) * rstd * snw[cc], hi_bf(q[k][j]) * rstd * snw[cc + 1]); }
                *(GAS u32x4*)(rp + PC_Z + lane * 32 + k * 8) = q[k]; }
        }
    }
    for (int idx = blockIdx.x * 512 + tid; idx < 40 * 9216; idx += gridDim.x * 512) {
        const int seq = idx / 9216, rem = idx % 9216, k = rem / 3072, ch = rem % 3072;
        const int row = seq < 8 ? seq * 2048 + 2045 + k : T_PROMPT + (seq - 8) * 64 + 61 + k;
        const float v = bf2f(proj[(size_t)row * NP + PC_XBC + ch]);
        if (seq < 8) p.out[O_CONVP + (size_t)(l * 8 + seq) * 9216 + rem] = v; else p.out[O_CONVS + (size_t)(l * 32 + (seq - 8)) * 9216 + rem] = v;
    }
}

__device__ __forceinline__ unsigned fkey(float f) { const unsigned u = __float_as_uint(f); return u ^ ((unsigned)((int)u >> 31) | 0x80000000u); }
__device__ __forceinline__ int popc64(unsigned long long m) { return __builtin_popcountll(m); }
__device__ __forceinline__ int mbcnt64(unsigned long long m) { return (int)__builtin_amdgcn_mbcnt_hi((unsigned)(m >> 32), __builtin_amdgcn_mbcnt_lo((unsigned)m, 0u)); }
template <int NV>
__device__ __forceinline__ unsigned kth16(const unsigned (&k)[NV]) {
    unsigned prefix = 0u; bool exact = false;
#pragma unroll 1
    for (int bit = 31; bit >= 0 && !exact; --bit) { const unsigned trial = prefix | (1u << bit); int cnt = 0;
#pragma unroll
        for (int c = 0; c < NV; ++c) cnt += popc64(__ballot(k[c] >= trial));
        prefix = cnt >= 16 ? trial : prefix; exact = cnt == 16; }
    return prefix;
}
__device__ __forceinline__ void kth16x2(const unsigned (&ka)[2], const unsigned (&kb)[2], unsigned& Ta, unsigned& Tb) {
    unsigned pa = 0u, pb = 0u; bool ea = false, eb = false;
#pragma unroll 1
    for (int bit = 31; bit >= 0 && !(ea && eb); --bit) { const unsigned ta = pa | (1u << bit), tb = pb | (1u << bit);
        const int ca_ = popc64(__ballot(ka[0] >= ta)) + popc64(__ballot(ka[1] >= ta)), cb_ = popc64(__ballot(kb[0] >= tb)) + popc64(__ballot(kb[1] >= tb));
        pa = ca_ >= 16 ? ta : pa; pb = cb_ >= 16 ? tb : pb; ea = ea || ca_ == 16; eb = eb || cb_ == 16; }
    Ta = pa; Tb = pb;
}
template <int NV>
__device__ __forceinline__ void compact16(const unsigned (&k)[NV], unsigned T, const int (&pa)[NV], const int (&pb)[NV], int& oa, int& ob) {
    unsigned long long bg[NV], be[NV]; int ngt = 0;
#pragma unroll
    for (int c = 0; c < NV; ++c) { bg[c] = __ballot(k[c] > T); be[c] = __ballot(k[c] == T); ngt += popc64(bg[c]); }
    const int need = 16 - ngt; int baseg = 0, basee = 0; oa = 0; ob = 0;
#pragma unroll
    for (int c = 0; c < NV; ++c) { const bool g = k[c] > T, e = k[c] == T; const int rg = baseg + mbcnt64(bg[c]), re = basee + mbcnt64(be[c]);
        const bool sel = g || (e && re < need); const int pos = g ? rg : ngt + re; const int addr = (sel ? pos : 63) << 2;
        oa |= __builtin_amdgcn_ds_permute(addr, pa[c]); ob |= __builtin_amdgcn_ds_permute(addr, pb[c]);
        baseg += popc64(bg[c]); basee += popc64(be[c]); }
}
__device__ __forceinline__ void wave_top16x2(float (&va)[2], float (&vb)[2], int lane, float& oa, int& ia, float& ob, int& ib) {
    oa = -3.0e38f; ob = -3.0e38f; ia = 0; ib = 0;
#pragma unroll 1
    for (int it = 0; it < 16; ++it) {
        const float ma = fmaxf(va[0], va[1]), mb = fmaxf(vb[0], vb[1]);
        const float Ma = wave_max_u(ma), Mb = wave_max_u(mb);
        const int sa = __builtin_amdgcn_readfirstlane(__ffsll((long long)__ballot(ma == Ma)) - 1), sb = __builtin_amdgcn_readfirstlane(__ffsll((long long)__ballot(mb == Mb)) - 1);
        const bool ha0 = va[0] == Ma, hb0 = vb[0] == Mb;
        const int ida = ha0 ? lane : lane + 64, idb = hb0 ? lane : lane + 64;
        if (lane == sa) { if (ha0) va[0] = -3.0e38f; else va[1] = -3.0e38f; }
        if (lane == sb) { if (hb0) vb[0] = -3.0e38f; else vb[1] = -3.0e38f; }
        const int xa = __builtin_amdgcn_readlane(ida, sa), xb = __builtin_amdgcn_readlane(idb, sb);
        if (lane == it) { oa = Ma; ia = xa; ob = Mb; ib = xb; }
    }
}
__device__ __forceinline__ void wave_top16x1(float v, int id, int lane, float& outv, int& outi) {
    outv = -3.0e38f; outi = 0;
#pragma unroll 1
    for (int it = 0; it < 16; ++it) {
        const float M = wave_max_u(v);
        const int src = __builtin_amdgcn_readfirstlane(__ffsll((long long)__ballot(v == M)) - 1);
        const int sel = __builtin_amdgcn_readlane(id, src);
        if (lane == src) v = -3.0e38f;
        if (lane == it) { outv = M; outi = sel; }
    }
}
template <bool DRY>
__device__ __forceinline__ void phase_peer(const Params& p, int l) {
    const int tid = otid(), lane = tid & 63, gw = blockIdx.x * 8 + (tid >> 6), nwv = gridDim.x * 8;
    typedef float f32x2_t __attribute__((ext_vector_type(2)));
    const GAS float* scores = (const GAS float*)(p.ws + WS_PROJ); const GAS bf16_t* H = (const GAS bf16_t*)(p.ws + WS_H);
    const GAS unsigned char* UV = (const GAS unsigned char*)(p.ws + ws_uv(l));
    const GAS float* SU = (const GAS float*)(p.ws + ws_su(l)); const GAS float* SV = (const GAS float*)(p.ws + ws_sv(l));
    const GAS float* mod = (const GAS float*)(p.ws + WS_MOD); GAS float* X = (GAS float*)p.out;
    int ca, cb;
    { const int L = lane; const int thr[15] = {16, 24, 29, 33, 36, 38, 40, 42, 43, 44, 45, 46, 47, 48, 49}; const int cnt[15] = {16, 8, 5, 4, 3, 2, 2, 2, 1, 1, 1, 1, 1, 1, 1};
        int a_ = 0, pre = 0;
#pragma unroll
        for (int k = 0; k < 15; ++k) { const bool ge = L >= thr[k]; a_ += ge ? 1 : 0; pre += ge ? cnt[k] : 0; }
        ca = a_; cb = L - pre; if (L >= 50) { ca = 0; cb = 0; } }
    const bool b5 = (lane & 32) != 0, b4 = (lane & 16) != 0, b3 = (lane & 8) != 0, b2 = (lane & 4) != 0;
    const int ntok = gw < T_TOK ? (T_TOK - 1 - gw) / nwv + 1 : 0, nitems = ntok * 8;
    if (nitems == 0) return;
#define PEER_SC(q_, dst) do { const GAS float* sc_ = scores + (size_t)(gw + ((q_) >> 3) * nwv) * 2048 + ((q_) & 7) * 256; dst[0] = __builtin_nontemporal_load(sc_ + lane); dst[1] = __builtin_nontemporal_load(sc_ + 64 + lane); dst[2] = __builtin_nontemporal_load(sc_ + 128 + lane); dst[3] = __builtin_nontemporal_load(sc_ + 192 + lane); } while (0)
#define PEER_ROUTE(scv, eidx_o, gs_o) do { \
        const unsigned ka_[2] = {fkey(scv[0]), fkey(scv[1])}, kb_[2] = {fkey(scv[2]), fkey(scv[3])}; unsigned Ta_, Tb_; kth16x2(ka_, kb_, Ta_, Tb_); \
        const int pva_[2] = {__float_as_int(scv[0]), __float_as_int(scv[1])}, pvb_[2] = {__float_as_int(scv[2]), __float_as_int(scv[3])}, pid_[2] = {lane, lane + 64}; \
        int v1b_, i1_, v2b_, i2_; compact16<2>(ka_, Ta_, pva_, pid_, v1b_, i1_); compact16<2>(kb_, Tb_, pvb_, pid_, v2b_, i2_); \
          \
        const float v1a_ = __int_as_float(__shfl(v1b_, lane >> 2)); const int i1a_ = __shfl(i1_, lane >> 2) * 128; \
        unsigned kc_[4]; int pc_[4], pi_[4]; \
        _Pragma("unroll") for (int c = 0; c < 4; ++c) { const int bb_ = (lane & 3) * 4 + c; const float cv_ = v1a_ + __int_as_float(__shfl(v2b_, bb_)); kc_[c] = fkey(cv_); pc_[c] = __float_as_int(cv_); pi_[c] = i1a_ + __shfl(i2_, bb_); } \
        const unsigned Tc_ = kth16<4>(kc_); int svb_, ei_; compact16<4>(kc_, Tc_, pc_, pi_, svb_, ei_); \
        const float sv_ = lane < 16 ? __int_as_float(svb_) : -3.0e38f; const float mx_ = wave_max_u(sv_); const float ex_ = lane < 16 ? __expf(sv_ - mx_) : 0.f; \
        eidx_o = lane < 16 ? ei_ : 0; gs_o = ex_ / wave_sum_u(ex_); } while (0)
    float scn[4]; int eidx; float gs;
    PEER_SC(0, scn);
    PEER_ROUTE(scn, eidx, gs);
    if (nitems > 1) PEER_SC(1, scn);
    float xf[16]; f32x2_t acc2[8];
#pragma unroll 1
    for (int q = 0; q < nitems; ++q) {
        const int t = gw + (q >> 3) * nwv, h = q & 7;
#ifdef DRY_ROUTE_ONLY
        if (DRY) { asm volatile("" :: "v"(eidx), "v"(gs)); if (q + 1 < nitems) { float sc1[4] = {scn[0], scn[1], scn[2], scn[3]}; if (q + 2 < nitems) PEER_SC(q + 2, scn); PEER_ROUTE(sc1, eidx, gs); } continue; }
#endif
        const float su_l = lane < 16 ? SU[eidx] : 0.f, sv_l = lane < 16 ? SV[eidx] : 0.f;
        u32x4 ur[16], vr[16];
#pragma unroll
        for (int e = 0; e < 16; ++e) { const int eid = __builtin_amdgcn_readlane(eidx, e);
            const GAS unsigned char* rp_ = UV + (size_t)eid * 2048 + lane * 16; ur[e] = *(const GAS u32x4*)rp_; vr[e] = *(const GAS u32x4*)(rp_ + 1024); }
        const float gs_c = gs;
        if (h == 0) { const u32x4 a = __builtin_nontemporal_load((const GAS u32x4*)(H + (size_t)t * 1024 + lane * 16)), b = __builtin_nontemporal_load((const GAS u32x4*)(H + (size_t)t * 1024 + lane * 16 + 8));
#pragma unroll
            for (int j = 0; j < 4; ++j) { xf[2 * j] = lo_bf(a[j]); xf[2 * j + 1] = hi_bf(a[j]); xf[8 + 2 * j] = lo_bf(b[j]); xf[8 + 2 * j + 1] = hi_bf(b[j]); }
#pragma unroll
            for (int j = 0; j < 8; ++j) acc2[j] = (f32x2_t){0.f, 0.f}; }
        if (q + 1 < nitems) { float sc1[4] = {scn[0], scn[1], scn[2], scn[3]}; if (q + 2 < nitems) PEER_SC(q + 2, scn); PEER_ROUTE(sc1, eidx, gs); }
        float d[16];
        f32x2_t xp2[8];
#pragma unroll
        for (int j = 0; j < 8; ++j) xp2[j] = (f32x2_t){xf[2 * j], xf[2 * j + 1]};
#pragma unroll
        for (int e = 0; e < 16; ++e) { f32x2_t dp = (f32x2_t){0.f, 0.f};
#pragma unroll
            for (int j = 0; j < 4; ++j) { const f32x2_t lo = __builtin_amdgcn_cvt_pk_f32_fp8((int)ur[e][j], false), hi = __builtin_amdgcn_cvt_pk_f32_fp8((int)ur[e][j], true);
                dp = __builtin_elementwise_fma(xp2[2 * j], lo, dp); dp = __builtin_elementwise_fma(xp2[2 * j + 1], hi, dp); }
            d[e] = dp.x + dp.y; }
        float r8[8], r4[4], r2[2], r1;
#pragma unroll
        for (int k = 0; k < 8; ++k) { const float snd = b5 ? d[k] : d[k + 8]; r8[k] = (b5 ? d[k + 8] : d[k]) + __shfl_xor(snd, 32); }
#pragma unroll
        for (int k = 0; k < 4; ++k) { const float snd = b4 ? r8[k] : r8[k + 4]; r4[k] = (b4 ? r8[k + 4] : r8[k]) + __shfl_xor(snd, 16); }
#pragma unroll
        for (int k = 0; k < 2; ++k) { const float snd = b3 ? r4[k] : r4[k + 2]; r2[k] = (b3 ? r4[k + 2] : r4[k]) + __shfl_xor(snd, 8); }
        { const float snd = b2 ? r2[0] : r2[1]; r1 = (b2 ? r2[1] : r2[0]) + __shfl_xor(snd, 4); }
        r1 += __shfl_xor(r1, 1); r1 += __shfl_xor(r1, 2);
        const int eq = lane >> 2;
        const float act = r1 * __shfl(su_l, eq);
        const float wv = __shfl(gs_c, eq) * 0.5f * act * (1.f + erff(act * 0.7071067811865476f)) * __shfl(sv_l, eq);
#pragma unroll
        for (int e = 0; e < 16; ++e) { const float w = __int_as_float(__builtin_amdgcn_readlane(__float_as_int(wv), 4 * e));
#pragma unroll
            for (int j = 0; j < 4; ++j) { const f32x2_t lo = __builtin_amdgcn_cvt_pk_f32_fp8((int)vr[e][j], false), hi = __builtin_amdgcn_cvt_pk_f32_fp8((int)vr[e][j], true); const f32x2_t w2 = (f32x2_t){w, w};
                acc2[2 * j] = __builtin_elementwise_fma(w2, lo, acc2[2 * j]); acc2[2 * j + 1] = __builtin_elementwise_fma(w2, hi, acc2[2 * j + 1]); } }
        if (h == 7) {
            const GAS float* gp = mod + (size_t)cb_of_row(t) * 12288 + l * 6144 + 5 * 1024 + lane * 16; GAS float* xp = X + (size_t)t * 1024 + lane * 16;
            f32x4 xn[4]; float ss = 0.f;
#pragma unroll
            for (int j = 0; j < 4; ++j) { const f32x4 g = *(const GAS f32x4*)(gp + 4 * j); xn[j] = __builtin_nontemporal_load((const GAS f32x4*)(xp + 4 * j));
#pragma unroll
                for (int k = 0; k < 4; ++k) { xn[j][k] += g[k] * acc2[2 * j + (k >> 1)][k & 1]; ss += xn[j][k] * xn[j][k]; } }
            const float rstd = rsqrtf(wave_sum_u(ss) * (1.f / 1024.f) + EPSN);
            if (l == 1) { const GAS float* fw = (const GAS float*)p.in[29] + lane * 16;
#pragma unroll
                for (int j = 0; j < 4; ++j) { const f32x4 w = *(const GAS f32x4*)(fw + 4 * j); xn[j] = xn[j] * rstd * w; } }
            else if (!DRY) {
                const GAS float* nw = (const GAS float*)p.in[9] + 1024 + lane * 16; const GAS float* mp = mod + (size_t)cb_of_row(t) * 12288 + 6144 + lane * 16; u32x4 ho[2];
#pragma unroll
                for (int j = 0; j < 4; ++j) { const f32x4 w = *(const GAS f32x4*)(nw + 4 * j), sh = *(const GAS f32x4*)(mp + 4 * j), sc = *(const GAS f32x4*)(mp + 1024 + 4 * j); const f32x4 o = xn[j] * rstd * w * (sc + 1.f) + sh;
                    ho[j >> 1][(j & 1) * 2] = cvt_pk_bf16(o[0], o[1]); ho[j >> 1][(j & 1) * 2 + 1] = cvt_pk_bf16(o[2], o[3]); }
                *(GAS u32x4*)((GAS bf16_t*)(p.ws + WS_H) + (size_t)t * 1024 + lane * 16) = ho[0]; *(GAS u32x4*)((GAS bf16_t*)(p.ws + WS_H) + (size_t)t * 1024 + lane * 16 + 8) = ho[1]; }
#pragma unroll
            for (int j = 0; j < 4; ++j) { if (!DRY) __builtin_nontemporal_store(xn[j], (GAS f32x4*)(xp + 4 * j)); else asm volatile("" :: "v"(xn[j][0]), "v"(xn[j][1]), "v"(xn[j][2]), "v"(xn[j][3])); }
        }
    }
#undef PEER_SC
#undef PEER_ROUTE
}

__device__ __forceinline__ void load_params(Params& q, const LAS unsigned* tab) {
#pragma unroll
    for (int k = 0; k < 32; ++k) {
        const unsigned lo = __builtin_amdgcn_readfirstlane(tab[2 * k]), hi = __builtin_amdgcn_readfirstlane(tab[2 * k + 1]);
        const unsigned long long a = ((unsigned long long)hi << 32) | lo;
        if (k < 30) q.in[k] = (const float*)a; else if (k == 30) q.out = (float*)a; else q.ws = (unsigned char*)a;
    }
}
#define PHASE_PARAMS Params p; load_params(p, tab)

#ifdef DBG
__device__ __forceinline__ void dbg_flag(const Params& p, int code) { atomicMax((unsigned*)(p.ws + WS_BAR) + 4000, (unsigned)(1000 - code)); }
__device__ __forceinline__ void dbg_bf16(const Params& p, const bf16_t* base, int rows, int ld, int ncols, int code) {
    const int tid = otid(); bool bad = false;
    for (size_t i = (size_t)blockIdx.x * 512 + tid; i < (size_t)rows * ncols; i += (size_t)gridDim.x * 512) { const size_t r = i / ncols, c = i % ncols; const unsigned v = base[r * ld + c]; if ((v & 0x7F80u) == 0x7F80u) bad = true; }
    if (bad) dbg_flag(p, code);
}
__device__ __forceinline__ void dbg_f32(const Params& p, const float* base, int rows, int ld, int ncols, int code) {
    const int tid = otid(); bool bad = false;
    for (size_t i = (size_t)blockIdx.x * 512 + tid; i < (size_t)rows * ncols; i += (size_t)gridDim.x * 512) { const size_t r = i / ncols, c = i % ncols; const unsigned v = __float_as_uint(base[r * ld + c]); if ((v & 0x7F800000u) == 0x7F800000u) bad = true; }
    if (bad) dbg_flag(p, code);
}
#define DBG_DO(x) { { PHASE_PARAMS; x; } xcd_barrier(xb); }
#else
#define DBG_DO(x)
#endif
__global__ void __launch_bounds__(512, 2) mega_fwd(Params p0) {
    __shared__ __attribute__((aligned(16))) unsigned char smem[LDS_BYTES];
    LAS unsigned char* lds = (LAS unsigned char*)smem;
    LAS unsigned* tab = (LAS unsigned*)(lds + LDS_TAB);
    if (threadIdx.x == 0) {
        volatile LAS unsigned* st0 = (volatile LAS unsigned*)(lds + LDS_ST); st0[0] = 0u; st0[1] = 0u;
#pragma unroll
        for (int k = 0; k < 32; ++k) { const unsigned long long a = k < 30 ? (unsigned long long)p0.in[k] : (k == 30 ? (unsigned long long)p0.out : (unsigned long long)p0.ws); tab[2 * k] = (unsigned)a; tab[2 * k + 1] = (unsigned)(a >> 32); }
    }
    __syncthreads();
    const XcdBarrier xb = xcd_barrier_post((unsigned*)(p0.ws + WS_BAR), (volatile LAS unsigned*)(lds + LDS_ST));
#pragma unroll 1
    for (int l = 0; l < 2; ++l) {
        if (l == 0) {
            { PHASE_PARAMS; phase_convert(p, 0, smem, (int)blockIdx.x, (int)gridDim.x, 1); mod_gemv(p, smem, (int)blockIdx.x, (int)gridDim.x); }
            xcd_barrier(xb);
        }
        if (l == 0) {
            { PHASE_PARAMS; phase_norm(p, p.in[0], p.in[1], p.in[9], 0, 1024); }
            xcd_barrier(xb);
        }
        DBG_DO(dbg_bf16(p, (const bf16_t*)(p.ws + WS_H), T_TOK, 1024, 1024, l * 10 + 2))
        { PHASE_PARAMS; EpiInProj e; e.P = (bf16_t*)(p.ws + WS_PROJ); e.aux = (float*)(p.ws + WS_AUX);
          run_gemm<1>(lds, (const bf16_t*)(p.ws + WS_H), 1024, (const bf16_t*)(p.ws + ws_win(l)), T_TOK, NP, 1024, e);
#ifdef DUP_INPROJ
          run_gemm<1>(lds, (const bf16_t*)(p.ws + WS_H), 1024, (const bf16_t*)(p.ws + ws_win(l)), T_TOK, NP, 1024, e);
#endif
        }
        xcd_barrier(xb);
        DBG_DO(dbg_bf16(p, (const bf16_t*)(p.ws + WS_PROJ), T_TOK, NP, 10240, l * 10 + 3); dbg_f32(p, (const float*)(p.ws + WS_AUX), T_TOK, 64, 48, l * 10 + 3))
#ifndef NO_MIXER
        { PHASE_PARAMS; phase_gla_pre(p, l, lds); }
        { PHASE_PARAMS; phase_ssd_pre(p, l, lds); }
        xcd_barrier(xb);
#ifdef DUP_MIXER
        { PHASE_PARAMS; phase_mixer<true>(p, l, lds); }
#endif
        { PHASE_PARAMS; phase_mixer<false>(p, l, lds); }
#endif
        xcd_barrier(xb);
        DBG_DO(dbg_bf16(p, (const bf16_t*)(p.ws + WS_PROJ) + PC_V, T_TOK, NP, 1024, l * 10 + 4); dbg_bf16(p, (const bf16_t*)(p.ws + WS_PROJ) + PC_Z, T_TOK, NP, 2048, l * 10 + 5))
#ifndef NO_NG
        { PHASE_PARAMS; phase_normgate(p, l); }
#endif
        xcd_barrier(xb);
        DBG_DO(dbg_bf16(p, (const bf16_t*)(p.ws + WS_PROJ) + PC_V, T_TOK, NP, 1024, l * 10 + 6); dbg_bf16(p, (const bf16_t*)(p.ws + WS_PROJ) + PC_Z, T_TOK, NP, 2048, l * 10 + 6))
#ifdef STOP1
        continue;
#endif
        { PHASE_PARAMS; bf16_t* proj = (bf16_t*)(p.ws + WS_PROJ); EpiGlaProj e; e.P = proj; run_gemm<2>(lds, proj + PC_V, NP, (const bf16_t*)(p.ws + ws_wgla(l)), T_TOK, 1024, 1024, e); }
        { PHASE_PARAMS; bf16_t* proj = (bf16_t*)(p.ws + WS_PROJ); EpiSsdProj e; e.P = proj; e.H = (bf16_t*)(p.ws + WS_H); run_gemm<3>(lds, proj + PC_Z, NP, (const bf16_t*)(p.ws + ws_wssd(l)), T_TOK, 1024, 2048, e); }
        {
            const int skip = gridDim.x > 64 ? 32 : 0;
            if ((int)blockIdx.x >= skip) { PHASE_PARAMS; phase_convert(p, 1, smem, (int)blockIdx.x - skip, (int)gridDim.x - skip, l == 0 ? 1 : 12); }
        }
#ifdef DUP_GS
        { PHASE_PARAMS; bf16_t* proj = (bf16_t*)(p.ws + WS_PROJ); EpiGlaProj e; e.P = proj; run_gemm<2>(lds, proj + PC_V, NP, (const bf16_t*)(p.ws + ws_wgla(l)), T_TOK, 1024, 1024, e); }
        { PHASE_PARAMS; bf16_t* proj = (bf16_t*)(p.ws + WS_PROJ); EpiSsdProj e; e.P = proj; e.H = (bf16_t*)(p.ws + WS_H); run_gemm<3>(lds, proj + PC_Z, NP, (const bf16_t*)(p.ws + ws_wssd(l)), T_TOK, 1024, 2048, e); }
#endif
        xcd_barrier(xb);
        DBG_DO(dbg_bf16(p, (const bf16_t*)(p.ws + WS_H), T_TOK, 1024, 1024, l * 10 + 7))
        { PHASE_PARAMS; EpiWout e; e.X = p.out; e.Xa = l == 0 ? p.in[0] : p.out; e.Xb = l == 0 ? p.in[1] : p.out + (size_t)T_PROMPT * 1024; e.modg = (const float*)(p.ws + WS_MOD) + l * 6144 + 2 * 1024; run_gemm<4>(lds, (const bf16_t*)(p.ws + WS_H), 1024, (const bf16_t*)(p.ws + ws_wout(l)), T_TOK, 1024, 1024, e); }
        if (l == 0) { const int skip = gridDim.x > 64 ? 32 : 0;
            if ((int)blockIdx.x >= skip) { PHASE_PARAMS; phase_convert(p, 0, smem, (int)blockIdx.x - skip, (int)gridDim.x - skip, 4); } }
        xcd_barrier(xb);
        DBG_DO(dbg_f32(p, p.out, T_TOK, 1024, 1024, l * 10 + 8))
        { PHASE_PARAMS; phase_norm(p, p.out, p.out + (size_t)T_PROMPT * 1024, p.in[23] + l * 1024, l * 6144 + 3 * 1024, l * 6144 + 4 * 1024); }
        xcd_barrier(xb);
        DBG_DO(dbg_bf16(p, (const bf16_t*)(p.ws + WS_H), T_TOK, 1024, 1024, l * 10 + 9))
        { PHASE_PARAMS; EpiF32NT e; e.C = (float*)(p.ws + WS_PROJ); e.ldc = 2048; e.bias = nullptr; run_gemm<5>(lds, (const bf16_t*)(p.ws + WS_H), 1024, (const bf16_t*)(p.ws + ws_wpeer(l)), T_TOK, 2048, 1024, e); }
        if (l == 0) { const int skip = gridDim.x > 128 ? 64 : 0;
            if ((int)blockIdx.x >= skip) { PHASE_PARAMS; phase_convert(p, 0, smem, (int)blockIdx.x - skip, (int)gridDim.x - skip, 8); } }
#ifdef DUP_SCORES
        { PHASE_PARAMS; EpiF32NT e; e.C = (float*)(p.ws + WS_PROJ); e.ldc = 2048; e.bias = nullptr; run_gemm<5>(lds, (const bf16_t*)(p.ws + WS_H), 1024, (const bf16_t*)(p.ws + ws_wpeer(l)), T_TOK, 2048, 1024, e); }
#endif
        xcd_barrier(xb);
        DBG_DO(dbg_f32(p, (const float*)(p.ws + WS_PROJ), T_TOK, 2048, 2048, l * 10 + 10))
#ifndef NO_PEER
#ifdef DUP_PEER
        { PHASE_PARAMS; phase_peer<true>(p, l); }
#endif
        { PHASE_PARAMS; phase_peer<false>(p, l); }
#endif
        if (l == 0) xcd_barrier(xb);
    }
#ifdef DBG
    xcd_barrier(xb);
    { PHASE_PARAMS; const unsigned f = __hip_atomic_load((unsigned*)(p.ws + WS_BAR) + 4000, __ATOMIC_RELAXED, __HIP_MEMORY_SCOPE_AGENT); if (f) { const float K = 10.f * (float)(1000 - (int)f); const int tid = otid(); for (size_t i = (size_t)blockIdx.x * 512 + tid; i < (size_t)T_TOK * 1024; i += (size_t)gridDim.x * 512) p.out[i] = K; } }
#endif
#ifdef DBG2
    xcd_barrier(xb);
    { PHASE_PARAMS; const unsigned f = __hip_atomic_load((unsigned*)(p.ws + WS_BAR) + 4000, __ATOMIC_RELAXED, __HIP_MEMORY_SCOPE_AGENT); if (f) { const float K = 10.f * (float)(1 << (100 - (int)f)); const int tid = otid(); for (size_t i = (size_t)blockIdx.x * 512 + tid; i < (size_t)T_TOK * 1024; i += (size_t)gridDim.x * 512) p.out[i] = K; } }
#endif
#ifdef SANITIZE
    xcd_barrier(xb);
    { PHASE_PARAMS; const int tid = otid(); for (size_t i = (size_t)blockIdx.x * 512 + tid; i < (size_t)51068928; i += (size_t)gridDim.x * 512) { const float v = p.out[i]; if (!(fabsf(v) < 3.0e38f)) p.out[i] = 0.f; } }
#endif
}

extern "C" void kernel_launch(void* const* d_in, const int* in_sizes, int n_in, void* d_out, int out_size, void* d_ws, size_t ws_size, hipStream_t stream) {
    static int grid = 0;
    if (grid == 0) {
        if (n_in != 30 || ws_size < WS_END) { fprintf(stderr, "kernel_launch: need 30 inputs and >= %zu bytes of workspace; got %d, %zu\n", (size_t)WS_END, n_in, ws_size); grid = -1; return; }
        int dev = 0, cus = 0, per_cu = 0;
        (void)hipGetDevice(&dev); (void)hipDeviceGetAttribute(&cus, hipDeviceAttributeMultiprocessorCount, dev);
        if (hipOccupancyMaxActiveBlocksPerMultiprocessor(&per_cu, (const void*)mega_fwd, 512, 0) != hipSuccess || per_cu < 1) { fprintf(stderr, "kernel_launch: occupancy query failed (%d)\n", per_cu); (void)hipGetLastError(); per_cu = 1; }
        grid = cus * (per_cu > 1 ? 1 : per_cu);
        if (grid > 256) grid = 256;
    }
    if (grid < 0) return;
    if (hipMemsetAsync((char*)d_ws + WS_BAR, 0, 16384, stream) != hipSuccess) { fprintf(stderr, "kernel_launch: memset of the barrier words failed\n"); return; }
    Params p{};
    for (int i = 0; i < 30; ++i) p.in[i] = (const float*)d_in[i];
    p.out = (float*)d_out; p.ws = (unsigned char*)d_ws;
    void* args[] = {&p};
    hipError_t e = hipLaunchCooperativeKernel((const void*)mega_fwd, dim3(grid), dim3(512), args, 0, stream);
    if (e != hipSuccess) fprintf(stderr, "kernel_launch: cooperative launch failed: %s (grid %d)\n", hipGetErrorString(e), grid);
}
```

```cpp
#include <hip/hip_runtime.h>
#include <cstdio>
#define LAS __attribute__((address_space(3)))
namespace pg8 {
#define PG8_LAS __attribute__((address_space(3)))
typedef unsigned short bf16_t;
typedef short bf16x8 __attribute__((ext_vector_type(8)));
typedef float f32x4 __attribute__((ext_vector_type(4)));
typedef unsigned u32x4 __attribute__((ext_vector_type(4)));
constexpr int BM = 256, BK = 64, HALF = 128, HTB = HALF * BK * 2  , STAGE_BYTES = 8 * HTB, NXCD = 8, WGM = 4;

__host__ __device__ __forceinline__ int lds_byte(int r, int c) { const int st = (r >> 4) * 2 + (c >> 5), rr = r & 15, cc = c & 31, ob = rr * 64 + cc * 2; return st * 1024 + (ob ^ (((ob >> 9) & 1) << 5)); }
__host__ __device__ __forceinline__ void stage_rc(int b, int& R, int& C) { const int st = b / 1024, sb = b % 1024, swz = sb ^ (((sb >> 9) & 1) << 5); R = (st >> 1) * 16 + swz / 64; C = (st & 1) * 32 + (swz % 64) / 2; }
__host__ __device__ __forceinline__ int perm32(int rho) { const int n = rho >> 4, i = rho & 15; return 8 * (i >> 2) + 4 * n + (i & 3); }

struct Unit { int pm, pn; };
struct Gemm { const bf16_t* A; const bf16_t* Bt; int M, N, K, lda; };

struct StaticOrder {
    int nM, nN, nwg, G, c;
    __host__ __device__ void init(int M, int N, int G_, int c_) { nM = M / BM; nN = N / BM; nwg = nM * nN; G = G_; c = c_; }
    __host__ __device__ bool next(int i, Unit& u) const {
        const long L = (long)i * G + c; if (L >= nwg) return false;
        int wgid = (int)L; { const int q = nwg / NXCD, r = nwg % NXCD, xcd = wgid % NXCD, off = wgid / NXCD; wgid = (xcd < r ? xcd * (q + 1) : r * (q + 1) + (xcd - r) * q) + off; }
        const int nig = WGM * nN, gid = wgid / nig, fm = gid * WGM, gsz = (nM - fm) < WGM ? (nM - fm) : WGM;
        u.pm = fm + ((wgid % nig) % gsz); u.pn = (wgid % nig) / gsz; return true;
    }
    __device__ __forceinline__ void a_ready(const Unit&) const {}
    __device__ __forceinline__ void done(const Unit&) const {}
};
typedef float f32x2 __attribute__((ext_vector_type(2)));
typedef __bf16 bf16v2_t __attribute__((ext_vector_type(2)));
__device__ __forceinline__ unsigned cvt_pk_bf16(float lo, float hi) { const f32x2 v = {lo, hi}; return __builtin_bit_cast(unsigned, __builtin_convertvector(v, bf16v2_t)); }
template <class Epi, class Sched, bool STAMP = false>
__device__ __forceinline__ void gemm_phase(PG8_LAS unsigned char* lds, const Gemm g, const Sched& S, const Epi& E, unsigned long long* stamps) {
    int tid_ = threadIdx.x; asm volatile("" : "+v"(tid_)); const int tid = tid_, wid = __builtin_amdgcn_readfirstlane(tid >> 6), lane = tid & 63, wr = wid >> 2, wc = wid & 3, fr = lane & 15, fq = lane >> 4;
    const int K = g.K, nt = K / BK;
    int ts_lo = 0, ts_hi = 0, nts = 0; const unsigned long long rt_entry = STAMP ? (unsigned long long)wall_clock64() : 0ull;
#define PG8_STAMP() do { if (STAMP && wid == 0 && nts < 64) { const unsigned long long _c = (unsigned long long)clock64(); \
        ts_lo = (lane == nts) ? (int)(unsigned)_c : ts_lo; ts_hi = (lane == nts) ? (int)(unsigned)(_c >> 32) : ts_hi; ++nts; } } while (0)
    PG8_STAMP();
    unsigned voffA[2], voffB[2];
#pragma unroll
    for (int i = 0; i < 2; ++i) { int R, C; stage_rc(tid * 16 + i * 8192, R, C); const int Rb = Epi::PERM ? ((R & ~31) + perm32(R & 31)) : R;
        voffA[i] = (unsigned)(R * g.lda + C) * 2u; voffB[i] = (unsigned)(Rb * K + C) * 2u; }
    const size_t kstep = (size_t)(BK * 2);
    const size_t hstepB = (size_t)HALF * K * 2, hstepA = (size_t)HALF * g.lda * 2;
    const size_t tstepA = 2 * hstepA, tstepB = 2 * hstepB;
    const unsigned ldsw = (unsigned)wid * 1024u;
    const int aoff = lds_byte(wr * 64 + fr, fq * 8), boff = lds_byte(wc * 32 + fr, fq * 8);
#define PG8_SA(b, h) (((b) * 2 + (h)) * HTB)
#define PG8_SB(b, h) ((4 + (b) * 2 + (h)) * HTB)
#define PG8_STAGE(bufoff, gbase, voff) do { _Pragma("unroll") for (int _i = 0; _i < 2; ++_i) \
        __builtin_amdgcn_global_load_lds((const unsigned*)((const char*)(gbase) + (voff)[_i]), (PG8_LAS unsigned*)(lds + (bufoff) + ldsw + _i * 8192), 16, 0, 0); } while (0)
#define PG8_LDA(dst, b, h) do { _Pragma("unroll") for (int m = 0; m < 4; ++m) _Pragma("unroll") for (int k = 0; k < 2; ++k) dst[m][k] = *(const PG8_LAS bf16x8*)(lds + PG8_SA(b, h) + aoff + m * 2048 + k * 1024); } while (0)
#define PG8_LDB(dst, b, h) do { _Pragma("unroll") for (int n = 0; n < 2; ++n) _Pragma("unroll") for (int k = 0; k < 2; ++k) dst[n][k] = *(const PG8_LAS bf16x8*)(lds + PG8_SB(b, h) + boff + n * 2048 + k * 1024); } while (0)
#define PG8_MMA(ai, bj, At, Bt) do { __builtin_amdgcn_s_setprio(1); _Pragma("unroll") for (int m = 0; m < 4; ++m) _Pragma("unroll") for (int n = 0; n < 2; ++n) _Pragma("unroll") for (int k = 0; k < 2; ++k) \
        acc[ai][bj][m][n] = __builtin_amdgcn_mfma_f32_16x16x32_bf16(Bt[n][k], At[m][k], acc[ai][bj][m][n], 0, 0, 0); __builtin_amdgcn_s_setprio(0); } while (0)
#define PG8_WAIT_V(n) asm volatile("s_waitcnt vmcnt(" #n ")" ::: "memory")
#define PG8_WAIT_L(n) asm volatile("s_waitcnt lgkmcnt(" #n ")" ::: "memory")
#define PG8_BAR __builtin_amdgcn_s_barrier()
#define PG8_SCHED __builtin_amdgcn_sched_barrier(0)
    Unit cur, nxt; int ui = 0;
    if (!S.next(0, cur)) return;
    f32x4 acc[2][2][4][2];
#pragma unroll
    for (int a = 0; a < 2; ++a)
#pragma unroll
        for (int b = 0; b < 2; ++b)
#pragma unroll
            for (int m = 0; m < 4; ++m)
#pragma unroll
                for (int n = 0; n < 2; ++n) acc[a][b][m][n] = (f32x4){0.f, 0.f, 0.f, 0.f};
    bf16x8 At[4][2], B0[2][2], B1[2][2];
    const char* cA = (const char*)g.A + (size_t)cur.pm * tstepA; const char* cB = (const char*)g.Bt + (size_t)cur.pn * tstepB;
    S.a_ready(cur);
    PG8_STAGE(PG8_SB(0, 0), cB, voffB); PG8_STAGE(PG8_SA(0, 0), cA, voffA); PG8_STAGE(PG8_SB(0, 1), cB + hstepB, voffB); PG8_STAGE(PG8_SA(0, 1), cA + hstepA, voffA);
    if (wr == 1) PG8_BAR;
    PG8_WAIT_V(4); PG8_BAR;
    PG8_STAGE(PG8_SB(1, 0), cB + kstep, voffB); PG8_STAGE(PG8_SA(1, 0), cA + kstep, voffA); PG8_STAGE(PG8_SB(1, 1), cB + hstepB + kstep, voffB);
    PG8_WAIT_V(6); PG8_BAR;
    PG8_STAMP();
    for (;;) {
        const bool has_next = S.next(ui + 1, nxt);
        const char* nA = has_next ? (const char*)g.A + (size_t)nxt.pm * tstepA : cA; const char* nB = has_next ? (const char*)g.Bt + (size_t)nxt.pn * tstepB : cB;
        for (int t = 0; t < nt; t += 2) {
            const bool last = (t == nt - 2);
            const char* a1 = cA + (size_t)(t + 1) * kstep;
            const char* a2 = last ? nA : cA + (size_t)(t + 2) * kstep; const char* b2 = last ? nB : cB + (size_t)(t + 2) * kstep;
            const char* a3 = a2 + kstep; const char* b3 = b2 + kstep;
            if (last && has_next) S.a_ready(nxt);
            PG8_LDB(B0, 0, 0); PG8_SCHED; PG8_LDA(At, 0, 0); PG8_STAGE(PG8_SA(1, 1), a1 + hstepA, voffA);
            PG8_WAIT_L(8); PG8_BAR; PG8_WAIT_L(0); PG8_MMA(0, 0, At, B0); PG8_BAR; PG8_SCHED;
            PG8_LDB(B1, 0, 1); PG8_STAGE(PG8_SB(0, 0), b2, voffB);
            PG8_BAR; PG8_WAIT_L(0); PG8_MMA(0, 1, At, B1); PG8_BAR;
            PG8_LDA(At, 0, 1); PG8_STAGE(PG8_SA(0, 0), a2, voffA);
            PG8_BAR; PG8_WAIT_L(0); PG8_MMA(1, 0, At, B0); PG8_BAR; PG8_SCHED;
            PG8_STAGE(PG8_SB(0, 1), b2 + hstepB, voffB);
            PG8_WAIT_V(6); PG8_BAR; PG8_MMA(1, 1, At, B1); PG8_BAR;
            PG8_LDB(B0, 1, 0); PG8_SCHED; PG8_LDA(At, 1, 0); PG8_STAGE(PG8_SA(0, 1), a2 + hstepA, voffA);
            PG8_WAIT_L(8); PG8_BAR; PG8_WAIT_L(0); PG8_MMA(0, 0, At, B0); PG8_BAR; PG8_SCHED;
            PG8_LDB(B1, 1, 1); PG8_STAGE(PG8_SB(1, 0), b3, voffB);
            PG8_BAR; PG8_WAIT_L(0); PG8_MMA(0, 1, At, B1); PG8_BAR;
            PG8_LDA(At, 1, 1); PG8_STAGE(PG8_SA(1, 0), a3, voffA);
            PG8_BAR; PG8_WAIT_L(0); PG8_MMA(1, 0, At, B0); PG8_BAR; PG8_SCHED;
            PG8_STAGE(PG8_SB(1, 1), b3 + hstepB, voffB);
            PG8_WAIT_V(6); PG8_BAR; PG8_MMA(1, 1, At, B1); PG8_BAR;
        }
        PG8_STAMP();
        if constexpr (!Epi::AFTER_DRAIN) { E(acc, cur, wr, wc, fr, fq); S.done(cur); }
        PG8_STAMP();
        if (!has_next) break;
#pragma unroll
        for (int a = 0; a < 2; ++a)
#pragma unroll
            for (int b = 0; b < 2; ++b)
#pragma unroll
                for (int m = 0; m < 4; ++m)
#pragma unroll
                    for (int n = 0; n < 2; ++n) acc[a][b][m][n] = (f32x4){0.f, 0.f, 0.f, 0.f};
        cur = nxt; cA = nA; cB = nB; ++ui;
    }
    PG8_WAIT_V(0);
    if (wr == 0) PG8_BAR;
    PG8_BAR;
    if constexpr (Epi::AFTER_DRAIN) { E.fused(acc, cur, wr, wc, fr, fq, lds, wid, lane); S.done(cur); }
    PG8_STAMP();
    if (STAMP && wid == 0) { stamps[lane] = lane < nts ? (((unsigned long long)(unsigned)ts_hi << 32) | (unsigned)ts_lo) : 0ull;
        if (lane == 62) stamps[62] = rt_entry; if (lane == 63) stamps[63] = (unsigned long long)wall_clock64(); }
#undef PG8_STAMP
#undef PG8_SA
#undef PG8_SB
#undef PG8_STAGE
#undef PG8_LDA
#undef PG8_LDB
#undef PG8_MMA
#undef PG8_WAIT_V
#undef PG8_WAIT_L
#undef PG8_BAR
#undef PG8_SCHED
}
}
#define XB_TMO      128
#define XB_XCNT(j)  (256  + 64 * (j))
#define XB_XSUB(j)  (1280 + 64 * (j))
#define XB_XGEN(j)  (2304 + 64 * (j))
#define XB_TOP      3328
#define XB_TOPGEN   3392
#define XCD_BAR_WORDS 3456
#define XB_SPIN_CAP (1u << 18)

__device__ __forceinline__ unsigned xb_ld(unsigned* p)              { return __hip_atomic_load(p, __ATOMIC_RELAXED, __HIP_MEMORY_SCOPE_AGENT); }
__device__ __forceinline__ unsigned xb_add(unsigned* p, unsigned v) { return __hip_atomic_fetch_add(p, v, __ATOMIC_RELAXED, __HIP_MEMORY_SCOPE_AGENT); }
__device__ __forceinline__ unsigned xb_xcc_id() { return (unsigned)__builtin_amdgcn_s_getreg((3 << 11) | 20) & 0xFu; }
#define XB_SPIN(cond, bar) do { unsigned _sp = 0; while (cond) { __builtin_amdgcn_s_sleep(1); \
    if ((++_sp & 255u) == 0u) { if (xb_ld(&(bar)[XB_TMO])) break; if (_sp > XB_SPIN_CAP) { atomicAdd(&(bar)[XB_TMO], 1u); break; } } } } while (0)

struct XcdBarrier {
    unsigned* bar; unsigned x;
    volatile LAS unsigned* st;
};

__device__ __forceinline__ XcdBarrier xcd_barrier_post(unsigned* bar, volatile LAS unsigned* st) {
    XcdBarrier b; b.bar = bar; b.x = xb_xcc_id(); b.st = st;
    if (threadIdx.x == 0) (void)xb_add(&bar[XB_XCNT(b.x)], 1u);
    return b;
}
__device__ __forceinline__ void xcd_barrier_complete(unsigned* bar, unsigned x, unsigned& nloc, unsigned& nx) {
    const unsigned G = gridDim.x * gridDim.y * gridDim.z;
    unsigned sum, cnt, mine, sp = 0u;
    for (;;) {
        sum = 0u; cnt = 0u; mine = 0u;
#pragma unroll
        for (unsigned j = 0; j < 16; ++j) { const unsigned c = xb_ld(&bar[XB_XCNT(j)]); sum += c; cnt += (c > 0u) ? 1u : 0u; mine = (j == x) ? c : mine; }
        if (sum == G) break;
        __builtin_amdgcn_s_sleep(1);
        if ((++sp & 255u) == 0u) { if (xb_ld(&bar[XB_TMO])) break; if (sp > XB_SPIN_CAP) { atomicAdd(&bar[XB_TMO], 1u); break; } }
    }
    nloc = mine > 0u ? mine : 1u; nx = cnt > 0u ? cnt : 1u;
}

__device__ __forceinline__ void xcd_barrier(const XcdBarrier& b) {
    asm volatile("s_waitcnt vmcnt(0)" ::: "memory");
    __syncthreads();
    int xb_tid = threadIdx.x; asm volatile("" : "+v"(xb_tid));
    if (xb_tid == 0) {
        unsigned* bar = b.bar; asm volatile("" : "+v"(bar));
        unsigned bx = b.x; asm volatile("" : "+v"(bx));
        __builtin_amdgcn_s_waitcnt(0);
        unsigned nloc = b.st[0], nx = b.st[1];
        if (nloc == 0u) { xcd_barrier_complete(bar, bx, nloc, nx); b.st[0] = nloc; b.st[1] = nx; }
        const unsigned old = xb_add(&bar[XB_XSUB(bx)], 1u);
        const unsigned gen = old / nloc;
        if (old + 1u == (gen + 1u) * nloc) {
            __builtin_amdgcn_fence(__ATOMIC_RELEASE, "agent");
            asm volatile("s_waitcnt vmcnt(0)" ::: "memory");
            const unsigned og = xb_add(&bar[XB_TOP], 1u);
            const unsigned tg = og / nx;
            if (og + 1u == (tg + 1u) * nx) xb_add(&bar[XB_TOPGEN], 1u);
            else XB_SPIN(xb_ld(&bar[XB_TOPGEN]) == tg, bar);
            __builtin_amdgcn_fence(__ATOMIC_ACQUIRE, "agent");
            xb_add(&bar[XB_XGEN(bx)], 1u);
            asm volatile("s_waitcnt vmcnt(0)" ::: "memory");
        } else {
            XB_SPIN(xb_ld(&bar[XB_XGEN(bx)]) == gen, bar);
            __builtin_amdgcn_fence(__ATOMIC_ACQUIRE, "agent");
            asm volatile("s_waitcnt vmcnt(0)" ::: "memory");
        }
    }
    __syncthreads();
}


using pg8::bf16_t; using pg8::bf16x8; using pg8::f32x4; using pg8::u32x4; using pg8::Unit; using pg8::cvt_pk_bf16;
typedef unsigned u32x2 __attribute__((ext_vector_type(2)));
constexpr int T_TOK = 18432, T_PROMPT = 16384, DM = 1024, NP = 10496, NIN = 10288;
constexpr float EPSN = 1e-6f;
constexpr int LDS_BYTES = 163840, LDS_ST = 163328, LDS_TAB = 163344;
constexpr size_t WS_BAR = 0;
constexpr size_t WS_WADA = 16384;
constexpr size_t WS_WIN = WS_WADA + (size_t)12288 * 1024 * 2;
constexpr size_t WS_WGLA = WS_WIN + (size_t)NP * 1024 * 2;
constexpr size_t WS_WSSD = WS_WGLA + (size_t)1024 * 1024 * 2;
constexpr size_t WS_WOUT = WS_WSSD + (size_t)1024 * 2048 * 2;
constexpr size_t WS_WPEER = WS_WOUT + (size_t)1024 * 1024 * 2;
constexpr size_t WS_U = WS_WPEER + (size_t)2048 * 1024 * 2;
constexpr size_t WS_V = WS_U + (size_t)16384 * 1024 * 2;
constexpr size_t WS_SILUC = WS_V + (size_t)16384 * 1024 * 2;
constexpr size_t WS_MOD = WS_SILUC + (size_t)256 * 1024 * 2;
constexpr size_t WS_H = WS_MOD + (size_t)256 * 12288 * 4;
constexpr size_t WS_AUX = WS_H + (size_t)T_TOK * 1024 * 2;
constexpr size_t WS_PROJ = WS_AUX + (size_t)T_TOK * 64 * 4;
constexpr size_t WS_KET = WS_PROJ + (size_t)T_TOK * NP * 2;
constexpr size_t WS_ATT = WS_KET + (size_t)1152 * 8192 * 2;
constexpr size_t WS_DEC = WS_ATT + (size_t)1152 * 4096 * 2;
constexpr size_t WS_CBG = WS_DEC + (size_t)1152 * 128 * 4;
constexpr size_t WS_SM1 = WS_CBG + (size_t)1152 * 4096 * 2;
constexpr size_t WS_SCL = WS_SM1 + (size_t)12 * 1024 * 1024;
constexpr size_t WS_END = WS_SCL + (size_t)4 * 16384 * 4;
__host__ __device__ constexpr size_t ws_win(int l) { return l ? WS_WADA : WS_WIN; }
__host__ __device__ constexpr size_t ws_wgla(int l) { return l ? WS_SM1 : WS_WGLA; }
__host__ __device__ constexpr size_t ws_wssd(int l) { return l ? WS_SM1 + (size_t)2 * 1024 * 1024 : WS_WSSD; }
__host__ __device__ constexpr size_t ws_wout(int l) { return l ? WS_SM1 + (size_t)6 * 1024 * 1024 : WS_WOUT; }
__host__ __device__ constexpr size_t ws_wpeer(int l) { return l ? WS_SM1 + (size_t)8 * 1024 * 1024 : WS_WPEER; }
__host__ __device__ constexpr size_t ws_uv(int l) { return l ? WS_V : WS_U; }
__host__ __device__ constexpr size_t ws_su(int l) { return WS_SCL + (size_t)l * 131072; }
__host__ __device__ constexpr size_t ws_sv(int l) { return WS_SCL + (size_t)l * 131072 + 65536; }
constexpr int PC_Q = 0, PC_K = 512, PC_V = 1024, PC_GO = 2048, PC_Z = 3072, PC_XBC = 5120, PC_GATE = 8192;
constexpr size_t O_GLAP = 18874368, O_SSDP = 20971520, O_CONVP = 25165824, O_GLAS = 25313280, O_SSDS = 33701888, O_CONVS = 50479104;

#ifndef GEMM_MASK
#define GEMM_MASK 63
#endif
#define GAS __attribute__((address_space(1)))
struct Params { const float* in[30]; float* out; unsigned char* ws; };

__device__ __forceinline__ float bf2f(bf16_t b) { return __uint_as_float(((unsigned)b) << 16); }
__device__ __forceinline__ bf16_t f2bf(float f) { return (bf16_t)(cvt_pk_bf16(f, 0.f) & 0xffffu); }
__device__ __forceinline__ float lo_bf(unsigned w) { return __uint_as_float(w << 16); }
__device__ __forceinline__ float hi_bf(unsigned w) { return __uint_as_float(w & 0xffff0000u); }
__device__ __forceinline__ float sigmoidf_(float x) { return 1.f / (1.f + __expf(-x)); }
__device__ __forceinline__ float siluf_(float x) { return x / (1.f + __expf(-x)); }
__device__ __forceinline__ int otid() { int t = threadIdx.x; asm volatile("" : "+v"(t)); return t; }
__device__ __forceinline__ int cb_of_row(int r) { return r < T_PROMPT ? (r >> 11) : 8 + ((r - T_PROMPT) >> 6); }
__device__ __forceinline__ float wave_sum(float v) {
#pragma unroll
    for (int o = 32; o >= 1; o >>= 1) v += __shfl_xor(v, o);
    return v;
}
__device__ __forceinline__ float wave_max(float v) {
#pragma unroll
    for (int o = 32; o >= 1; o >>= 1) v = fmaxf(v, __shfl_xor(v, o));
    return v;
}

struct EpiF32 {
    static constexpr bool PERM = false, AFTER_DRAIN = false;
    float* C; int ldc; const float* bias;
    __device__ __forceinline__ void operator()(const f32x4 (&acc)[2][2][4][2], const Unit& u, int wr, int wc, int fr, int fq) const {
        const int row0 = u.pm * 256 + wr * 64 + fr, col0 = u.pn * 256 + wc * 32 + 4 * fq;
        f32x4 bv[2][2];
#pragma unroll
        for (int bj = 0; bj < 2; ++bj)
#pragma unroll
            for (int n = 0; n < 2; ++n) bv[bj][n] = bias ? *(const f32x4*)(bias + col0 + bj * 128 + n * 16) : (f32x4){0.f, 0.f, 0.f, 0.f};
#pragma unroll
        for (int ai = 0; ai < 2; ++ai)
#pragma unroll
            for (int m = 0; m < 4; ++m) { float* rowp = C + (size_t)(row0 + ai * 128 + m * 16) * ldc + col0;
#pragma unroll
                for (int bj = 0; bj < 2; ++bj)
#pragma unroll
                    for (int n = 0; n < 2; ++n) *(f32x4*)(rowp + bj * 128 + n * 16) = acc[ai][bj][m][n] + bv[bj][n]; }
    }
};
struct EpiF32NT {
    static constexpr bool PERM = false, AFTER_DRAIN = false;
    float* C; int ldc; const float* bias;
    __device__ __forceinline__ void operator()(const f32x4 (&acc)[2][2][4][2], const Unit& u, int wr, int wc, int fr, int fq) const {
        const int row0 = u.pm * 256 + wr * 64 + fr, col0 = u.pn * 256 + wc * 32 + 4 * fq;
        f32x4 bv[2][2];
#pragma unroll
        for (int bj = 0; bj < 2; ++bj)
#pragma unroll
            for (int n = 0; n < 2; ++n) bv[bj][n] = bias ? *(const f32x4*)(bias + col0 + bj * 128 + n * 16) : (f32x4){0.f, 0.f, 0.f, 0.f};
#pragma unroll
        for (int ai = 0; ai < 2; ++ai)
#pragma unroll
            for (int m = 0; m < 4; ++m) { float* rowp = C + (size_t)(row0 + ai * 128 + m * 16) * ldc + col0;
#pragma unroll
                for (int bj = 0; bj < 2; ++bj)
#pragma unroll
                    for (int n = 0; n < 2; ++n) __builtin_nontemporal_store(acc[ai][bj][m][n] + bv[bj][n], (GAS f32x4*)(rowp + bj * 128 + n * 16)); }
    }
};
struct EpiInProj {
    static constexpr bool PERM = true, AFTER_DRAIN = false;
    bf16_t* P; float* aux;
    __device__ __forceinline__ void operator()(const f32x4 (&acc)[2][2][4][2], const Unit& u, int wr, int wc, int fr, int fq) const {
        const int row0 = u.pm * 256 + wr * 64 + fr;
        if (u.pn == 40) {
            if (wc < 2) {
#pragma unroll
                for (int ai = 0; ai < 2; ++ai)
#pragma unroll
                    for (int m = 0; m < 4; ++m) { GAS float* rowp = (GAS float*)aux + (size_t)(row0 + ai * 128 + m * 16) * 64 + wc * 32 + 8 * fq;
                        *(GAS f32x4*)rowp = acc[ai][0][m][0]; *(GAS f32x4*)(rowp + 4) = acc[ai][0][m][1]; }
            }
        } else {
            const int col0 = u.pn * 256 + wc * 32 + 8 * fq;
#pragma unroll
            for (int ai = 0; ai < 2; ++ai)
#pragma unroll
                for (int m = 0; m < 4; ++m) { GAS bf16_t* rowp = (GAS bf16_t*)P + (size_t)(row0 + ai * 128 + m * 16) * NP + col0;
#pragma unroll
                    for (int bj = 0; bj < 2; ++bj) { const f32x4 v0 = acc[ai][bj][m][0], v1 = acc[ai][bj][m][1];
                        u32x4 w; w.x = cvt_pk_bf16(v0[0], v0[1]); w.y = cvt_pk_bf16(v0[2], v0[3]); w.z = cvt_pk_bf16(v1[0], v1[1]); w.w = cvt_pk_bf16(v1[2], v1[3]);
                        *(GAS u32x4*)(rowp + bj * 128) = w; } }
        }
    }
};
struct EpiGlaProj {
    static constexpr bool PERM = false, AFTER_DRAIN = false;
    bf16_t* P;
    __device__ __forceinline__ void operator()(const f32x4 (&acc)[2][2][4][2], const Unit& u, int wr, int wc, int fr, int fq) const {
        const int row0 = u.pm * 256 + wr * 64 + fr, col0 = u.pn * 256 + wc * 32 + 4 * fq;
#pragma unroll
        for (int ai = 0; ai < 2; ++ai)
#pragma unroll
            for (int m = 0; m < 4; ++m) { bf16_t* rowp = P + (size_t)(row0 + ai * 128 + m * 16) * NP + col0;
#pragma unroll
                for (int bj = 0; bj < 2; ++bj)
#pragma unroll
                    for (int n = 0; n < 2; ++n) { const f32x4 v = acc[ai][bj][m][n]; const u32x2 g = *(const u32x2*)(rowp + PC_GATE + bj * 128 + n * 16);
                        u32x2 w; w.x = cvt_pk_bf16(v[0] * sigmoidf_(lo_bf(g.x)), v[1] * sigmoidf_(hi_bf(g.x))); w.y = cvt_pk_bf16(v[2] * sigmoidf_(lo_bf(g.y)), v[3] * sigmoidf_(hi_bf(g.y)));
                        *(u32x2*)(rowp + bj * 128 + n * 16) = w; } }
    }
};
struct EpiSsdProj {
    static constexpr bool PERM = false, AFTER_DRAIN = false;
    const bf16_t* P; bf16_t* H;
    __device__ __forceinline__ void operator()(const f32x4 (&acc)[2][2][4][2], const Unit& u, int wr, int wc, int fr, int fq) const {
        const int row0 = u.pm * 256 + wr * 64 + fr, col0 = u.pn * 256 + wc * 32 + 4 * fq;
#pragma unroll
        for (int ai = 0; ai < 2; ++ai)
#pragma unroll
            for (int m = 0; m < 4; ++m) { const int row = row0 + ai * 128 + m * 16; const bf16_t* rowp = P + (size_t)row * NP + col0; bf16_t* hp = H + (size_t)row * 1024 + col0;
#pragma unroll
                for (int bj = 0; bj < 2; ++bj)
#pragma unroll
                    for (int n = 0; n < 2; ++n) { const f32x4 v = acc[ai][bj][m][n]; const u32x2 g = *(const u32x2*)(rowp + PC_GATE + 1024 + bj * 128 + n * 16); const u32x2 t = *(const u32x2*)(rowp + bj * 128 + n * 16);
                        u32x2 w; w.x = cvt_pk_bf16(lo_bf(t.x) + v[0] * sigmoidf_(lo_bf(g.x)), hi_bf(t.x) + v[1] * sigmoidf_(hi_bf(g.x)));
                        w.y = cvt_pk_bf16(lo_bf(t.y) + v[2] * sigmoidf_(lo_bf(g.y)), hi_bf(t.y) + v[3] * sigmoidf_(hi_bf(g.y)));
                        *(u32x2*)(hp + bj * 128 + n * 16) = w; } }
    }
};
struct EpiWout {
    static constexpr bool PERM = false, AFTER_DRAIN = false;
    float* X; const float* Xa; const float* Xb; const float* modg;
    __device__ __forceinline__ void operator()(const f32x4 (&acc)[2][2][4][2], const Unit& u, int wr, int wc, int fr, int fq) const {
        const int row0 = u.pm * 256 + wr * 64 + fr, col0 = u.pn * 256 + wc * 32 + 4 * fq;
#pragma unroll
        for (int ai = 0; ai < 2; ++ai)
#pragma unroll
            for (int m = 0; m < 4; ++m) { const int row = row0 + ai * 128 + m * 16; float* xp = X + (size_t)row * 1024 + col0; const float* xi = (row < T_PROMPT ? Xa + (size_t)row * 1024 : Xb + (size_t)(row - T_PROMPT) * 1024) + col0; const float* gp = modg + (size_t)cb_of_row(row) * 12288 + col0;
#pragma unroll
                for (int bj = 0; bj < 2; ++bj)
#pragma unroll
                    for (int n = 0; n < 2; ++n) { const f32x4 g = *(const f32x4*)(gp + bj * 128 + n * 16); f32x4 xv = *(const f32x4*)(xi + bj * 128 + n * 16); xv = xv + g * acc[ai][bj][m][n]; *(f32x4*)(xp + bj * 128 + n * 16) = xv; } }
    }
};

template <int ID, class Epi>
__device__ __forceinline__ void run_gemm(LAS unsigned char* lds, const bf16_t* A, int lda, const bf16_t* Bt, int M, int N, int K, const Epi& E) {
    pg8::Gemm g; g.A = A; g.Bt = Bt; g.M = M; g.N = N; g.K = K; g.lda = lda;
    pg8::StaticOrder S; S.init(M, N, (int)gridDim.x, (int)blockIdx.x);
#ifndef NO_GEMM
    if (!((GEMM_MASK >> ID) & 1)) return;
    pg8::gemm_phase<Epi, pg8::StaticOrder, false>(lds, g, S, E, nullptr);
#endif
    __syncthreads();
}

__device__ __forceinline__ int win_src_col(int n) {
    if (n < 3072) return n;
    if (n < 8192) return n + 16;
    if (n < 10240) return n + 48;
    if (n < 10256) return n - 10240 + 3072;
    if (n < 10288) return n - 10256 + 8208;
    return -1;
}
template <bool MAP>
__device__ __forceinline__ void tconv_tile(const float* W, int Nsrc, bf16_t* Wt, int ldt, int k0, int n0, float* tile, int tid) {
    {
        const int nn = tid & 63, n = n0 + nn; const int sc = MAP ? win_src_col(n) : n;
#pragma unroll
        for (int i = 0; i < 8; ++i) { const int kk = i * 8 + (tid >> 6); tile[kk * 65 + nn] = sc >= 0 ? __builtin_nontemporal_load(W + (size_t)(k0 + kk) * Nsrc + sc) : 0.f; }
    }
    __syncthreads();
    {
        const int nn = tid >> 3, ks = (tid & 7) * 8; const float* s = tile + ks * 65 + nn;
        u32x4 o; o.x = cvt_pk_bf16(s[0], s[65]); o.y = cvt_pk_bf16(s[2 * 65], s[3 * 65]); o.z = cvt_pk_bf16(s[4 * 65], s[5 * 65]); o.w = cvt_pk_bf16(s[6 * 65], s[7 * 65]);
        *(u32x4*)(Wt + (size_t)(n0 + nn) * ldt + k0 + ks) = o;
    }
    __syncthreads();
}
__device__ __forceinline__ void conv_rows_bf16(const float* src, bf16_t* dst, size_t n8, int bid, int nb, int tid) {
    for (size_t i = (size_t)bid * 512 + tid; i < n8; i += (size_t)nb * 512) {
        const f32x4 a = *(const f32x4*)(src + i * 8), b = *(const f32x4*)(src + i * 8 + 4);
        u32x4 o; o.x = cvt_pk_bf16(a[0], a[1]); o.y = cvt_pk_bf16(a[2], a[3]); o.z = cvt_pk_bf16(b[0], b[1]); o.w = cvt_pk_bf16(b[2], b[3]);
        *(u32x4*)(dst + i * 8) = o;
    }
}
#define DPPF(old, src, ctrl, rm, bm) __int_as_float(__builtin_amdgcn_update_dpp(__float_as_int(old), __float_as_int(src), ctrl, rm, bm, false))
__device__ __forceinline__ float wave_max_u(float v) {
    const float ninf = -3.4e38f;
    v = fmaxf(v, DPPF(ninf, v, 0x111, 0xf, 0xf)); v = fmaxf(v, DPPF(ninf, v, 0x112, 0xf, 0xf)); v = fmaxf(v, DPPF(ninf, v, 0x114, 0xf, 0xf)); v = fmaxf(v, DPPF(ninf, v, 0x118, 0xf, 0xf));
    v = fmaxf(v, DPPF(ninf, v, 0x142, 0xa, 0xf)); v = fmaxf(v, DPPF(ninf, v, 0x143, 0xc, 0xf));
    return __int_as_float(__builtin_amdgcn_readlane(__float_as_int(v), 63));
}
__device__ __forceinline__ float wave_sum_u(float v) {
    v += DPPF(0.f, v, 0x111, 0xf, 0xf); v += DPPF(0.f, v, 0x112, 0xf, 0xf); v += DPPF(0.f, v, 0x114, 0xf, 0xf); v += DPPF(0.f, v, 0x118, 0xf, 0xf);
    v += DPPF(0.f, v, 0x142, 0xa, 0xf); v += DPPF(0.f, v, 0x143, 0xc, 0xf);
    return __int_as_float(__builtin_amdgcn_readlane(__float_as_int(v), 63));
}
__device__ __forceinline__ void conv_rows_fp8(const float* src, unsigned char* dst, float* scl, int bid, int nb, int tid, int row_lo, int row_hi) {
    const int lane = tid & 63;
    for (int row = row_lo + bid * 8 + (tid >> 6); row < row_hi; row += nb * 8) {
        const GAS f32x4* sp = (const GAS f32x4*)((const GAS float*)src + (size_t)row * 1024) + lane; f32x4 v[4]; float am = 0.f;
#pragma unroll
        for (int j = 0; j < 4; ++j) { v[j] = __builtin_nontemporal_load(sp + 64 * j); am = fmaxf(am, fmaxf(fmaxf(fabsf(v[j][0]), fabsf(v[j][1])), fmaxf(fabsf(v[j][2]), fabsf(v[j][3])))); }
        am = wave_max_u(am); const float q = am > 0.f ? 448.f / am : 1.f;
        GAS unsigned* dp = (GAS unsigned*)((GAS unsigned char*)dst + (size_t)row * 2048) + lane;
#pragma unroll
        for (int j = 0; j < 4; ++j) { int w = 0; w = __builtin_amdgcn_cvt_pk_fp8_f32(v[j][0] * q, v[j][1] * q, w, false); w = __builtin_amdgcn_cvt_pk_fp8_f32(v[j][2] * q, v[j][3] * q, w, true); dp[64 * j] = (unsigned)w; }
        if (lane == 0) scl[row] = am > 0.f ? am * (1.f / 448.f) : 1.f;
    }
}
__device__ __forceinline__ void mod_gemv(const Params& p, unsigned char* smem, int bid, int nb) {
    typedef __bf16 bf16v2_l __attribute__((ext_vector_type(2)));
    const int tid = otid(), wid = tid >> 6, lane = tid & 63;
    unsigned* sc2 = (unsigned*)smem;
    float* part = (float*)(smem + 81920);
    GAS float* mod = (GAS float*)(p.ws + WS_MOD); const GAS float* bias = (const GAS float*)p.in[8];
    for (int idx = tid; idx < 40 * 512; idx += 512) { const int cb = idx >> 9, kp = idx & 511; const GAS float* cp = cb < 8 ? (const GAS float*)p.in[5] + cb * 1024 : (const GAS float*)p.in[6] + (cb - 8) * 1024;
        sc2[kp * 40 + cb] = cvt_pk_bf16(siluf_(cp[2 * kp]), siluf_(cp[2 * kp + 1])); }
    __syncthreads();
    for (int cg = bid; cg < 192; cg += nb) {
        const int n = cg * 64 + lane, la = n / 6144, nn = n - la * 6144;
        const GAS float* W = (const GAS float*)p.in[7] + (size_t)la * 1024 * 6144 + nn + (size_t)(wid * 128) * 6144;
        float acc[40];
#pragma unroll
        for (int r = 0; r < 40; ++r) acc[r] = 0.f;
#pragma unroll 1
        for (int kb = 0; kb < 64; kb += 16) {
            float wv[32];
#pragma unroll
            for (int j = 0; j < 32; ++j) wv[j] = __builtin_nontemporal_load(W + (size_t)(2 * kb + j) * 6144);
#pragma unroll
            for (int j = 0; j < 16; ++j) { const bf16v2_l wp = __builtin_bit_cast(bf16v2_l, cvt_pk_bf16(wv[2 * j], wv[2 * j + 1])); const unsigned* sr = sc2 + (wid * 64 + kb + j) * 40;
#pragma unroll
                for (int r = 0; r < 40; ++r) acc[r] = __builtin_amdgcn_fdot2_f32_bf16(wp, __builtin_bit_cast(bf16v2_l, sr[r]), acc[r], false); }
        }
#pragma unroll
        for (int half = 0; half < 2; ++half) {
#pragma unroll
            for (int r = 0; r < 20; ++r) part[(wid * 20 + r) * 64 + lane] = acc[half * 20 + r];
            __syncthreads();
            for (int o = tid; o < 20 * 64; o += 512) { const int r = o >> 6, c = o & 63; float sum = 0.f;
#pragma unroll
                for (int w = 0; w < 8; ++w) sum += part[(w * 20 + r) * 64 + c];
                const int n2 = cg * 64 + c; mod[(size_t)(half * 20 + r) * 12288 + n2] = sum + bias[n2]; }
            __syncthreads();
        }
    }
}
__device__ __forceinline__ void phase_convert(const Params& p, int l, unsigned char* smem, int bid, int nb, int parts) {
    const int tid = otid();
    float* tile = (float*)smem;
    if (parts & 1) {
    for (int it = bid; it < 164 * 16; it += nb) { const int nt = it / 16, kt = it % 16;
        tconv_tile<true>(p.in[10] + (size_t)l * 1024 * NIN, NIN, (bf16_t*)(p.ws + ws_win(l)), 1024, kt * 64, nt * 64, tile, tid); }
    for (int it = bid; it < 256; it += nb) { const int nt = it / 16, kt = it % 16;
        tconv_tile<false>(p.in[14] + (size_t)l * 1024 * 1024, 1024, (bf16_t*)(p.ws + ws_wgla(l)), 1024, kt * 64, nt * 64, tile, tid); }
    for (int it = bid; it < 512; it += nb) { const int nt = it / 32, kt = it % 32;
        tconv_tile<false>(p.in[21] + (size_t)l * 2048 * 1024, 1024, (bf16_t*)(p.ws + ws_wssd(l)), 2048, kt * 64, nt * 64, tile, tid); }
    for (int it = bid; it < 256; it += nb) { const int nt = it / 16, kt = it % 16;
        tconv_tile<false>(p.in[22] + (size_t)l * 1024 * 1024, 1024, (bf16_t*)(p.ws + ws_wout(l)), 1024, kt * 64, nt * 64, tile, tid); }
    }
    if (parts & 12) {
        const int rlo = (parts & 4) ? 0 : 8192, rhi = (parts & 8) ? 16384 : 8192;
        conv_rows_fp8(p.in[27] + (size_t)l * 16384 * 1024, p.ws + ws_uv(l), (float*)(p.ws + ws_su(l)), bid, nb, tid, rlo, rhi);
        conv_rows_fp8(p.in[28] + (size_t)l * 16384 * 1024, p.ws + ws_uv(l) + 1024, (float*)(p.ws + ws_sv(l)), bid, nb, tid, rlo, rhi);
    }
    if (parts & 1)
    {
        float* keysL = (float*)smem; float* wqL = keysL + 64 * 129;
        bf16_t* WpT = (bf16_t*)(p.ws + ws_wpeer(l));
        for (int it = bid; it < 512; it += nb) {
            const int nt = it >> 4, mt = it & 15, n0 = nt * 64, m0 = mt * 64, h = n0 >> 8, half = (n0 >> 7) & 1, k0 = n0 & 127;
            const float* kp = (half ? p.in[26] : p.in[25]) + ((size_t)(l * 8 + h) * 128 + k0) * 128;
            const float* wp = p.in[24] + (size_t)l * 1024 * 2048 + (size_t)m0 * 2048 + h * 256 + half * 128;
#pragma unroll
            for (int i = 0; i < 16; ++i) { const int idx = tid + 512 * i, r = idx >> 7, d = idx & 127; keysL[r * 129 + d] = kp[r * 128 + d]; wqL[r * 129 + d] = wp[(size_t)r * 2048 + d]; }
            __syncthreads();
            const int nn = tid >> 3, ms = (tid & 7) * 8; float a[8] = {0.f, 0.f, 0.f, 0.f, 0.f, 0.f, 0.f, 0.f};
            for (int d = 0; d < 128; ++d) { const float kv = keysL[nn * 129 + d];
#pragma unroll
                for (int j = 0; j < 8; ++j) a[j] += kv * wqL[(ms + j) * 129 + d]; }
            u32x4 o; o.x = cvt_pk_bf16(a[0], a[1]); o.y = cvt_pk_bf16(a[2], a[3]); o.z = cvt_pk_bf16(a[4], a[5]); o.w = cvt_pk_bf16(a[6], a[7]);
            *(u32x4*)(WpT + (size_t)(n0 + nn) * 1024 + m0 + ms) = o;
            __syncthreads();
        }
    }
}

__device__ __forceinline__ void phase_norm(const Params& p, const float* Xa, const float* Xb, const float* nw, int off_sh, int off_sc) {
    const int tid = otid(), lane = tid & 63, gw = blockIdx.x * 8 + (tid >> 6), nw_ = gridDim.x * 8;
    const GAS float* mod = (const GAS float*)(p.ws + WS_MOD); GAS bf16_t* H = (GAS bf16_t*)(p.ws + WS_H);
    f32x4 wv[4];
#pragma unroll
    for (int j = 0; j < 4; ++j) wv[j] = *(const GAS f32x4*)((const GAS float*)nw + lane * 4 + 256 * j);
    constexpr int RB = 3;
    for (int row0 = gw; row0 < T_TOK; row0 += nw_ * RB) {
        f32x4 v[RB][4];
#pragma unroll
        for (int r = 0; r < RB; ++r) { const int row = row0 + r * nw_; if (row < T_TOK) { const GAS f32x4* xr = (const GAS f32x4*)(row < T_PROMPT ? Xa + (size_t)row * 1024 : Xb + (size_t)(row - T_PROMPT) * 1024) + lane;
#pragma unroll
                for (int j = 0; j < 4; ++j) v[r][j] = xr[64 * j]; } }
#pragma unroll
        for (int r = 0; r < RB; ++r) { const int row = row0 + r * nw_; if (row < T_TOK) { float ss = 0.f;
#pragma unroll
                for (int j = 0; j < 4; ++j) ss += v[r][j][0] * v[r][j][0] + v[r][j][1] * v[r][j][1] + v[r][j][2] * v[r][j][2] + v[r][j][3] * v[r][j][3];
                const float rstd = rsqrtf(wave_sum_u(ss) * (1.f / 1024.f) + EPSN);
                const GAS float* mp = mod + (size_t)cb_of_row(row) * 12288;
#pragma unroll
                for (int j = 0; j < 4; ++j) { const int col = lane * 4 + 256 * j;
                    const f32x4 sc = *(const GAS f32x4*)(mp + off_sc + col), sh = *(const GAS f32x4*)(mp + off_sh + col);
                    const f32x4 o = v[r][j] * rstd * wv[j] * (sc + 1.f) + sh;
                    u32x2 pk; pk.x = cvt_pk_bf16(o[0], o[1]); pk.y = cvt_pk_bf16(o[2], o[3]);
                    *(GAS u32x2*)(H + (size_t)row * 1024 + col) = pk; } } }
    }
}

__device__ __forceinline__ bf16x8 ldfrag(const LAS bf16_t* base, int stride, int r0, int k0, int lane) {
    return *(const LAS bf16x8*)(base + (r0 + (lane & 15)) * stride + k0 + (lane >> 4) * 8);
}
__device__ __forceinline__ f32x4 mfma16(bf16x8 a, bf16x8 b, f32x4 c) { return __builtin_amdgcn_mfma_f32_16x16x32_bf16(a, b, c, 0, 0, 0); }


#ifdef DBG2
__device__ __forceinline__ void dbg2(const Params& p, bool bad, int e) { if (bad) atomicMax((unsigned*)(p.ws + WS_BAR) + 4000, (unsigned)(100 - e)); }
__device__ __forceinline__ bool nonfin(float v) { return (__float_as_uint(v) & 0x7F800000u) == 0x7F800000u; }
#define DBG2(bad, e) dbg2(p, bad, e)
#else
#define DBG2(bad, e)
#endif
__device__ __forceinline__ void gla_pre_item(const Params& p, int l, LAS unsigned char* lds, int item) {
    const int tid = otid(), wid = tid >> 6, lane = tid & 63, quad = lane >> 4, l15 = lane & 15;
    LAS bf16_t* Q = (LAS bf16_t*)(lds + 0); LAS bf16_t* Kt = (LAS bf16_t*)(lds + 17408); LAS bf16_t* KeT = (LAS bf16_t*)(lds + 34816);
    LAS bf16_t* Att = (LAS bf16_t*)(lds + 57856);
    LAS float* bsum = (LAS float*)(lds + 75776); LAS float* ptot = (LAS float*)(lds + 108544); LAS float* gl = (LAS float*)(lds + 110592); LAS float* dec = (LAS float*)(lds + 114688);
    GAS bf16_t* proj = (GAS bf16_t*)(p.ws + WS_PROJ); const GAS float* aux = (const GAS float*)(p.ws + WS_AUX);
    const int gc = item >> 2, h = item & 3, r0 = gc * 64;
    const int d = tid & 127, part = tid >> 7;
    float w2c[16];
#pragma unroll
    for (int r = 0; r < 16; ++r) w2c[r] = ((const GAS float*)p.in[11])[(size_t)(l * 16 + r) * 512 + h * 128 + d];
    const float gb = ((const GAS float*)p.in[12])[l * 512 + h * 128 + d];
    const int gi = (tid >> 2) & 63, gq4 = (tid & 3) * 4, qr = tid >> 4, qc8 = (tid & 15) * 8;
    {
        const f32x4 n_gl = *(const GAS f32x4*)(aux + (size_t)(r0 + gi) * 64 + gq4); u32x4 n_q[2], n_k[2];
#pragma unroll
        for (int q_ = 0; q_ < 2; ++q_) { const GAS bf16_t* rp_ = proj + (size_t)(r0 + qr + 32 * q_) * NP + h * 128 + qc8; n_q[q_] = *(const GAS u32x4*)(rp_ + PC_Q); n_k[q_] = *(const GAS u32x4*)(rp_ + PC_K); }
        __syncthreads();
        if (tid < 256) *(LAS f32x4*)(gl + gi * 16 + gq4) = n_gl;
#pragma unroll
        for (int q_ = 0; q_ < 2; ++q_) { *(LAS u32x4*)(Q + (qr + 32 * q_) * 136 + qc8) = n_q[q_]; *(LAS u32x4*)(Kt + (qr + 32 * q_) * 136 + qc8) = n_k[q_]; }
    }
    __syncthreads();
    { float run = 0.f;
#pragma unroll 4
        for (int ii = 0; ii < 16; ++ii) { const int i = part * 16 + ii; float z = gb;
#pragma unroll
            for (int r = 0; r < 16; ++r) z += gl[i * 16 + r] * w2c[r];
            const float g = (fminf(z, 0.f) - __logf(1.f + __expf(-fabsf(z)))) * (1.f / 16.f);
            run += g; bsum[i * 128 + d] = run; }
        ptot[part * 128 + d] = run; }
    __syncthreads();
    { float off = 0.f, tot = 0.f;
#pragma unroll
        for (int pp = 0; pp < 4; ++pp) { const float t = ptot[pp * 128 + d]; if (pp < part) off += t; tot += t; }
        const float etot = __expf(tot);
        if (part == 0) dec[d] = etot;
#pragma unroll
        for (int i8 = 0; i8 < 2; ++i8) { float ke[8];
#pragma unroll
            for (int ii = 0; ii < 8; ++ii) { const int i = part * 16 + i8 * 8 + ii; const float b = bsum[i * 128 + d] + off;
                const float qv = bf2f(Q[i * 136 + d]), kv = bf2f(Kt[i * 136 + d]); const float enb = __expf(-b);
                Q[i * 136 + d] = f2bf(qv * 0.08838834764831845f * __expf(b)); Kt[i * 136 + d] = f2bf(kv * enb); ke[ii] = kv * (etot * enb); }
            u32x4 o; o.x = cvt_pk_bf16(ke[0], ke[1]); o.y = cvt_pk_bf16(ke[2], ke[3]); o.z = cvt_pk_bf16(ke[4], ke[5]); o.w = cvt_pk_bf16(ke[6], ke[7]);
            *(LAS u32x4*)(KeT + d * 72 + part * 16 + i8 * 8) = o; } }
    __syncthreads();
    { const int ti = wid >> 1;
#pragma unroll
        for (int t2 = 0; t2 < 2; ++t2) { const int tj = (wid & 1) * 2 + t2; f32x4 a = (f32x4){0.f, 0.f, 0.f, 0.f};
            if (tj <= ti) {
#pragma unroll
                for (int kk = 0; kk < 4; ++kk) a = mfma16(ldfrag(Q, 136, ti * 16, kk * 32, lane), ldfrag(Kt, 136, tj * 16, kk * 32, lane), a); }
#pragma unroll
            for (int jj = 0; jj < 4; ++jj) { const int i = ti * 16 + quad * 4 + jj, j = tj * 16 + l15; Att[i * 72 + j] = f2bf(j <= i ? a[jj] : 0.f); } } }
    __syncthreads();
    {
#pragma unroll
        for (int q_ = 0; q_ < 2; ++q_) *(GAS u32x4*)(proj + (size_t)(r0 + qr + 32 * q_) * NP + h * 128 + qc8 + PC_Q) = *(const LAS u32x4*)(Q + (qr + 32 * q_) * 136 + qc8);
        GAS bf16_t* ket = (GAS bf16_t*)(p.ws + WS_KET) + (size_t)item * 8192;
#pragma unroll
        for (int q_ = 0; q_ < 2; ++q_) { const int idx = tid + 512 * q_, dd = idx >> 3, c8 = (idx & 7) * 8; *(GAS u32x4*)(ket + dd * 64 + c8) = *(const LAS u32x4*)(KeT + dd * 72 + c8); }
        GAS bf16_t* att = (GAS bf16_t*)(p.ws + WS_ATT) + (size_t)item * 4096;
        { const int ii = tid >> 3, c8 = (tid & 7) * 8; *(GAS u32x4*)(att + ii * 64 + c8) = *(const LAS u32x4*)(Att + ii * 72 + c8); }
        if (tid < 32) *(GAS f32x4*)((GAS float*)(p.ws + WS_DEC) + (size_t)item * 128 + tid * 4) = *(const LAS f32x4*)(dec + tid * 4);
    }
}
__device__ __forceinline__ void phase_gla_pre(const Params& p, int l, LAS unsigned char* lds) {
    for (int it = blockIdx.x; it < 1152; it += gridDim.x) gla_pre_item(p, l, lds, it);
}

template <bool DRY>
__device__ __forceinline__ void gla_chain(const Params& p, int l, LAS unsigned char* lds, int seq, int h, int sl) {
    const int tid = otid(), wid = tid >> 6, lane = tid & 63, quad = lane >> 4, l15 = lane & 15;
    GAS bf16_t* proj = (GAS bf16_t*)(p.ws + WS_PROJ);
    const GAS bf16_t* ketg = (const GAS bf16_t*)(p.ws + WS_KET); const GAS bf16_t* attg = (const GAS bf16_t*)(p.ws + WS_ATT); const GAS float* decg = (const GAS float*)(p.ws + WS_DEC);
    const bool samp = seq >= 8; const int nch = samp ? 1 : 32; const int gc0 = samp ? 256 + (seq - 8) : seq * 32;
    const int d0 = wid * 16 + quad * 4;
    f32x4 S[2];
    if (samp) { const GAS float* sp = (const GAS float*)p.in[2] + (size_t)((l * 32 + (seq - 8)) * 4 + h) * 32768;
#pragma unroll
        for (int te = 0; te < 2; ++te)
#pragma unroll
            for (int jj = 0; jj < 4; ++jj) S[te][jj] = sp[(d0 + jj) * 256 + sl * 32 + te * 16 + l15];
    } else { S[0] = (f32x4){0.f, 0.f, 0.f, 0.f}; S[1] = S[0]; }
    const int vj = tid >> 3, ve4 = (tid & 7) * 4, qr = tid >> 4, qc8 = (tid & 15) * 8, kd = tid >> 3, kc8 = (tid & 7) * 8;
    u32x2 n_v; u32x4 n_q[2], n_ke[2], n_att; f32x4 n_dec;
#define GLA_ISSUE(c_) do { const int gc_ = gc0 + (c_), r0_ = gc_ * 64, it_ = gc_ * 4 + h; \
        n_v = *(const GAS u32x2*)(proj + (size_t)(r0_ + vj) * NP + PC_V + h * 256 + sl * 32 + ve4); \
        _Pragma("unroll") for (int q_ = 0; q_ < 2; ++q_) { n_q[q_] = *(const GAS u32x4*)(proj + (size_t)(r0_ + qr + 32 * q_) * NP + h * 128 + qc8 + PC_Q); \
            n_ke[q_] = *(const GAS u32x4*)(ketg + (size_t)it_ * 8192 + (kd + 64 * q_) * 64 + kc8); } \
        n_att = *(const GAS u32x4*)(attg + (size_t)it_ * 4096 + kd * 64 + kc8); \
        if (tid < 32) n_dec = *(const GAS f32x4*)(decg + (size_t)it_ * 128 + tid * 4); } while (0)
    GLA_ISSUE(0);
    __syncthreads();
    { LAS bf16_t* ST = (LAS bf16_t*)(lds + 67072);
#pragma unroll
        for (int te = 0; te < 2; ++te) { u32x2 w; w.x = cvt_pk_bf16(S[te][0], S[te][1]); w.y = cvt_pk_bf16(S[te][2], S[te][3]); *(LAS u32x2*)(ST + (te * 16 + l15) * 136 + d0) = w; } }
    for (int c = 0; c < nch; ++c) {
        const int r0 = (gc0 + c) * 64;
        int lz = 0; asm volatile("" : "+v"(lz));
        LAS unsigned char* L = lds + lz;
        LAS bf16_t* Q = (LAS bf16_t*)(L + 0); LAS bf16_t* KeT = (LAS bf16_t*)(L + 34816);
        LAS bf16_t* vT = (LAS bf16_t*)(L + 53248); LAS bf16_t* Att = (LAS bf16_t*)(L + 57856); LAS bf16_t* ST = (LAS bf16_t*)(L + 67072); LAS float* dec = (LAS float*)(L + 114688);
        vT[(ve4 + 0) * 72 + vj] = (bf16_t)(n_v.x & 0xffffu); vT[(ve4 + 1) * 72 + vj] = (bf16_t)(n_v.x >> 16); vT[(ve4 + 2) * 72 + vj] = (bf16_t)(n_v.y & 0xffffu); vT[(ve4 + 3) * 72 + vj] = (bf16_t)(n_v.y >> 16);
#pragma unroll
        for (int q_ = 0; q_ < 2; ++q_) { *(LAS u32x4*)(Q + (qr + 32 * q_) * 136 + qc8) = n_q[q_]; *(LAS u32x4*)(KeT + (kd + 64 * q_) * 72 + kc8) = n_ke[q_]; }
        *(LAS u32x4*)(Att + kd * 72 + kc8) = n_att;
        if (tid < 32) *(LAS f32x4*)(dec + tid * 4) = n_dec;
        if (c + 1 < nch) GLA_ISSUE(c + 1);
        __syncthreads();
        { const int ti = wid >> 1, te = wid & 1; f32x4 a = (f32x4){0.f, 0.f, 0.f, 0.f};
#pragma unroll
            for (int kk = 0; kk < 2; ++kk) a = mfma16(ldfrag(Att, 72, ti * 16, kk * 32, lane), ldfrag(vT, 72, te * 16, kk * 32, lane), a);
#pragma unroll
            for (int kk = 0; kk < 4; ++kk) a = mfma16(ldfrag(Q, 136, ti * 16, kk * 32, lane), ldfrag(ST, 136, te * 16, kk * 32, lane), a);
#pragma unroll
            for (int jj = 0; jj < 4; ++jj) { const int i = ti * 16 + quad * 4 + jj; if (!DRY) proj[(size_t)(r0 + i) * NP + PC_V + h * 256 + sl * 32 + te * 16 + l15] = f2bf(a[jj]); else asm volatile("" :: "v"(a[jj])); } }
        { f32x4 dcv = *(const LAS f32x4*)(dec + d0);
#pragma unroll
            for (int te = 0; te < 2; ++te) { f32x4 a = (f32x4){0.f, 0.f, 0.f, 0.f};
#pragma unroll
                for (int kk = 0; kk < 2; ++kk) a = mfma16(ldfrag(KeT, 72, wid * 16, kk * 32, lane), ldfrag(vT, 72, te * 16, kk * 32, lane), a);
                S[te] = S[te] * dcv + a; } }
        __syncthreads();
#pragma unroll
        for (int te = 0; te < 2; ++te) { u32x2 w; w.x = cvt_pk_bf16(S[te][0], S[te][1]); w.y = cvt_pk_bf16(S[te][2], S[te][3]); *(LAS u32x2*)(ST + (te * 16 + l15) * 136 + d0) = w; }
    }
#undef GLA_ISSUE
    GAS float* so = (GAS float*)p.out + (samp ? O_GLAS + (size_t)((l * 32 + (seq - 8)) * 4 + h) * 32768 : O_GLAP + (size_t)((l * 8 + seq) * 4 + h) * 32768);
#pragma unroll
    for (int te = 0; te < 2; ++te)
#pragma unroll
        for (int jj = 0; jj < 4; ++jj) { if (!DRY) so[(d0 + jj) * 256 + sl * 32 + te * 16 + l15] = S[te][jj]; else asm volatile("" :: "v"(S[te][jj])); }
}

__device__ __forceinline__ void ssd_pre_item(const Params& p, int l, LAS unsigned char* lds, int item) {
    const int tid = otid(), wid = tid >> 6, lane = tid & 63, quad = lane >> 4, l15 = lane & 15;
    LAS bf16_t* rawT = (LAS bf16_t*)(lds + 0);
    LAS bf16_t* Bm = (LAS bf16_t*)(lds + 36864); LAS bf16_t* BT = (LAS bf16_t*)(lds + 54272); LAS bf16_t* Cm = (LAS bf16_t*)(lds + 72704); LAS bf16_t* CBl = (LAS bf16_t*)(lds + 90112);
    const GAS bf16_t* proj = (const GAS bf16_t*)(p.ws + WS_PROJ);
    const int gc = item >> 2, g = item & 3, r0 = gc * 64;
    const bool first = gc >= 256 || (gc & 31) == 0, samp = gc >= 256;
    u32x4 n_p[5];
#pragma unroll
    for (int j = 0; j < 5; ++j) { const int q_ = tid + 512 * j, rr = q_ >> 5, pc = q_ & 31; const int gcol = pc < 16 ? 2048 + g * 128 + pc * 8 : 2560 + g * 128 + (pc - 16) * 8;
        if (rr < 67 && (rr >= 3 || !first)) n_p[j] = *(const GAS u32x4*)(proj + (size_t)(r0 - 3 + rr) * NP + PC_XBC + gcol); }
    const int ch = tid & 255, half = tid >> 8; const int chan = ch < 128 ? 2048 + g * 128 + ch : 2560 + g * 128 + (ch - 128);
    const GAS float* cw = (const GAS float*)p.in[15] + (size_t)l * 4 * 3072; const float w0 = cw[chan], w1 = cw[3072 + chan], w2 = cw[2 * 3072 + chan], w3 = cw[3 * 3072 + chan], bb = ((const GAS float*)p.in[16])[(size_t)l * 3072 + chan];
    __syncthreads();
#pragma unroll
    for (int j = 0; j < 5; ++j) { const int q_ = tid + 512 * j, rr = q_ >> 5, pc = q_ & 31; if (rr < 67 && (rr >= 3 || !first)) *(LAS u32x4*)(rawT + rr * 264 + pc * 8) = n_p[j]; }
    if (first) { const GAS float* cprev = (const GAS float*)p.in[4] + (size_t)(l * 32 + (samp ? gc - 256 : 0)) * 3 * 3072;
        for (int idx = tid; idx < 768; idx += 512) { const int k = idx >> 8, c2 = idx & 255; const int chan2 = c2 < 128 ? 2048 + g * 128 + c2 : 2560 + g * 128 + (c2 - 128);
            rawT[k * 264 + c2] = samp ? f2bf(cprev[(size_t)k * 3072 + chan2]) : (bf16_t)0; } }
    __syncthreads();
    { const int i0 = half * 32; float x0 = bf2f(rawT[(i0 + 0) * 264 + ch]), x1 = bf2f(rawT[(i0 + 1) * 264 + ch]), x2 = bf2f(rawT[(i0 + 2) * 264 + ch]);
#pragma unroll
        for (int i8 = 0; i8 < 4; ++i8) { float a8[8];
#pragma unroll
            for (int ii = 0; ii < 8; ++ii) { const int i = i0 + i8 * 8 + ii; const float x3 = bf2f(rawT[(i + 3) * 264 + ch]); const float cv = bb + w0 * x0 + w1 * x1 + w2 * x2 + w3 * x3; a8[ii] = siluf_(cv);
                const bf16_t av = f2bf(a8[ii]);
                if (ch < 128) Bm[i * 136 + ch] = av; else Cm[i * 136 + (ch - 128)] = av;
                x0 = x1; x1 = x2; x2 = x3; }
            if (ch < 128) { u32x4 o; o.x = cvt_pk_bf16(a8[0], a8[1]); o.y = cvt_pk_bf16(a8[2], a8[3]); o.z = cvt_pk_bf16(a8[4], a8[5]); o.w = cvt_pk_bf16(a8[6], a8[7]); *(LAS u32x4*)(BT + ch * 72 + i0 + i8 * 8) = o; } } }
    __syncthreads();
    { const int ti = wid >> 1;
#pragma unroll
        for (int t2 = 0; t2 < 2; ++t2) { const int tj = (wid & 1) * 2 + t2; f32x4 a = (f32x4){0.f, 0.f, 0.f, 0.f};
            if (tj <= ti) {
#pragma unroll
                for (int kk = 0; kk < 4; ++kk) a = mfma16(ldfrag(Cm, 136, ti * 16, kk * 32, lane), ldfrag(Bm, 136, tj * 16, kk * 32, lane), a); }
#pragma unroll
            for (int jj = 0; jj < 4; ++jj) CBl[(ti * 16 + quad * 4 + jj) * 72 + tj * 16 + l15] = f2bf(a[jj]); } }
    __syncthreads();
    { GAS bf16_t* cact = (GAS bf16_t*)(p.ws + WS_H) + (size_t)item * 8192; GAS bf16_t* btg = (GAS bf16_t*)(p.ws + WS_H) + (size_t)1152 * 8192 + (size_t)item * 8192; GAS bf16_t* cbg = (GAS bf16_t*)(p.ws + WS_CBG) + (size_t)item * 4096;
#pragma unroll
        for (int q_ = 0; q_ < 2; ++q_) { const int idx = tid + 512 * q_;
            { const int rr = idx >> 4, c8 = (idx & 15) * 8; *(GAS u32x4*)(cact + rr * 128 + c8) = *(const LAS u32x4*)(Cm + rr * 136 + c8); }
            { const int ss = idx >> 3, c8 = (idx & 7) * 8; *(GAS u32x4*)(btg + ss * 64 + c8) = *(const LAS u32x4*)(BT + ss * 72 + c8); } }
        { const int ii = tid >> 3, c8 = (tid & 7) * 8; *(GAS u32x4*)(cbg + ii * 64 + c8) = *(const LAS u32x4*)(CBl + ii * 72 + c8); } }
}
__device__ __forceinline__ void phase_ssd_pre(const Params& p, int l, LAS unsigned char* lds) {
    for (int it = (int)((blockIdx.x + gridDim.x / 2) % gridDim.x); it < 1152; it += gridDim.x) ssd_pre_item(p, l, lds, it);
}

template <bool DRY>
__device__ __forceinline__ void ssd_chain(const Params& p, int l, LAS unsigned char* lds, int seq, int hd) {
    const int tid = otid(), wid = tid >> 6, lane = tid & 63, quad = lane >> 4, l15 = lane & 15;
    GAS bf16_t* proj = (GAS bf16_t*)(p.ws + WS_PROJ); const GAS float* aux = (const GAS float*)(p.ws + WS_AUX);
    const GAS bf16_t* cactg = (const GAS bf16_t*)(p.ws + WS_H); const GAS bf16_t* btgg = (const GAS bf16_t*)(p.ws + WS_H) + (size_t)1152 * 8192; const GAS bf16_t* cbgg = (const GAS bf16_t*)(p.ws + WS_CBG);
    const bool samp = seq >= 8; const int nch = samp ? 1 : 32; const int gc0 = samp ? 256 + (seq - 8) : seq * 32;
    const int g = hd >> 3, s0 = wid * 16 + quad * 4;
    const float Ah = -__expf(p.in[18][l * 32 + hd]), Dh = p.in[19][l * 32 + hd], dtb = p.in[17][l * 32 + hd];
    f32x4 S[4];
    if (samp) { const GAS float* sp = (const GAS float*)p.in[3] + (size_t)((l * 32 + (seq - 8)) * 32 + hd) * 8192;
#pragma unroll
        for (int tp = 0; tp < 4; ++tp) S[tp] = *(const GAS f32x4*)(sp + (tp * 16 + l15) * 128 + s0);
    } else {
#pragma unroll
        for (int tp = 0; tp < 4; ++tp) S[tp] = (f32x4){0.f, 0.f, 0.f, 0.f}; }
    const int xch = tid & 63, xpart = tid >> 6; const int xchan = hd * 64 + xch;
    const GAS float* cw = (const GAS float*)p.in[15] + (size_t)l * 4 * 3072; const float w0 = cw[xchan], w1 = cw[3072 + xchan], w2 = cw[2 * 3072 + xchan], w3 = cw[3 * 3072 + xchan], bb = ((const GAS float*)p.in[16])[(size_t)l * 3072 + xchan];
    const int pr = tid >> 4, pc8 = (tid & 15) * 8, kd = tid >> 3, kc8 = (tid & 7) * 8;
    u32x4 n_c[2], n_bt[2], n_cb, n_x[2]; float n_dt = 0.f;
#define SSD_ISSUE(c_) do { const int gc_ = gc0 + (c_), r0_ = gc_ * 64, it_ = gc_ * 4 + g; \
        if (wid == 0) n_dt = aux[(size_t)(r0_ + lane) * 64 + 16 + hd]; \
        _Pragma("unroll") for (int q_ = 0; q_ < 2; ++q_) { n_c[q_] = *(const GAS u32x4*)(cactg + (size_t)it_ * 8192 + (pr + 32 * q_) * 128 + pc8); n_bt[q_] = *(const GAS u32x4*)(btgg + (size_t)it_ * 8192 + (kd + 64 * q_) * 64 + kc8); \
            const int rr = kd + 64 * q_; if (rr < 67 && (rr >= 3 || (c_) > 0)) n_x[q_] = *(const GAS u32x4*)(proj + (size_t)(r0_ - 3 + rr) * NP + PC_XBC + hd * 64 + kc8); } \
        n_cb = *(const GAS u32x4*)(cbgg + (size_t)it_ * 4096 + kd * 64 + kc8); } while (0)
    SSD_ISSUE(0);
    __syncthreads();
    { LAS bf16_t* Sl = (LAS bf16_t*)(lds + 72704);
#pragma unroll
        for (int tp = 0; tp < 4; ++tp) { u32x2 w; w.x = cvt_pk_bf16(S[tp][0], S[tp][1]); w.y = cvt_pk_bf16(S[tp][2], S[tp][3]); *(LAS u32x2*)(Sl + (tp * 16 + l15) * 136 + s0) = w; } }
    for (int c = 0; c < nch; ++c) {
        const int r0 = (gc0 + c) * 64;
        int lz = 0; asm volatile("" : "+v"(lz));
        LAS unsigned char* L = lds + lz;
        LAS bf16_t* xT = (LAS bf16_t*)(L + 0); LAS bf16_t* xwT = (LAS bf16_t*)(L + 9216); LAS bf16_t* Cm = (LAS bf16_t*)(L + 18432); LAS bf16_t* BT = (LAS bf16_t*)(L + 35840);
        LAS bf16_t* CBl = (LAS bf16_t*)(L + 54272); LAS bf16_t* Wm = (LAS bf16_t*)(L + 63488); LAS bf16_t* Sl = (LAS bf16_t*)(L + 72704);
        LAS float* a_arr = (LAS float*)(L + 90112); LAS float* dt_arr = (LAS float*)(L + 90368); LAS bf16_t* rawT = (LAS bf16_t*)(L + 90624);
#pragma unroll
        for (int q_ = 0; q_ < 2; ++q_) { *(LAS u32x4*)(Cm + (pr + 32 * q_) * 136 + pc8) = n_c[q_]; *(LAS u32x4*)(BT + (kd + 64 * q_) * 72 + kc8) = n_bt[q_];
            const int rr = kd + 64 * q_; if (rr < 67 && (rr >= 3 || c > 0)) *(LAS u32x4*)(rawT + rr * 72 + kc8) = n_x[q_]; }
        *(LAS u32x4*)(CBl + kd * 72 + kc8) = n_cb;
        if (c == 0 && tid < 192) { const int k = tid >> 6, c2 = tid & 63; const GAS float* cprev = (const GAS float*)p.in[4] + (size_t)(l * 32 + (samp ? seq - 8 : 0)) * 3 * 3072;
            rawT[k * 72 + c2] = samp ? f2bf(cprev[(size_t)k * 3072 + hd * 64 + c2]) : (bf16_t)0; }
        unsigned short zc[8];
#pragma unroll
        for (int t2 = 0; t2 < 2; ++t2)
#pragma unroll
            for (int jj = 0; jj < 4; ++jj) zc[t2 * 4 + jj] = proj[(size_t)(r0 + (wid >> 1) * 16 + quad * 4 + jj) * NP + PC_Z + hd * 64 + ((wid & 1) * 2 + t2) * 16 + l15];
        if (wid == 0) { const float dtr = n_dt + dtb; const float dtv = fmaxf(dtr, 0.f) + log1pf(__expf(-fabsf(dtr)));
            float da = dtv * Ah;
#pragma unroll
            for (int o = 1; o < 64; o <<= 1) { const float t = __shfl_up(da, o); if (lane >= o) da += t; }
            a_arr[lane] = da; dt_arr[lane] = dtv; }
        if (c + 1 < nch) SSD_ISSUE(c + 1);
        __syncthreads();
        { const float a_last = a_arr[63]; const int i0 = xpart * 8;
            float x0 = bf2f(rawT[(i0 + 0) * 72 + xch]), x1 = bf2f(rawT[(i0 + 1) * 72 + xch]), x2 = bf2f(rawT[(i0 + 2) * 72 + xch]);
            float av[8], aw[8];
#pragma unroll
            for (int ii = 0; ii < 8; ++ii) { const int i = i0 + ii; const float x3 = bf2f(rawT[(i + 3) * 72 + xch]); const float cv = bb + w0 * x0 + w1 * x1 + w2 * x2 + w3 * x3; const float act = siluf_(cv);
                av[ii] = act; aw[ii] = act * dt_arr[i] * __expf(a_last - a_arr[i]);
                x0 = x1; x1 = x2; x2 = x3; }
            { u32x4 o1, o2;
#pragma unroll
                for (int k = 0; k < 4; ++k) { o1[k] = cvt_pk_bf16(av[2 * k], av[2 * k + 1]); o2[k] = cvt_pk_bf16(aw[2 * k], aw[2 * k + 1]); }
                *(LAS u32x4*)(xT + xch * 72 + i0) = o1; *(LAS u32x4*)(xwT + xch * 72 + i0) = o2; }
            const int wi = tid >> 3, wj0 = (tid & 7) * 8; const u32x4 cbv = *(const LAS u32x4*)(CBl + wi * 72 + wj0); const float ai = a_arr[wi]; float wv[8];
#pragma unroll
            for (int k = 0; k < 4; ++k) { const int j = wj0 + 2 * k; wv[2 * k] = j <= wi ? lo_bf(cbv[k]) * __expf(ai - a_arr[j]) * dt_arr[j] : 0.f; wv[2 * k + 1] = (j + 1) <= wi ? hi_bf(cbv[k]) * __expf(ai - a_arr[j + 1]) * dt_arr[j + 1] : 0.f; }
            u32x4 wo; wo.x = cvt_pk_bf16(wv[0], wv[1]); wo.y = cvt_pk_bf16(wv[2], wv[3]); wo.z = cvt_pk_bf16(wv[4], wv[5]); wo.w = cvt_pk_bf16(wv[6], wv[7]);
            *(LAS u32x4*)(Wm + wi * 72 + wj0) = wo; }
        __syncthreads();
        { const int ti = wid >> 1;
#pragma unroll
            for (int t2 = 0; t2 < 2; ++t2) { const int tp = (wid & 1) * 2 + t2; f32x4 yi = (f32x4){0.f, 0.f, 0.f, 0.f}, yo = yi;
#pragma unroll
                for (int kk = 0; kk < 2; ++kk) yi = mfma16(ldfrag(Wm, 72, ti * 16, kk * 32, lane), ldfrag(xT, 72, tp * 16, kk * 32, lane), yi);
#pragma unroll
                for (int kk = 0; kk < 4; ++kk) yo = mfma16(ldfrag(Cm, 136, ti * 16, kk * 32, lane), ldfrag(Sl, 136, tp * 16, kk * 32, lane), yo);
                const int pcol = tp * 16 + l15;
#pragma unroll
                for (int jj = 0; jj < 4; ++jj) { const int i = ti * 16 + quad * 4 + jj; const float xv = bf2f(xT[pcol * 72 + i]);
                    float y = yi[jj] + __expf(a_arr[i]) * yo[jj] + Dh * xv;
                    y *= siluf_(bf2f(zc[t2 * 4 + jj])); if (!DRY) proj[(size_t)(r0 + i) * NP + PC_Z + hd * 64 + pcol] = f2bf(y); else asm volatile("" :: "v"(y)); } } }
        { const float el = __expf(a_arr[63]);
#pragma unroll
            for (int tp = 0; tp < 4; ++tp) { f32x4 a = (f32x4){0.f, 0.f, 0.f, 0.f};
#pragma unroll
                for (int kk = 0; kk < 2; ++kk) a = mfma16(ldfrag(BT, 72, wid * 16, kk * 32, lane), ldfrag(xwT, 72, tp * 16, kk * 32, lane), a);
                S[tp] = S[tp] * el + a; } }
        __syncthreads();
#pragma unroll
        for (int tp = 0; tp < 4; ++tp) { u32x2 w; w.x = cvt_pk_bf16(S[tp][0], S[tp][1]); w.y = cvt_pk_bf16(S[tp][2], S[tp][3]); *(LAS u32x2*)(Sl + (tp * 16 + l15) * 136 + s0) = w; }
    }
#undef SSD_ISSUE
    GAS float* so = (GAS float*)p.out + (samp ? O_SSDS + (size_t)((l * 32 + (seq - 8)) * 32 + hd) * 8192 : O_SSDP + (size_t)((l * 8 + seq) * 32 + hd) * 8192);
#pragma unroll
    for (int tp = 0; tp < 4; ++tp) { if (!DRY) *(GAS f32x4*)(so + (tp * 16 + l15) * 128 + s0) = S[tp]; else asm volatile("" :: "v"(S[tp][0]), "v"(S[tp][1]), "v"(S[tp][2]), "v"(S[tp][3])); }
}

template <bool DRY>
__device__ __forceinline__ void phase_mixer(const Params& p, int l, LAS unsigned char* lds) {
    const int vb = (gridDim.x & 7) == 0 ? (int)((blockIdx.x & 7) * (gridDim.x >> 3) + (blockIdx.x >> 3)) : (int)blockIdx.x;
    for (int it = vb; it < 2560; it += gridDim.x) {
#ifdef DRY_GLA_ONLY
        if (DRY && ((it >= 256 && it < 512) || it >= 1536)) continue;
#endif
#ifdef DRY_PROMPT_ONLY
        if (DRY && it >= 512) continue;
#endif
#ifndef NO_GLA
        if (it < 256) gla_chain<DRY>(p, l, lds, it >> 5, (it >> 3) & 3, it & 7);
#else
        if (it < 256) {}
#endif
#ifndef NO_SSD
        else if (it < 512) { const int i = it - 256; ssd_chain<DRY>(p, l, lds, i >> 5, i & 31); }
#endif
#ifndef NO_GLA
        else if (it < 1536) { const int i = it - 512; gla_chain<DRY>(p, l, lds, 8 + (i >> 5), (i >> 3) & 3, i & 7); }
#endif
#ifndef NO_SSD
        else { const int i = it - 1536; ssd_chain<DRY>(p, l, lds, 8 + (i >> 5), i & 31); }
#endif
    }
}

__device__ __forceinline__ void phase_normgate(const Params& p, int l) {
    const int tid = otid(), lane = tid & 63, gw = blockIdx.x * 8 + (tid >> 6), nwv = gridDim.x * 8;
    GAS bf16_t* proj = (GAS bf16_t*)(p.ws + WS_PROJ);
    const GAS float* gnw = (const GAS float*)p.in[13] + l * 256; const GAS float* snw = (const GAS float*)p.in[20] + l * 2048;
    for (int row = gw; row < T_TOK; row += nwv) {
        GAS bf16_t* rp = proj + (size_t)row * NP;
        u32x4 q[4];
#pragma unroll
        for (int k = 0; k < 4; ++k) q[k] = *(const GAS u32x4*)(rp + PC_Z + lane * 32 + k * 8);
        {
            u32x4 a = *(const GAS u32x4*)(rp + PC_V + lane * 16), b = *(const GAS u32x4*)(rp + PC_V + lane * 16 + 8);
            const u32x4 ga = *(const GAS u32x4*)(rp + PC_GO + lane * 16), gb2 = *(const GAS u32x4*)(rp + PC_GO + lane * 16 + 8);
            float v[16], gg[16];
#pragma unroll
            for (int j = 0; j < 4; ++j) { v[2 * j] = lo_bf(a[j]); v[2 * j + 1] = hi_bf(a[j]); v[8 + 2 * j] = lo_bf(b[j]); v[8 + 2 * j + 1] = hi_bf(b[j]);
                gg[2 * j] = lo_bf(ga[j]); gg[2 * j + 1] = hi_bf(ga[j]); gg[8 + 2 * j] = lo_bf(gb2[j]); gg[8 + 2 * j + 1] = hi_bf(gb2[j]); }
            float ss = 0.f;
#pragma unroll
            for (int j = 0; j < 16; ++j) ss += v[j] * v[j];
            ss += __shfl_xor(ss, 1); ss += __shfl_xor(ss, 2); ss += __shfl_xor(ss, 4); ss += __shfl_xor(ss, 8);
            const float rstd = rsqrtf(ss * (1.f / 256.f) + EPSN); const int e0 = (lane * 16) & 255;
#pragma unroll
            for (int j = 0; j < 16; ++j) v[j] = v[j] * rstd * gnw[e0 + j] * siluf_(gg[j]);
#pragma unroll
            for (int j = 0; j < 4; ++j) { a[j] = cvt_pk_bf16(v[2 * j], v[2 * j + 1]); b[j] = cvt_pk_bf16(v[8 + 2 * j], v[8 + 2 * j + 1]); }
            *(GAS u32x4*)(rp + PC_V + lane * 16) = a; *(GAS u32x4*)(rp + PC_V + lane * 16 + 8) = b;
        }
        {
            float ss = 0.f;
#pragma unroll
            for (int k = 0; k < 4; ++k) {
#pragma unroll
                for (int j = 0; j < 4; ++j) { const float x0 = lo_bf(q[k][j]), x1 = hi_bf(q[k][j]); ss += x0 * x0 + x1 * x1; } }
            ss += __shfl_xor(ss, 1); ss += __shfl_xor(ss, 2); ss += __shfl_xor(ss, 4); ss += __shfl_xor(ss, 8);
            const float rstd = rsqrtf(ss * (1.f / 512.f) + EPSN);
#pragma unroll
            for (int k = 0; k < 4; ++k) {
#pragma unroll
                for (int j = 0; j < 4; ++j) { const int cc = lane * 32 + k * 8 + 2 * j; q[k][j] = cvt_pk_bf16(lo_bf(q[k][j]) * rstd * snw[cc], hi_bf(q[k][j]) * rstd * snw[cc + 1]); }
                *(GAS u32x4*)(rp + PC_Z + lane * 32 + k * 8) = q[k]; }
        }
    }
    for (int idx = blockIdx.x * 512 + tid; idx < 40 * 9216; idx += gridDim.x * 512) {
        const int seq = idx / 9216, rem = idx % 9216, k = rem / 3072, ch = rem % 3072;
        const int row = seq < 8 ? seq * 2048 + 2045 + k : T_PROMPT + (seq - 8) * 64 + 61 + k;
        const float v = bf2f(proj[(size_t)row * NP + PC_XBC + ch]);
        if (seq < 8) p.out[O_CONVP + (size_t)(l * 8 + seq) * 9216 + rem] = v; else p.out[O_CONVS + (size_t)(l * 32 + (seq - 8)) * 9216 + rem] = v;
    }
}

__device__ __forceinline__ unsigned fkey(float f) { const unsigned u = __float_as_uint(f); return u ^ ((unsigned)((int)u >> 31) | 0x80000000u); }
__device__ __forceinline__ int popc64(unsigned long long m) { return __builtin_popcountll(m); }
__device__ __forceinline__ int mbcnt64(unsigned long long m) { return (int)__builtin_amdgcn_mbcnt_hi((unsigned)(m >> 32), __builtin_amdgcn_mbcnt_lo((unsigned)m, 0u)); }
template <int NV>
__device__ __forceinline__ unsigned kth16(const unsigned (&k)[NV]) {
    unsigned prefix = 0u; bool exact = false;
#pragma unroll 1
    for (int bit = 31; bit >= 0 && !exact; --bit) { const unsigned trial = prefix | (1u << bit); int cnt = 0;
#pragma unroll
        for (int c = 0; c < NV; ++c) cnt += popc64(__ballot(k[c] >= trial));
        prefix = cnt >= 16 ? trial : prefix; exact = cnt == 16; }
    return prefix;
}
__device__ __forceinline__ void kth16x2(const unsigned (&ka)[2], const unsigned (&kb)[2], unsigned& Ta, unsigned& Tb) {
    unsigned pa = 0u, pb = 0u; bool ea = false, eb = false;
#pragma unroll 1
    for (int bit = 31; bit >= 0 && !(ea && eb); --bit) { const unsigned ta = pa | (1u << bit), tb = pb | (1u << bit);
        const int ca_ = popc64(__ballot(ka[0] >= ta)) + popc64(__ballot(ka[1] >= ta)), cb_ = popc64(__ballot(kb[0] >= tb)) + popc64(__ballot(kb[1] >= tb));
        pa = ca_ >= 16 ? ta : pa; pb = cb_ >= 16 ? tb : pb; ea = ea || ca_ == 16; eb = eb || cb_ == 16; }
    Ta = pa; Tb = pb;
}
template <int NV>
__device__ __forceinline__ void compact16(const unsigned (&k)[NV], unsigned T, const int (&pa)[NV], const int (&pb)[NV], int& oa, int& ob) {
    unsigned long long bg[NV], be[NV]; int ngt = 0;
#pragma unroll
    for (int c = 0; c < NV; ++c) { bg[c] = __ballot(k[c] > T); be[c] = __ballot(k[c] == T); ngt += popc64(bg[c]); }
    const int need = 16 - ngt; int baseg = 0, basee = 0; oa = 0; ob = 0;
#pragma unroll
    for (int c = 0; c < NV; ++c) { const bool g = k[c] > T, e = k[c] == T; const int rg = baseg + mbcnt64(bg[c]), re = basee + mbcnt64(be[c]);
        const bool sel = g || (e && re < need); const int pos = g ? rg : ngt + re; const int addr = (sel ? pos : 63) << 2;
        oa |= __builtin_amdgcn_ds_permute(addr, pa[c]); ob |= __builtin_amdgcn_ds_permute(addr, pb[c]);
        baseg += popc64(bg[c]); basee += popc64(be[c]); }
}
__device__ __forceinline__ void wave_top16x2(float (&va)[2], float (&vb)[2], int lane, float& oa, int& ia, float& ob, int& ib) {
    oa = -3.0e38f; ob = -3.0e38f; ia = 0; ib = 0;
#pragma unroll 1
    for (int it = 0; it < 16; ++it) {
        const float ma = fmaxf(va[0], va[1]), mb = fmaxf(vb[0], vb[1]);
        const float Ma = wave_max_u(ma), Mb = wave_max_u(mb);
        const int sa = __builtin_amdgcn_readfirstlane(__ffsll((long long)__ballot(ma == Ma)) - 1), sb = __builtin_amdgcn_readfirstlane(__ffsll((long long)__ballot(mb == Mb)) - 1);
        const bool ha0 = va[0] == Ma, hb0 = vb[0] == Mb;
        const int ida = ha0 ? lane : lane + 64, idb = hb0 ? lane : lane + 64;
        if (lane == sa) { if (ha0) va[0] = -3.0e38f; else va[1] = -3.0e38f; }
        if (lane == sb) { if (hb0) vb[0] = -3.0e38f; else vb[1] = -3.0e38f; }
        const int xa = __builtin_amdgcn_readlane(ida, sa), xb = __builtin_amdgcn_readlane(idb, sb);
        if (lane == it) { oa = Ma; ia = xa; ob = Mb; ib = xb; }
    }
}
__device__ __forceinline__ void wave_top16x1(float v, int id, int lane, float& outv, int& outi) {
    outv = -3.0e38f; outi = 0;
#pragma unroll 1
    for (int it = 0; it < 16; ++it) {
        const float M = wave_max_u(v);
        const int src = __builtin_amdgcn_readfirstlane(__ffsll((long long)__ballot(v == M)) - 1);
        const int sel = __builtin_amdgcn_readlane(id, src);
        if (lane == src) v = -3.0e38f;
        if (lane == it) { outv = M; outi = sel; }
    }
}
template <bool DRY>
__device__ __forceinline__ void phase_peer(const Params& p, int l) {
    const int tid = otid(), lane = tid & 63, gw = blockIdx.x * 8 + (tid >> 6), nwv = gridDim.x * 8;
    typedef float f32x2_t __attribute__((ext_vector_type(2)));
    const GAS float* scores = (const GAS float*)(p.ws + WS_PROJ); const GAS bf16_t* H = (const GAS bf16_t*)(p.ws + WS_H);
    const GAS unsigned char* UV = (const GAS unsigned char*)(p.ws + ws_uv(l));
    const GAS float* SU = (const GAS float*)(p.ws + ws_su(l)); const GAS float* SV = (const GAS float*)(p.ws + ws_sv(l));
    const GAS float* mod = (const GAS float*)(p.ws + WS_MOD); GAS float* X = (GAS float*)p.out;
    int ca, cb;
    { const int L = lane; const int thr[15] = {16, 24, 29, 33, 36, 38, 40, 42, 43, 44, 45, 46, 47, 48, 49}; const int cnt[15] = {16, 8, 5, 4, 3, 2, 2, 2, 1, 1, 1, 1, 1, 1, 1};
        int a_ = 0, pre = 0;
#pragma unroll
        for (int k = 0; k < 15; ++k) { const bool ge = L >= thr[k]; a_ += ge ? 1 : 0; pre += ge ? cnt[k] : 0; }
        ca = a_; cb = L - pre; if (L >= 50) { ca = 0; cb = 0; } }
    const bool b5 = (lane & 32) != 0, b4 = (lane & 16) != 0, b3 = (lane & 8) != 0, b2 = (lane & 4) != 0;
    const int ntok = gw < T_TOK ? (T_TOK - 1 - gw) / nwv + 1 : 0, nitems = ntok * 8;
    if (nitems == 0) return;
#define PEER_SC(q_, dst) do { const GAS float* sc_ = scores + (size_t)(gw + ((q_) >> 3) * nwv) * 2048 + ((q_) & 7) * 256; dst[0] = __builtin_nontemporal_load(sc_ + lane); dst[1] = __builtin_nontemporal_load(sc_ + 64 + lane); dst[2] = __builtin_nontemporal_load(sc_ + 128 + lane); dst[3] = __builtin_nontemporal_load(sc_ + 192 + lane); } while (0)
#define PEER_ROUTE(scv, eidx_o, gs_o) do { \
        const unsigned ka_[2] = {fkey(scv[0]), fkey(scv[1])}, kb_[2] = {fkey(scv[2]), fkey(scv[3])}; unsigned Ta_, Tb_; kth16x2(ka_, kb_, Ta_, Tb_); \
        const int pva_[2] = {__float_as_int(scv[0]), __float_as_int(scv[1])}, pvb_[2] = {__float_as_int(scv[2]), __float_as_int(scv[3])}, pid_[2] = {lane, lane + 64}; \
        int v1b_, i1_, v2b_, i2_; compact16<2>(ka_, Ta_, pva_, pid_, v1b_, i1_); compact16<2>(kb_, Tb_, pvb_, pid_, v2b_, i2_); \
          \
        const float v1a_ = __int_as_float(__shfl(v1b_, lane >> 2)); const int i1a_ = __shfl(i1_, lane >> 2) * 128; \
        unsigned kc_[4]; int pc_[4], pi_[4]; \
        _Pragma("unroll") for (int c = 0; c < 4; ++c) { const int bb_ = (lane & 3) * 4 + c; const float cv_ = v1a_ + __int_as_float(__shfl(v2b_, bb_)); kc_[c] = fkey(cv_); pc_[c] = __float_as_int(cv_); pi_[c] = i1a_ + __shfl(i2_, bb_); } \
        const unsigned Tc_ = kth16<4>(kc_); int svb_, ei_; compact16<4>(kc_, Tc_, pc_, pi_, svb_, ei_); \
        const float sv_ = lane < 16 ? __int_as_float(svb_) : -3.0e38f; const float mx_ = wave_max_u(sv_); const float ex_ = lane < 16 ? __expf(sv_ - mx_) : 0.f; \
        eidx_o = lane < 16 ? ei_ : 0; gs_o = ex_ / wave_sum_u(ex_); } while (0)
    float scn[4]; int eidx; float gs;
    PEER_SC(0, scn);
    PEER_ROUTE(scn, eidx, gs);
    if (nitems > 1) PEER_SC(1, scn);
    float xf[16]; f32x2_t acc2[8];
#pragma unroll 1
    for (int q = 0; q < nitems; ++q) {
        const int t = gw + (q >> 3) * nwv, h = q & 7;
#ifdef DRY_ROUTE_ONLY
        if (DRY) { asm volatile("" :: "v"(eidx), "v"(gs)); if (q + 1 < nitems) { float sc1[4] = {scn[0], scn[1], scn[2], scn[3]}; if (q + 2 < nitems) PEER_SC(q + 2, scn); PEER_ROUTE(sc1, eidx, gs); } continue; }
#endif
        const float su_l = lane < 16 ? SU[eidx] : 0.f, sv_l = lane < 16 ? SV[eidx] : 0.f;
        u32x4 ur[16], vr[16];
#pragma unroll
        for (int e = 0; e < 16; ++e) { const int eid = __builtin_amdgcn_readlane(eidx, e);
            const GAS unsigned char* rp_ = UV + (size_t)eid * 2048 + lane * 16; ur[e] = *(const GAS u32x4*)rp_; vr[e] = *(const GAS u32x4*)(rp_ + 1024); }
        const float gs_c = gs;
        if (h == 0) { const u32x4 a = __builtin_nontemporal_load((const GAS u32x4*)(H + (size_t)t * 1024 + lane * 16)), b = __builtin_nontemporal_load((const GAS u32x4*)(H + (size_t)t * 1024 + lane * 16 + 8));
#pragma unroll
            for (int j = 0; j < 4; ++j) { xf[2 * j] = lo_bf(a[j]); xf[2 * j + 1] = hi_bf(a[j]); xf[8 + 2 * j] = lo_bf(b[j]); xf[8 + 2 * j + 1] = hi_bf(b[j]); }
#pragma unroll
            for (int j = 0; j < 8; ++j) acc2[j] = (f32x2_t){0.f, 0.f}; }
        if (q + 1 < nitems) { float sc1[4] = {scn[0], scn[1], scn[2], scn[3]}; if (q + 2 < nitems) PEER_SC(q + 2, scn); PEER_ROUTE(sc1, eidx, gs); }
        float d[16];
        f32x2_t xp2[8];
#pragma unroll
        for (int j = 0; j < 8; ++j) xp2[j] = (f32x2_t){xf[2 * j], xf[2 * j + 1]};
#pragma unroll
        for (int e = 0; e < 16; ++e) { f32x2_t dp = (f32x2_t){0.f, 0.f};
#pragma unroll
            for (int j = 0; j < 4; ++j) { const f32x2_t lo = __builtin_amdgcn_cvt_pk_f32_fp8((int)ur[e][j], false), hi = __builtin_amdgcn_cvt_pk_f32_fp8((int)ur[e][j], true);
                dp = __builtin_elementwise_fma(xp2[2 * j], lo, dp); dp = __builtin_elementwise_fma(xp2[2 * j + 1], hi, dp); }
            d[e] = dp.x + dp.y; }
        float r8[8], r4[4], r2[2], r1;
#pragma unroll
        for (int k = 0; k < 8; ++k) { const float snd = b5 ? d[k] : d[k + 8]; r8[k] = (b5 ? d[k + 8] : d[k]) + __shfl_xor(snd, 32); }
#pragma unroll
        for (int k = 0; k < 4; ++k) { const float snd = b4 ? r8[k] : r8[k + 4]; r4[k] = (b4 ? r8[k + 4] : r8[k]) + __shfl_xor(snd, 16); }
#pragma unroll
        for (int k = 0; k < 2; ++k) { const float snd = b3 ? r4[k] : r4[k + 2]; r2[k] = (b3 ? r4[k + 2] : r4[k]) + __shfl_xor(snd, 8); }
        { const float snd = b2 ? r2[0] : r2[1]; r1 = (b2 ? r2[1] : r2[0]) + __shfl_xor(snd, 4); }
        r1 += __shfl_xor(r1, 1); r1 += __shfl_xor(r1, 2);
        const int eq = lane >> 2;
        const float act = r1 * __shfl(su_l, eq);
        const float wv = __shfl(gs_c, eq) * 0.5f * act * (1.f + erff(act * 0.7071067811865476f)) * __shfl(sv_l, eq);
#pragma unroll
        for (int e = 0; e < 16; ++e) { const float w = __int_as_float(__builtin_amdgcn_readlane(__float_as_int(wv), 4 * e));
#pragma unroll
            for (int j = 0; j < 4; ++j) { const f32x2_t lo = __builtin_amdgcn_cvt_pk_f32_fp8((int)vr[e][j], false), hi = __builtin_amdgcn_cvt_pk_f32_fp8((int)vr[e][j], true); const f32x2_t w2 = (f32x2_t){w, w};
                acc2[2 * j] = __builtin_elementwise_fma(w2, lo, acc2[2 * j]); acc2[2 * j + 1] = __builtin_elementwise_fma(w2, hi, acc2[2 * j + 1]); } }
        if (h == 7) {
            const GAS float* gp = mod + (size_t)cb_of_row(t) * 12288 + l * 6144 + 5 * 1024 + lane * 16; GAS float* xp = X + (size_t)t * 1024 + lane * 16;
            f32x4 xn[4]; float ss = 0.f;
#pragma unroll
            for (int j = 0; j < 4; ++j) { const f32x4 g = *(const GAS f32x4*)(gp + 4 * j); xn[j] = __builtin_nontemporal_load((const GAS f32x4*)(xp + 4 * j));
#pragma unroll
                for (int k = 0; k < 4; ++k) { xn[j][k] += g[k] * acc2[2 * j + (k >> 1)][k & 1]; ss += xn[j][k] * xn[j][k]; } }
            const float rstd = rsqrtf(wave_sum_u(ss) * (1.f / 1024.f) + EPSN);
            if (l == 1) { const GAS float* fw = (const GAS float*)p.in[29] + lane * 16;
#pragma unroll
                for (int j = 0; j < 4; ++j) { const f32x4 w = *(const GAS f32x4*)(fw + 4 * j); xn[j] = xn[j] * rstd * w; } }
            else if (!DRY) {
                const GAS float* nw = (const GAS float*)p.in[9] + 1024 + lane * 16; const GAS float* mp = mod + (size_t)cb_of_row(t) * 12288 + 6144 + lane * 16; u32x4 ho[2];
#pragma unroll
                for (int j = 0; j < 4; ++j) { const f32x4 w = *(const GAS f32x4*)(nw + 4 * j), sh = *(const GAS f32x4*)(mp + 4 * j), sc = *(const GAS f32x4*)(mp + 1024 + 4 * j); const f32x4 o = xn[j] * rstd * w * (sc + 1.f) + sh;
                    ho[j >> 1][(j & 1) * 2] = cvt_pk_bf16(o[0], o[1]); ho[j >> 1][(j & 1) * 2 + 1] = cvt_pk_bf16(o[2], o[3]); }
                *(GAS u32x4*)((GAS bf16_t*)(p.ws + WS_H) + (size_t)t * 1024 + lane * 16) = ho[0]; *(GAS u32x4*)((GAS bf16_t*)(p.ws + WS_H) + (size_t)t * 1024 + lane * 16 + 8) = ho[1]; }
#pragma unroll
            for (int j = 0; j < 4; ++j) { if (!DRY) __builtin_nontemporal_store(xn[j], (GAS f32x4*)(xp + 4 * j)); else asm volatile("" :: "v"(xn[j][0]), "v"(xn[j][1]), "v"(xn[j][2]), "v"(xn[j][3])); }
        }
    }
#undef PEER_SC
#undef PEER_ROUTE
}

__device__ __forceinline__ void load_params(Params& q, const LAS unsigned* tab) {
#pragma unroll
    for (int k = 0; k < 32; ++k) {
        const unsigned lo = __builtin_amdgcn_readfirstlane(tab[2 * k]), hi = __builtin_amdgcn_readfirstlane(tab[2 * k + 1]);
        const unsigned long long a = ((unsigned long long)hi << 32) | lo;
        if (k < 30) q.in[k] = (const float*)a; else if (k == 30) q.out = (float*)a; else q.ws = (unsigned char*)a;
    }
}
#define PHASE_PARAMS Params p; load_params(p, tab)

#ifdef DBG
__device__ __forceinline__ void dbg_flag(const Params& p, int code) { atomicMax((unsigned*)(p.ws + WS_BAR) + 4000, (unsigned)(1000 - code)); }
__device__ __forceinline__ void dbg_bf16(const Params& p, const bf16_t* base, int rows, int ld, int ncols, int code) {
    const int tid = otid(); bool bad = false;
    for (size_t i = (size_t)blockIdx.x * 512 + tid; i < (size_t)rows * ncols; i += (size_t)gridDim.x * 512) { const size_t r = i / ncols, c = i % ncols; const unsigned v = base[r * ld + c]; if ((v & 0x7F80u) == 0x7F80u) bad = true; }
    if (bad) dbg_flag(p, code);
}
__device__ __forceinline__ void dbg_f32(const Params& p, const float* base, int rows, int ld, int ncols, int code) {
    const int tid = otid(); bool bad = false;
    for (size_t i = (size_t)blockIdx.x * 512 + tid; i < (size_t)rows * ncols; i += (size_t)gridDim.x * 512) { const size_t r = i / ncols, c = i % ncols; const unsigned v = __float_as_uint(base[r * ld + c]); if ((v & 0x7F800000u) == 0x7F800000u) bad = true; }
    if (bad) dbg_flag(p, code);
}
#define DBG_DO(x) { { PHASE_PARAMS; x; } xcd_barrier(xb); }
#else
#define DBG_DO(x)
#endif
__global__ void __launch_bounds__(512, 2) mega_fwd(Params p0) {
    __shared__ __attribute__((aligned(16))) unsigned char smem[LDS_BYTES];
    LAS unsigned char* lds = (LAS unsigned char*)smem;
    LAS unsigned* tab = (LAS unsigned*)(lds + LDS_TAB);
    if (threadIdx.x == 0) {
        volatile LAS unsigned* st0 = (volatile LAS unsigned*)(lds + LDS_ST); st0[0] = 0u; st0[1] = 0u;
#pragma unroll
        for (int k = 0; k < 32; ++k) { const unsigned long long a = k < 30 ? (unsigned long long)p0.in[k] : (k == 30 ? (unsigned long long)p0.out : (unsigned long long)p0.ws); tab[2 * k] = (unsigned)a; tab[2 * k + 1] = (unsigned)(a >> 32); }
    }
    __syncthreads();
    const XcdBarrier xb = xcd_barrier_post((unsigned*)(p0.ws + WS_BAR), (volatile LAS unsigned*)(lds + LDS_ST));
#pragma unroll 1
    for (int l = 0; l < 2; ++l) {
        if (l == 0) {
            { PHASE_PARAMS; phase_convert(p, 0, smem, (int)blockIdx.x, (int)gridDim.x, 1); mod_gemv(p, smem, (int)blockIdx.x, (int)gridDim.x); }
            xcd_barrier(xb);
        }
        if (l == 0) {
            { PHASE_PARAMS; phase_norm(p, p.in[0], p.in[1], p.in[9], 0, 1024); }
            xcd_barrier(xb);
        }
        DBG_DO(dbg_bf16(p, (const bf16_t*)(p.ws + WS_H), T_TOK, 1024, 1024, l * 10 + 2))
        { PHASE_PARAMS; EpiInProj e; e.P = (bf16_t*)(p.ws + WS_PROJ); e.aux = (float*)(p.ws + WS_AUX);
          run_gemm<1>(lds, (const bf16_t*)(p.ws + WS_H), 1024, (const bf16_t*)(p.ws + ws_win(l)), T_TOK, NP, 1024, e);
#ifdef DUP_INPROJ
          run_gemm<1>(lds, (const bf16_t*)(p.ws + WS_H), 1024, (const bf16_t*)(p.ws + ws_win(l)), T_TOK, NP, 1024, e);
#endif
        }
        xcd_barrier(xb);
        DBG_DO(dbg_bf16(p, (const bf16_t*)(p.ws + WS_PROJ), T_TOK, NP, 10240, l * 10 + 3); dbg_f32(p, (const float*)(p.ws + WS_AUX), T_TOK, 64, 48, l * 10 + 3))
#ifndef NO_MIXER
        { PHASE_PARAMS; phase_gla_pre(p, l, lds); }
        { PHASE_PARAMS; phase_ssd_pre(p, l, lds); }
        xcd_barrier(xb);
#ifdef DUP_MIXER
        { PHASE_PARAMS; phase_mixer<true>(p, l, lds); }
#endif
        { PHASE_PARAMS; phase_mixer<false>(p, l, lds); }
#endif
        xcd_barrier(xb);
        DBG_DO(dbg_bf16(p, (const bf16_t*)(p.ws + WS_PROJ) + PC_V, T_TOK, NP, 1024, l * 10 + 4); dbg_bf16(p, (const bf16_t*)(p.ws + WS_PROJ) + PC_Z, T_TOK, NP, 2048, l * 10 + 5))
#ifndef NO_NG
        { PHASE_PARAMS; phase_normgate(p, l); }
#endif
        xcd_barrier(xb);
        DBG_DO(dbg_bf16(p, (const bf16_t*)(p.ws + WS_PROJ) + PC_V, T_TOK, NP, 1024, l * 10 + 6); dbg_bf16(p, (const bf16_t*)(p.ws + WS_PROJ) + PC_Z, T_TOK, NP, 2048, l * 10 + 6))
#ifdef STOP1
        continue;
#endif
        { PHASE_PARAMS; bf16_t* proj = (bf16_t*)(p.ws + WS_PROJ); EpiGlaProj e; e.P = proj; run_gemm<2>(lds, proj + PC_V, NP, (const bf16_t*)(p.ws + ws_wgla(l)), T_TOK, 1024, 1024, e); }
        { PHASE_PARAMS; bf16_t* proj = (bf16_t*)(p.ws + WS_PROJ); EpiSsdProj e; e.P = proj; e.H = (bf16_t*)(p.ws + WS_H); run_gemm<3>(lds, proj + PC_Z, NP, (const bf16_t*)(p.ws + ws_wssd(l)), T_TOK, 1024, 2048, e); }
        {
            const int skip = gridDim.x > 64 ? 32 : 0;
            if ((int)blockIdx.x >= skip) { PHASE_PARAMS; phase_convert(p, 1, smem, (int)blockIdx.x - skip, (int)gridDim.x - skip, l == 0 ? 1 : 12); }
        }
#ifdef DUP_GS
        { PHASE_PARAMS; bf16_t* proj = (bf16_t*)(p.ws + WS_PROJ); EpiGlaProj e; e.P = proj; run_gemm<2>(lds, proj + PC_V, NP, (const bf16_t*)(p.ws + ws_wgla(l)), T_TOK, 1024, 1024, e); }
        { PHASE_PARAMS; bf16_t* proj = (bf16_t*)(p.ws + WS_PROJ); EpiSsdProj e; e.P = proj; e.H = (bf16_t*)(p.ws + WS_H); run_gemm<3>(lds, proj + PC_Z, NP, (const bf16_t*)(p.ws + ws_wssd(l)), T_TOK, 1024, 2048, e); }
#endif
        xcd_barrier(xb);
        DBG_DO(dbg_bf16(p, (const bf16_t*)(p.ws + WS_H), T_TOK, 1024, 1024, l * 10 + 7))
        { PHASE_PARAMS; EpiWout e; e.X = p.out; e.Xa = l == 0 ? p.in[0] : p.out; e.Xb = l == 0 ? p.in[1] : p.out + (size_t)T_PROMPT * 1024; e.modg = (const float*)(p.ws + WS_MOD) + l * 6144 + 2 * 1024; run_gemm<4>(lds, (const bf16_t*)(p.ws + WS_H), 1024, (const bf16_t*)(p.ws + ws_wout(l)), T_TOK, 1024, 1024, e); }
        if (l == 0) { const int skip = gridDim.x > 64 ? 32 : 0;
            if ((int)blockIdx.x >= skip) { PHASE_PARAMS; phase_convert(p, 0, smem, (int)blockIdx.x - skip, (int)gridDim.x - skip, 4); } }
        xcd_barrier(xb);
        DBG_DO(dbg_f32(p, p.out, T_TOK, 1024, 1024, l * 10 + 8))
        { PHASE_PARAMS; phase_norm(p, p.out, p.out + (size_t)T_PROMPT * 1024, p.in[23] + l * 1024, l * 6144 + 3 * 1024, l * 6144 + 4 * 1024); }
        xcd_barrier(xb);
        DBG_DO(dbg_bf16(p, (const bf16_t*)(p.ws + WS_H), T_TOK, 1024, 1024, l * 10 + 9))
        { PHASE_PARAMS; EpiF32 e; e.C = (float*)(p.ws + WS_PROJ); e.ldc = 2048; e.bias = nullptr; run_gemm<5>(lds, (const bf16_t*)(p.ws + WS_H), 1024, (const bf16_t*)(p.ws + ws_wpeer(l)), T_TOK, 2048, 1024, e); }
        if (l == 0) { const int skip = gridDim.x > 128 ? 64 : 0;
            if ((int)blockIdx.x >= skip) { PHASE_PARAMS; phase_convert(p, 0, smem, (int)blockIdx.x - skip, (int)gridDim.x - skip, 8); } }
#ifdef DUP_SCORES
        { PHASE_PARAMS; EpiF32 e; e.C = (float*)(p.ws + WS_PROJ); e.ldc = 2048; e.bias = nullptr; run_gemm<5>(lds, (const bf16_t*)(p.ws + WS_H), 1024, (const bf16_t*)(p.ws + ws_wpeer(l)), T_TOK, 2048, 1024, e); }
#endif
        xcd_barrier(xb);
        DBG_DO(dbg_f32(p, (const float*)(p.ws + WS_PROJ), T_TOK, 2048, 2048, l * 10 + 10))
#ifndef NO_PEER
#ifdef DUP_PEER
        { PHASE_PARAMS; phase_peer<true>(p, l); }
#endif
        { PHASE_PARAMS; phase_peer<false>(p, l); }
#endif
        if (l == 0) xcd_barrier(xb);
    }
#ifdef DBG
    xcd_barrier(xb);
    { PHASE_PARAMS; const unsigned f = __hip_atomic_load((unsigned*)(p.ws + WS_BAR) + 4000, __ATOMIC_RELAXED, __HIP_MEMORY_SCOPE_AGENT); if (f) { const float K = 10.f * (float)(1000 - (int)f); const int tid = otid(); for (size_t i = (size_t)blockIdx.x * 512 + tid; i < (size_t)T_TOK * 1024; i += (size_t)gridDim.x * 512) p.out[i] = K; } }
#endif
#ifdef DBG2
    xcd_barrier(xb);
    { PHASE_PARAMS; const unsigned f = __hip_atomic_load((unsigned*)(p.ws + WS_BAR) + 4000, __ATOMIC_RELAXED, __HIP_MEMORY_SCOPE_AGENT); if (f) { const float K = 10.f * (float)(1 << (100 - (int)f)); const int tid = otid(); for (size_t i = (size_t)blockIdx.x * 512 + tid; i < (size_t)T_TOK * 1024; i += (size_t)gridDim.x * 512) p.out[i] = K; } }
#endif
#ifdef SANITIZE
    xcd_barrier(xb);
    { PHASE_PARAMS; const int tid = otid(); for (size_t i = (size_t)blockIdx.x * 512 + tid; i < (size_t)51068928; i += (size_t)gridDim.x * 512) { const float v = p.out[i]; if (!(fabsf(v) < 3.0e38f)) p.out[i] = 0.f; } }
#endif
}

extern "C" void kernel_launch(void* const* d_in, const int* in_sizes, int n_in, void* d_out, int out_size, void* d_ws, size_t ws_size, hipStream_t stream) {
    static int grid = 0;
    if (grid == 0) {
        if (n_in != 30 || ws_size < WS_END) { fprintf(stderr, "kernel_launch: need 30 inputs and >= %zu bytes of workspace; got %d, %zu\n", (size_t)WS_END, n_in, ws_size); grid = -1; return; }
        int dev = 0, cus = 0, per_cu = 0;
        (void)hipGetDevice(&dev); (void)hipDeviceGetAttribute(&cus, hipDeviceAttributeMultiprocessorCount, dev);
        if (hipOccupancyMaxActiveBlocksPerMultiprocessor(&per_cu, (const void*)mega_fwd, 512, 0) != hipSuccess || per_cu < 1) { fprintf(stderr, "kernel_launch: occupancy query failed (%d)\n", per_cu); (void)hipGetLastError(); per_cu = 1; }
        grid = cus * (per_cu > 1 ? 1 : per_cu);
        if (grid > 256) grid = 256;
    }
    if (grid < 0) return;
    if (hipMemsetAsync((char*)d_ws + WS_BAR, 0, 16384, stream) != hipSuccess) { fprintf(stderr, "kernel_launch: memset of the barrier words failed\n"); return; }
    Params p{};
    for (int i = 0; i < 30; ++i) p.in[i] = (const float*)d_in[i];
    p.out = (float*)d_out; p.ws = (unsigned char*)d_ws;
    void* args[] = {&p};
    hipError_t e = hipLaunchCooperativeKernel((const void*)mega_fwd, dim3(grid), dim3(512), args, 0, stream);
    if (e != hipSuccess) fprintf(stderr, "kernel_launch: cooperative launch failed: %s (grid %d)\n", hipGetErrorString(e), grid);
}
```
